# Optimizing an MI355X kernel written in HIP

```python
import jax, jax.numpy as jnp
from jax import lax
import numpy as np

D_MODEL = 1024
BATCH = 2
SEQ = 8192
DEPTH = 2

CTX_LEN = 256
GRID_W = 64
D_MIX = D_MODEL
W_ATTN = D_MIX // 4
W_FOURIER = D_MIX // 4
W_CONV = D_MIX // 4
W_POOL = D_MIX // 4
HEAD_DIM = 64
N_Q_HEADS = W_ATTN // HEAD_DIM
N_KV_HEADS = 2
Q_PER_KV = N_Q_HEADS // N_KV_HEADS
N_FOURIER_HEADS = 4
FOURIER_HEAD_DIM = W_FOURIER // N_FOURIER_HEADS
CONV_WIDTH = 31
POOL_WINDOWS = (2, 4, 8, 16)
POOL_GROUP = W_POOL // len(POOL_WINDOWS)
D_FF = -(-(8 * D_MODEL) // (3 * 256)) * 256
ROPE_THETA = 10000.0
Q_BLOCK = 128
EPS = 1e-6
ATTN_SCALE = HEAD_DIM ** -0.5

OFF_Q = 0
OFF_K = OFF_Q + N_Q_HEADS * HEAD_DIM
OFF_V = OFF_K + N_KV_HEADS * HEAD_DIM
OFF_F = OFF_V + N_KV_HEADS * HEAD_DIM
OFF_C = OFF_F + W_FOURIER
OFF_P = OFF_C + 2 * W_CONV
D_IN = OFF_P + W_POOL

kernel_name = 'hymba_style_fourier_conv_pool_gqa_dit_block'


def rms_norm(x, g):
    xf = x.astype(jnp.float32)
    y = xf * lax.rsqrt(jnp.mean(xf * xf, axis=-1, keepdims=True) + EPS)
    return (y * g.astype(jnp.float32)).astype(x.dtype)


def layer_norm(x, g, b):
    xf = x.astype(jnp.float32)
    xc = xf - jnp.mean(xf, axis=-1, keepdims=True)
    y = xc * lax.rsqrt(jnp.mean(xc * xc, axis=-1, keepdims=True) + EPS)
    return (y * g.astype(jnp.float32) + b.astype(jnp.float32)).astype(x.dtype)


def axial_rope_tables(n, dtype):
    rows = n // GRID_W
    row = jnp.repeat(jnp.arange(rows, dtype=jnp.float32), GRID_W)
    col = jnp.tile(jnp.arange(GRID_W, dtype=jnp.float32), rows)
    n_freq = HEAD_DIM // 4
    inv_freq = ROPE_THETA ** (-jnp.arange(n_freq, dtype=jnp.float32) / n_freq)
    ang = jnp.concatenate([row[:, None] * inv_freq, col[:, None] * inv_freq], axis=-1)
    return jnp.cos(ang).astype(dtype), jnp.sin(ang).astype(dtype)


def apply_rope(x, cos, sin):
    xp = x.reshape(x.shape[:-1] + (HEAD_DIM // 2, 2))
    x0, x1 = xp[..., 0], xp[..., 1]
    cs = cos[None, :, None, :]
    sn = sin[None, :, None, :]
    return jnp.stack([x0 * cs - x1 * sn, x0 * sn + x1 * cs], axis=-1).reshape(x.shape)


def q_heads(pq, q_g):
    b, n, _ = pq.shape
    return rms_norm(pq.reshape(b, n, N_Q_HEADS, HEAD_DIM), q_g)


def kv_heads(pkv, k_g):
    b, n, _ = pkv.shape
    kv = pkv.reshape(b, n, 2, N_KV_HEADS, HEAD_DIM)
    return rms_norm(kv[:, :, 0], k_g), kv[:, :, 1]


def attend(q, k, v):
    b, nq = q.shape[:2]
    qg = q.reshape(b, nq, N_KV_HEADS, Q_PER_KV, HEAD_DIM)
    s = jnp.einsum('bqhgd,bkhd->bhgqk', qg, k).astype(jnp.float32) * ATTN_SCALE
    p = jax.nn.softmax(s, axis=-1).astype(v.dtype)
    o = jnp.einsum('bhgqk,bkhd->bqhgd', p, v)
    return o.reshape(b, nq, N_Q_HEADS * HEAD_DIM)


def attend_query_blocks(q, k, v):
    b, n = q.shape[:2]
    nb = n // Q_BLOCK
    qb = jnp.swapaxes(q.reshape(b, nb, Q_BLOCK, N_Q_HEADS, HEAD_DIM), 0, 1)
    ob = lax.map(lambda qi: attend(qi, k, v), qb)
    return jnp.swapaxes(ob, 0, 1).reshape(b, n, N_Q_HEADS * HEAD_DIM)


def fourier_mixer(u, w_f):
    b, n, _ = u.shape
    uf = u.astype(jnp.float32).reshape(b, n, N_FOURIER_HEADS, FOURIER_HEAD_DIM)
    y = jnp.fft.fft2(uf, axes=(1, 3), norm='ortho').real
    return y.reshape(b, n, W_FOURIER).astype(u.dtype) @ w_f


def conv_module(a, dw_w, dw_b, ln_g, ln_b, w_pw):
    glu = a[..., :W_CONV] * jax.nn.sigmoid(a[..., W_CONV:])
    y = lax.conv_general_dilated(
        glu, dw_w[:, None, :], window_strides=(1,),
        padding=[(CONV_WIDTH // 2, CONV_WIDTH // 2)],
        dimension_numbers=('NWC', 'WIO', 'NWC'),
        feature_group_count=W_CONV) + dw_b
    y = jax.nn.silu(layer_norm(y, ln_g, ln_b))
    return y @ w_pw


def pool_mixer(u, w_pool, scale):
    b, n, _ = u.shape
    uf = u.astype(jnp.float32)
    csum = jnp.concatenate([jnp.zeros((b, 1, W_POOL), jnp.float32), jnp.cumsum(uf, axis=1)], axis=1)
    t = jnp.arange(n)
    groups = []
    for gi, win in enumerate(POOL_WINDOWS):
        sl = slice(gi * POOL_GROUP, (gi + 1) * POOL_GROUP)
        lo = jnp.clip(t - win // 2, 0, n)
        hi = jnp.clip(t - win // 2 + win, 0, n)
        cs = csum[..., sl]
        cnt = (hi - lo).astype(jnp.float32)[None, :, None]
        mean = (jnp.take(cs, hi, axis=1) - jnp.take(cs, lo, axis=1)) / cnt
        groups.append(mean - uf[..., sl])
    y = jnp.stack(groups, axis=2).astype(u.dtype)
    y = jnp.einsum('blgc,gcd->blgd', y, w_pool).reshape(b, n, W_POOL)
    return y * scale


def swiglu(x, w_in, w_out):
    a, g = jnp.split(x @ w_in, 2, axis=-1)
    return (jax.nn.silu(a) * g) @ w_out


def mixers_and_ffn(x, p, attn, gate1, shift2, scale2, gate2, g2, w_f, dw_w, dw_b,
                   ln_g, ln_b, w_pw, w_pl, pl_scale, w_o, w_fi, w_fo):
    four = fourier_mixer(p[..., OFF_F:OFF_C], w_f)
    conv = conv_module(p[..., OFF_C:OFF_P], dw_w, dw_b, ln_g, ln_b, w_pw)
    pool = pool_mixer(p[..., OFF_P:], w_pl, pl_scale)
    mix = jnp.concatenate([attn, four, conv, pool], axis=-1) @ w_o
    x = x + gate1 * mix
    xn = rms_norm(x, g2) * (1 + scale2) + shift2
    return x + gate2 * swiglu(xn, w_fi, w_fo)


def setup_inputs(seed: int = 0) -> dict:
    key = jax.random.key(seed)
    ks = jax.random.split(key, 24)
    f32 = jnp.float32
    L = DEPTH
    D = D_MODEL

    def nrm(k, shape, scale):
        return jax.random.normal(k, shape, f32) * scale

    return {
        'x': nrm(ks[0], (BATCH, SEQ, D), 1.0),
        'c': nrm(ks[1], (BATCH, D), 1.0),
        'ctx': nrm(ks[2], (BATCH, CTX_LEN, D), 1.0),
        'c_ctx': nrm(ks[3], (D,), 1.0),
        'w_mod': nrm(ks[4], (L, D, 6 * D), D ** -0.5),
        'b_mod': nrm(ks[5], (L, 6 * D), 0.02),
        'g_norm1': 1.0 + nrm(ks[6], (L, D), 0.02),
        'g_norm2': 1.0 + nrm(ks[7], (L, D), 0.02),
        'w_in': nrm(ks[8], (L, D, D_IN), D ** -0.5),
        'q_norm_g': 1.0 + nrm(ks[9], (L, HEAD_DIM), 0.02),
        'k_norm_g': 1.0 + nrm(ks[10], (L, HEAD_DIM), 0.02),
        'w_fourier': nrm(ks[11], (L, W_FOURIER, W_FOURIER), W_FOURIER ** -0.5),
        'conv_dw_w': nrm(ks[12], (L, CONV_WIDTH, W_CONV), CONV_WIDTH ** -0.5),
        'conv_dw_b': nrm(ks[13], (L, W_CONV), 0.02),
        'conv_ln_g': 1.0 + nrm(ks[14], (L, W_CONV), 0.02),
        'conv_ln_b': nrm(ks[15], (L, W_CONV), 0.02),
        'w_conv_pw': nrm(ks[16], (L, W_CONV, W_CONV), W_CONV ** -0.5),
        'w_pool': nrm(ks[17], (L, len(POOL_WINDOWS), POOL_GROUP, POOL_GROUP), POOL_GROUP ** -0.5),
        'pool_scale': 1.0 + nrm(ks[18], (L, W_POOL), 0.02),
        'w_out': nrm(ks[19], (L, D_MIX, D), D_MIX ** -0.5),
        'w_ffn_in': nrm(ks[20], (L, D, 2 * D_FF), D ** -0.5),
        'w_ffn_out': nrm(ks[21], (L, D_FF, D), D_FF ** -0.5),
    }


def reference(x, c, ctx, c_ctx, w_mod, b_mod, g_norm1, g_norm2, w_in, q_norm_g, k_norm_g,
              w_fourier, conv_dw_w, conv_dw_b, conv_ln_g, conv_ln_b, w_conv_pw, w_pool,
              pool_scale, w_out, w_ffn_in, w_ffn_out):
    n = x.shape[1]
    cos, sin = axial_rope_tables(n, x.dtype)
    h = ctx
    sc = jax.nn.silu(c)
    scc = jax.nn.silu(c_ctx)
    for l in range(DEPTH):
        last = l == DEPTH - 1
        mod = jnp.split(sc @ w_mod[l] + b_mod[l], 6, axis=-1)
        shift1, scale1, gate1, shift2, scale2, gate2 = [m[:, None, :] for m in mod]
        n_ctx_mod = 2 if last else 6
        mod_c = jnp.split(scc @ w_mod[l][:, :n_ctx_mod * D_MODEL] + b_mod[l][:n_ctx_mod * D_MODEL], n_ctx_mod)

        hn = rms_norm(h, g_norm1[l]) * (1 + mod_c[1]) + mod_c[0]
        if last:
            kc, vc = kv_heads(hn @ w_in[l][:, OFF_K:OFF_F], k_norm_g[l])
        else:
            pc = hn @ w_in[l]
            qc = q_heads(pc[..., OFF_Q:OFF_K], q_norm_g[l])
            kc, vc = kv_heads(pc[..., OFF_K:OFF_F], k_norm_g[l])

        xn = rms_norm(x, g_norm1[l]) * (1 + scale1) + shift1
        p = xn @ w_in[l]
        q = apply_rope(q_heads(p[..., OFF_Q:OFF_K], q_norm_g[l]), cos, sin)
        k, v = kv_heads(p[..., OFF_K:OFF_F], k_norm_g[l])
        k = apply_rope(k, cos, sin)
        attn = attend_query_blocks(q, jnp.concatenate([kc, k], axis=1), jnp.concatenate([vc, v], axis=1))
        x_new = mixers_and_ffn(x, p, attn, gate1, shift2, scale2, gate2, g_norm2[l],
                               w_fourier[l], conv_dw_w[l], conv_dw_b[l], conv_ln_g[l], conv_ln_b[l],
                               w_conv_pw[l], w_pool[l], pool_scale[l], w_out[l], w_ffn_in[l], w_ffn_out[l])
        if not last:
            attn_c = attend(qc, kc, vc)
            h = mixers_and_ffn(h, pc, attn_c, mod_c[2], mod_c[3], mod_c[4], mod_c[5], g_norm2[l],
                               w_fourier[l], conv_dw_w[l], conv_dw_b[l], conv_ln_g[l], conv_ln_b[l],
                               w_conv_pw[l], w_pool[l], pool_scale[l], w_out[l], w_ffn_in[l], w_ffn_out[l])
        x = x_new
    return x
```

```cpp
#include <hip/hip_runtime.h>
#include <hip/hip_bf16.h>
#include <cstdio>
#include <cstdint>
#include <cmath>
constexpr int NWAVES = 8;
constexpr int BATCH = 2, SEQ = 8192, CTXL = 256, DM = 1024, DEPTH = 2, DFF = 2816, DIN0 = 1536, NIN = 1792;
constexpr int SPB = SEQ + CTXL;
constexpr int R = BATCH * SPB;
constexpr float EPS = 1e-6f;
constexpr float QSCALE = 0.125f * 1.4426950408889634f;
constexpr size_t MiB = 1u << 20;
constexpr size_t WS_CTL = 0, CTL_ZERO_BYTES = 1 * MiB;
constexpr size_t CTL_MOD = 64 * 1024;
constexpr size_t WS_WIN = 2 * MiB, WIN_STRIDE = 4 * MiB;
constexpr size_t WS_WO = 10 * MiB, WO_STRIDE = 2 * MiB;
constexpr size_t WS_WFI = 14 * MiB, WFI_STRIDE = 12 * MiB;
constexpr size_t WS_WFO = 38 * MiB, WFO_STRIDE = 6 * MiB;
constexpr size_t WS_SMALL = 50 * MiB;
constexpr size_t SM_BIN = WS_SMALL;
constexpr size_t SM_BFF = SM_BIN + 64 * 1024;
constexpr size_t SM_ROPE = SM_BFF + 192 * 1024;
constexpr size_t SM_TW = SM_ROPE + 16 * 1024;
constexpr size_t SM_M1 = SM_TW + 64 * 1024;
constexpr size_t SM_M2 = SM_M1 + 128 * 1024;
constexpr size_t SM_M3 = SM_M2 + 16 * 1024;
constexpr size_t SM_MODPART = 51 * MiB;
constexpr size_t WS_CTXRES = 54 * MiB;
constexpr size_t WS_ACT = 56 * MiB;
constexpr size_t WS_P = 89 * MiB;
constexpr size_t WS_Q = 147 * MiB;
constexpr size_t WS_K = 156 * MiB;
constexpr size_t WS_V = 161 * MiB;
constexpr size_t WS_GP = 166 * MiB;
constexpr size_t WS_H = 89 * MiB;
constexpr size_t WS_MIX = 182 * MiB;
constexpr size_t WS_RPART = 215 * MiB;
constexpr size_t WS_END = 220 * MiB;
static_assert(WS_H + (size_t)R * DFF * 2 <= WS_MIX && WS_GP + 16 * MiB <= WS_MIX && WS_P + (size_t)R * NIN * 2 <= WS_Q, "d_ws map");
constexpr int CW_BAR = 4096;
constexpr int RING_OFF = 0, RING_BYTES = 131072;
constexpr int LDSCTL_OFF = RING_BYTES, MISC_OFF = LDSCTL_OFF + 320;
constexpr int LDS_BYTES = 147456;
constexpr int PTAB_OFF = LDSCTL_OFF + 512;
#define N_IN 22
__device__ __forceinline__ const float* inptr(__attribute__((address_space(3))) unsigned char* lds, int i) {
    const unsigned long long v = *(const __attribute__((address_space(3))) unsigned long long*)(lds + PTAB_OFF + 8 * i);
    const unsigned lo = __builtin_amdgcn_readfirstlane((unsigned)v), hi = __builtin_amdgcn_readfirstlane((unsigned)(v >> 32));
    return (const float*)(((unsigned long long)hi << 32) | lo);
}
#define IN_X 0
#define IN_C 1
#define IN_CTX 2
#define IN_CCTX 3
#define IN_WMOD 4
#define IN_BMOD 5
#define IN_G1 6
#define IN_G2 7
#define IN_WIN 8
#define IN_QG 9
#define IN_KG 10
#define IN_WF 11
#define IN_DWW 12
#define IN_DWB 13
#define IN_LNG 14
#define IN_LNB 15
#define IN_WPW 16
#define IN_WPL 17
#define IN_PLS 18
#define IN_WO 19
#define IN_WFI 20
#define IN_WFO 21
#define IN_OUT 22
__device__ __forceinline__ float row_rstd(const float* rpart, int r) {
    typedef float f4 __attribute__((ext_vector_type(4)));
    const f4* p = (const f4*)(rpart + (size_t)r * 16); const f4 a = p[0], b = p[1], c = p[2], d = p[3];
    const float s = (((a[0] + a[1]) + (a[2] + a[3])) + ((b[0] + b[1]) + (b[2] + b[3]))) + (((c[0] + c[1]) + (c[2] + c[3])) + ((d[0] + d[1]) + (d[2] + d[3])));
    return rsqrtf(s * (1.0f / 1024.0f) + 1e-6f);
}
namespace pg8 {
#define PG8_LAS __attribute__((address_space(3)))
typedef unsigned short bf16_t;
typedef short bf16x8 __attribute__((ext_vector_type(8)));
typedef float f32x4 __attribute__((ext_vector_type(4)));
typedef unsigned u32x4 __attribute__((ext_vector_type(4)));
constexpr int BM = 256, BK = 64, HALF = 128, HTB = HALF * BK * 2  , STAGE_BYTES = 8 * HTB, NXCD = 8, WGM = 8;

__host__ __device__ __forceinline__ int lds_byte(int r, int c) { const int st = (r >> 4) * 2 + (c >> 5), rr = r & 15, cc = c & 31, ob = rr * 64 + cc * 2; return st * 1024 + (ob ^ (((ob >> 9) & 1) << 5)); }
__host__ __device__ __forceinline__ void stage_rc(int b, int& R, int& C) { const int st = b / 1024, sb = b % 1024, swz = sb ^ (((sb >> 9) & 1) << 5); R = (st >> 1) * 16 + swz / 64; C = (st & 1) * 32 + (swz % 64) / 2; }
__host__ __device__ __forceinline__ int perm32(int rho) { const int n = rho >> 4, i = rho & 15; return 8 * (i >> 2) + 4 * n + (i & 3); }

struct Unit { int pm, pn; };
struct Gemm { const bf16_t* A; const bf16_t* Bt; int M, N, K; };

struct StaticOrder {
    int nM, nN, nwg, G, c, skip;
    __host__ __device__ void init(int M, int N, int G_, int c_, int skip_) { nM = M / BM; nN = N / BM; nwg = nM * nN; G = G_; c = c_; skip = skip_; }
    __host__ __device__ bool next(int i, Unit& u) const {
        const long L = (long)i * G + c; if (L >= nwg) return false;
        int wgid = (int)L; { const int q = nwg / NXCD, r = nwg % NXCD, xcd = wgid % NXCD, off = wgid / NXCD; wgid = (xcd < r ? xcd * (q + 1) : r * (q + 1) + (xcd - r) * q) + off; }
        const int nig = WGM * nN, gid = wgid / nig, fm = gid * WGM, gsz = (nM - fm) < WGM ? (nM - fm) : WGM;
        u.pm = fm + ((wgid % nig) % gsz); u.pn = (wgid % nig) / gsz; if (skip) u.pm += 1 + u.pm / 32; return true;
    }
    __device__ __forceinline__ void a_ready(const Unit&) const {}
    __device__ __forceinline__ void done(const Unit&) const {}
};

__device__ __forceinline__ unsigned cvt_pk_bf16(float lo, float hi) { unsigned r; asm volatile("v_cvt_pk_bf16_f32 %0, %1, %2" : "=v"(r) : "v"(lo), "v"(hi)); return r; }
constexpr int RT = 33;
__device__ __forceinline__ int tile_v(int pm) { return (pm % RT == 0) ? 2 : pm / RT; }
typedef unsigned u32x2 __attribute__((ext_vector_type(2)));

struct EpiInProj {
    static constexpr bool PERM = true, AFTER_DRAIN = false;
    unsigned char* ws; int l;
    __device__ __forceinline__ void operator()(const f32x4 (&acc)[2][2][4][2], const Unit& u, int wr, int wc, int fr, int fq) const {
        bf16_t* O = (bf16_t*)(ws + WS_P); const float* rowss = (const float*)(ws + WS_RPART) + (size_t)(2 * l) * R * 16; const float* bias = (const float*)(ws + SM_BIN) + (size_t)l * 3 * NIN;
        const int row0 = u.pm * BM + wr * 64 + fr, v = tile_v(u.pm), col0 = u.pn * BM + wc * 32 + 8 * fq;
        const float* bp = bias + v * 1792 + col0;
        f32x4 bv[2][2];
#pragma unroll
        for (int bj = 0; bj < 2; ++bj)
#pragma unroll
            for (int n = 0; n < 2; ++n) bv[bj][n] = *(const f32x4*)(bp + bj * HALF + 4 * n);
#pragma unroll
        for (int ai = 0; ai < 2; ++ai)
#pragma unroll
            for (int m = 0; m < 4; ++m) { const int r = row0 + ai * HALF + m * 16; const float rs = row_rstd(rowss, r);
                bf16_t* rowp = O + (size_t)r * 1792 + col0;
#pragma unroll
                for (int bj = 0; bj < 2; ++bj) { const f32x4 v0 = acc[ai][bj][m][0] * rs + bv[bj][0], v1 = acc[ai][bj][m][1] * rs + bv[bj][1];
                    u32x4 w; w.x = cvt_pk_bf16(v0[0], v0[1]); w.y = cvt_pk_bf16(v0[2], v0[3]); w.z = cvt_pk_bf16(v1[0], v1[1]); w.w = cvt_pk_bf16(v1[2], v1[3]);
                    *(u32x4*)(rowp + bj * HALF) = w; } }
    }
};
struct EpiFfnIn {
    static constexpr bool PERM = true, AFTER_DRAIN = false;
    unsigned char* ws; int l;
    __device__ __forceinline__ void operator()(const f32x4 (&acc)[2][2][4][2], const Unit& u, int wr, int wc, int fr, int fq) const {
        bf16_t* H = (bf16_t*)(ws + WS_H); const float* rowss = (const float*)(ws + WS_RPART) + (size_t)(2 * l + 1) * R * 16; const float* bias = (const float*)(ws + SM_BFF) + (size_t)l * 3 * 2 * DFF;
        const int row0 = u.pm * BM + wr * 64 + fr, v = tile_v(u.pm), hc = wc * 32 + 8 * fq;
        const float* bp = bias + v * 5632 + u.pn * BM + hc;
        f32x4 bv[2][2];
#pragma unroll
        for (int bj = 0; bj < 2; ++bj)
#pragma unroll
            for (int n = 0; n < 2; ++n) bv[bj][n] = *(const f32x4*)(bp + bj * HALF + 4 * n);
#pragma unroll
        for (int ai = 0; ai < 2; ++ai)
#pragma unroll
            for (int m = 0; m < 4; ++m) { const int r = row0 + ai * HALF + m * 16; const float rs = row_rstd(rowss, r);
                float o[8];
#pragma unroll
                for (int n = 0; n < 2; ++n) { const f32x4 a = acc[ai][0][m][n] * rs + bv[0][n], g = acc[ai][1][m][n] * rs + bv[1][n];
#pragma unroll
                    for (int i = 0; i < 4; ++i) o[4 * n + i] = a[i] * __builtin_amdgcn_rcpf(1.0f + __expf(-a[i])) * g[i]; }
                u32x4 w; w.x = cvt_pk_bf16(o[0], o[1]); w.y = cvt_pk_bf16(o[2], o[3]); w.z = cvt_pk_bf16(o[4], o[5]); w.w = cvt_pk_bf16(o[6], o[7]);
                *(u32x4*)(H + (size_t)r * 2816 + u.pn * HALF + hc) = w; }
    }
};
struct EpiRes {
    static constexpr bool PERM = false, AFTER_DRAIN = false;
    PG8_LAS unsigned char* lds; unsigned char* ws; int l; int kind;
    __device__ __forceinline__ void operator()(const f32x4 (&acc)[2][2][4][2], const Unit& u, int wr, int wc, int fr, int fq) const {
        const float* mod = (const float*)(ws + WS_CTL + CTL_MOD) + (size_t)l * 3 * 6144;
        const bool lastffn = (kind == 1 && l == DEPTH - 1);
        const float* xin = (kind == 0 && l == 0) ? inptr(lds, IN_X) : nullptr; const float* ctxin = xin ? inptr(lds, IN_CTX) : nullptr;
        float* dout = (float*)inptr(lds, IN_OUT); float* ctxres = (float*)(ws + WS_CTXRES);
        const float* gate = mod + (kind == 0 ? 2048 : 5120);
        const float* gn = lastffn ? nullptr : (kind == 0 ? inptr(lds, IN_G2) + l * DM : inptr(lds, IN_G1) + (l + 1) * DM);
        const float* sc = kind == 0 ? mod + 4096 : mod + 3 * 6144 + 1024;
        bf16_t* A = lastffn ? nullptr : (bf16_t*)(ws + WS_ACT);
        float* rowss = (float*)(ws + WS_RPART) + (size_t)(2 * l + 1 + kind) * R * 16;
        const int v = tile_v(u.pm), rr = u.pm % RT, b = u.pm / RT;
        const float* src; float* dst;
        if (rr == 0) { dst = ctxres + (size_t)b * 256 * 1024; src = xin ? ctxin + (size_t)b * 256 * 1024 : dst; }
        else { const size_t off = ((size_t)b * 8192 + (size_t)(rr - 1) * 256) * 1024; dst = dout + off; src = xin ? xin + off : dst; }
        const int col0 = u.pn * BM + wc * 32 + 4 * fq;
        f32x4 gv[2][2], gs[2][2];
#pragma unroll
        for (int bj = 0; bj < 2; ++bj)
#pragma unroll
            for (int n = 0; n < 2; ++n) { const int c = col0 + bj * HALF + n * 16; gv[bj][n] = *(const f32x4*)(gate + v * 6144 + c);
                if (A) gs[bj][n] = *(const f32x4*)(gn + c) * (*(const f32x4*)(sc + v * 6144 + c) + 1.0f); else gs[bj][n] = (f32x4){0.f, 0.f, 0.f, 0.f}; }
#pragma unroll
        for (int ai = 0; ai < 2; ++ai)
#pragma unroll
            for (int m = 0; m < 4; ++m) { const int lr = ai * HALF + wr * 64 + m * 16 + fr; float ss = 0.f;
#pragma unroll
                for (int bj = 0; bj < 2; ++bj)
#pragma unroll
                    for (int n = 0; n < 2; ++n) { const size_t o = (size_t)lr * 1024 + col0 + bj * HALF + n * 16;
                        const f32x4 xs = *(const f32x4*)(src + o); const f32x4 xo = xs + gv[bj][n] * acc[ai][bj][m][n];
                        *(f32x4*)(dst + o) = xo;
                        if (A) { ss += (xo[0] * xo[0] + xo[1] * xo[1]) + (xo[2] * xo[2] + xo[3] * xo[3]); const f32x4 a = xo * gs[bj][n];
                            u32x2 w; w.x = cvt_pk_bf16(a[0], a[1]); w.y = cvt_pk_bf16(a[2], a[3]); *(u32x2*)(A + (size_t)(u.pm * BM + lr) * 1024 + col0 + bj * HALF + n * 16) = w; } }
                if (A) { ss += __shfl_xor(ss, 16); ss += __shfl_xor(ss, 32);
                    if (fq == 0) rowss[(size_t)(u.pm * BM + lr) * 16 + u.pn * 4 + wc] = ss; }
                asm volatile("" ::: "memory"); }
    }
};
template <class Epi, class Sched, bool ALIGN_EPI = false, bool SP2 = false>
__device__ __forceinline__ void gemm_phase(PG8_LAS unsigned char* lds, const Gemm g, const Sched& S, const Epi& E) {
    int tid_ = threadIdx.x; asm volatile("" : "+v"(tid_));
    const int tid = tid_, wid = __builtin_amdgcn_readfirstlane(tid >> 6), lane = tid & 63, wr = wid >> 2, wc = wid & 3, fr = lane & 15, fq = lane >> 4;
    const int K = g.K, nt = K / BK;
    unsigned voffA[2], voffB[2];
#pragma unroll
    for (int i = 0; i < 2; ++i) { int R, C; stage_rc(tid * 16 + i * 8192, R, C); const int Rb = Epi::PERM ? ((R & ~31) + perm32(R & 31)) : R;
        voffA[i] = (unsigned)(R * K + C) * 2u; voffB[i] = (unsigned)(Rb * K + C) * 2u; }
    const size_t kstep = (size_t)(BK * 2);
    const size_t hstep = (size_t)HALF * K * 2;
    const size_t tstep = 2 * hstep;
    const unsigned ldsw = (unsigned)wid * 1024u;
    const int aoff = lds_byte(wr * 64 + fr, fq * 8), boff = lds_byte(wc * 32 + fr, fq * 8);
#define PG8_SA(b, h) (((b) * 2 + (h)) * HTB)
#define PG8_SB(b, h) ((4 + (b) * 2 + (h)) * HTB)
#define PG8_STAGE(bufoff, gbase, voff) do { _Pragma("unroll") for (int _i = 0; _i < 2; ++_i) \
        __builtin_amdgcn_global_load_lds((const unsigned*)((const char*)(gbase) + (voff)[_i]), (PG8_LAS unsigned*)(lds + (bufoff) + ldsw + _i * 8192), 16, 0, 0); } while (0)
#define PG8_LDA(dst, b, h) do { _Pragma("unroll") for (int m = 0; m < 4; ++m) _Pragma("unroll") for (int k = 0; k < 2; ++k) dst[m][k] = *(const PG8_LAS bf16x8*)(lds + PG8_SA(b, h) + aoff + m * 2048 + k * 1024); } while (0)
#define PG8_LDB(dst, b, h) do { _Pragma("unroll") for (int n = 0; n < 2; ++n) _Pragma("unroll") for (int k = 0; k < 2; ++k) dst[n][k] = *(const PG8_LAS bf16x8*)(lds + PG8_SB(b, h) + boff + n * 2048 + k * 1024); } while (0)
#define PG8_MMA(ai, bj, At, Bt) do { __builtin_amdgcn_s_setprio(1); _Pragma("unroll") for (int m = 0; m < 4; ++m) _Pragma("unroll") for (int n = 0; n < 2; ++n) _Pragma("unroll") for (int k = 0; k < 2; ++k) \
        acc[ai][bj][m][n] = __builtin_amdgcn_mfma_f32_16x16x32_bf16(Bt[n][k], At[m][k], acc[ai][bj][m][n], 0, 0, 0); __builtin_amdgcn_s_setprio(0); } while (0)
#define PG8_WAIT_V(n) asm volatile("s_waitcnt vmcnt(" #n ")" ::: "memory")
#define PG8_WAIT_L(n) asm volatile("s_waitcnt lgkmcnt(" #n ")" ::: "memory")
#define PG8_BAR __builtin_amdgcn_s_barrier()
#define PG8_SCHED __builtin_amdgcn_sched_barrier(0)
    Unit cur, nxt; int ui = 0;
    if (!S.next(0, cur)) return;
    f32x4 acc[2][2][4][2];
#pragma unroll
    for (int a = 0; a < 2; ++a)
#pragma unroll
        for (int b = 0; b < 2; ++b)
#pragma unroll
            for (int m = 0; m < 4; ++m)
#pragma unroll
                for (int n = 0; n < 2; ++n) acc[a][b][m][n] = (f32x4){0.f, 0.f, 0.f, 0.f};
    bf16x8 At[4][2], B0[2][2], B1[2][2];
    const char* cA = (const char*)g.A + (size_t)cur.pm * tstep; const char* cB = (const char*)g.Bt + (size_t)cur.pn * tstep;
    S.a_ready(cur);
    if constexpr (SP2) {
        PG8_STAGE(PG8_SB(0, 0), cB, voffB); PG8_STAGE(PG8_SB(0, 1), cB + hstep, voffB); PG8_STAGE(PG8_SA(0, 0), cA, voffA); PG8_STAGE(PG8_SA(0, 1), cA + hstep, voffA);
        if (wr == 1) PG8_BAR;
        PG8_WAIT_V(2); PG8_BAR;
        PG8_STAGE(PG8_SB(1, 0), cB + kstep, voffB); PG8_STAGE(PG8_SA(1, 0), cA + kstep, voffA); PG8_STAGE(PG8_SB(1, 1), cB + hstep + kstep, voffB);
        PG8_WAIT_V(6); PG8_BAR;
    } else {
        PG8_STAGE(PG8_SB(0, 0), cB, voffB); PG8_STAGE(PG8_SA(0, 0), cA, voffA); PG8_STAGE(PG8_SB(0, 1), cB + hstep, voffB); PG8_STAGE(PG8_SA(0, 1), cA + hstep, voffA);
        if (wr == 1) PG8_BAR;
        PG8_WAIT_V(4); PG8_BAR;
        PG8_STAGE(PG8_SB(1, 0), cB + kstep, voffB); PG8_STAGE(PG8_SA(1, 0), cA + kstep, voffA); PG8_STAGE(PG8_SB(1, 1), cB + hstep + kstep, voffB);
        PG8_WAIT_V(6); PG8_BAR;
    }
    for (;;) {
        const bool has_next = S.next(ui + 1, nxt);
        const char* nA = has_next ? (const char*)g.A + (size_t)nxt.pm * tstep : cA; const char* nB = has_next ? (const char*)g.Bt + (size_t)nxt.pn * tstep : cB;
        for (int t = 0; t < nt; t += 2) {
            const bool last = (t == nt - 2);
            const char* a1 = cA + (size_t)(t + 1) * kstep;
            const char* a2 = last ? nA : cA + (size_t)(t + 2) * kstep; const char* b2 = last ? nB : cB + (size_t)(t + 2) * kstep;
            const char* a3 = a2 + kstep; const char* b3 = b2 + kstep;
            if (last && has_next) S.a_ready(nxt);
            if constexpr (SP2) {
            PG8_LDB(B0, 0, 0); PG8_LDB(B1, 0, 1); PG8_SCHED; PG8_LDA(At, 0, 0); PG8_STAGE(PG8_SA(1, 1), a1 + hstep, voffA);
            PG8_WAIT_V(8); PG8_WAIT_L(0); PG8_BAR; PG8_MMA(0, 0, At, B0); PG8_MMA(0, 1, At, B1); PG8_BAR; PG8_SCHED;
            PG8_LDA(At, 0, 1); PG8_STAGE(PG8_SB(0, 0), b2, voffB); PG8_STAGE(PG8_SB(0, 1), b2 + hstep, voffB); PG8_STAGE(PG8_SA(0, 0), a2, voffA);
            PG8_WAIT_V(8); PG8_WAIT_L(0); PG8_BAR; PG8_MMA(1, 0, At, B0); PG8_MMA(1, 1, At, B1); PG8_BAR; PG8_SCHED;
            PG8_LDB(B0, 1, 0); PG8_LDB(B1, 1, 1); PG8_SCHED; PG8_LDA(At, 1, 0); PG8_STAGE(PG8_SA(0, 1), a2 + hstep, voffA);
            PG8_WAIT_V(8); PG8_WAIT_L(0); PG8_BAR; PG8_MMA(0, 0, At, B0); PG8_MMA(0, 1, At, B1); PG8_BAR; PG8_SCHED;
            PG8_LDA(At, 1, 1); PG8_STAGE(PG8_SB(1, 0), b3, voffB); PG8_STAGE(PG8_SB(1, 1), b3 + hstep, voffB); PG8_STAGE(PG8_SA(1, 0), a3, voffA);
            PG8_WAIT_V(8); PG8_WAIT_L(0); PG8_BAR; PG8_MMA(1, 0, At, B0); PG8_MMA(1, 1, At, B1); PG8_BAR; PG8_SCHED;
            } else {
            PG8_LDB(B0, 0, 0); PG8_SCHED; PG8_LDA(At, 0, 0); PG8_STAGE(PG8_SA(1, 1), a1 + hstep, voffA);
            PG8_WAIT_L(8); PG8_BAR; PG8_WAIT_L(0); PG8_MMA(0, 0, At, B0); PG8_BAR; PG8_SCHED;
            PG8_LDB(B1, 0, 1); PG8_STAGE(PG8_SB(0, 0), b2, voffB);
            PG8_BAR; PG8_WAIT_L(0); PG8_MMA(0, 1, At, B1); PG8_BAR;
            PG8_LDA(At, 0, 1); PG8_STAGE(PG8_SA(0, 0), a2, voffA);
            PG8_BAR; PG8_WAIT_L(0); PG8_MMA(1, 0, At, B0); PG8_BAR; PG8_SCHED;
            PG8_STAGE(PG8_SB(0, 1), b2 + hstep, voffB);
            PG8_WAIT_V(6); PG8_BAR; PG8_MMA(1, 1, At, B1); PG8_BAR;
            PG8_LDB(B0, 1, 0); PG8_SCHED; PG8_LDA(At, 1, 0); PG8_STAGE(PG8_SA(0, 1), a2 + hstep, voffA);
            PG8_WAIT_L(8); PG8_BAR; PG8_WAIT_L(0); PG8_MMA(0, 0, At, B0); PG8_BAR; PG8_SCHED;
            PG8_LDB(B1, 1, 1); PG8_STAGE(PG8_SB(1, 0), b3, voffB);
            PG8_BAR; PG8_WAIT_L(0); PG8_MMA(0, 1, At, B1); PG8_BAR;
            PG8_LDA(At, 1, 1); PG8_STAGE(PG8_SA(1, 0), a3, voffA);
            PG8_BAR; PG8_WAIT_L(0); PG8_MMA(1, 0, At, B0); PG8_BAR; PG8_SCHED;
            PG8_STAGE(PG8_SB(1, 1), b3 + hstep, voffB);
            PG8_WAIT_V(6); PG8_BAR; PG8_MMA(1, 1, At, B1); PG8_BAR;
            }
        }
        if constexpr (ALIGN_EPI) { if (wr == 0) PG8_BAR; }
        if constexpr (!Epi::AFTER_DRAIN) { E(acc, cur, wr, wc, fr, fq); S.done(cur); }
        if (!has_next) break;
#pragma unroll
        for (int a = 0; a < 2; ++a)
#pragma unroll
            for (int b = 0; b < 2; ++b)
#pragma unroll
                for (int m = 0; m < 4; ++m)
#pragma unroll
                    for (int n = 0; n < 2; ++n) acc[a][b][m][n] = (f32x4){0.f, 0.f, 0.f, 0.f};
        cur = nxt; cA = nA; cB = nB; ++ui;
        if constexpr (ALIGN_EPI) { if (wr == 1) PG8_BAR; }
    }
    PG8_WAIT_V(0);
    if constexpr (!ALIGN_EPI) { if (wr == 0) PG8_BAR; }
    PG8_BAR;
    if constexpr (Epi::AFTER_DRAIN) { E.fused(acc, cur, wr, wc, fr, fq, lds, wid, lane); S.done(cur); }
#undef PG8_SA
#undef PG8_SB
#undef PG8_STAGE
#undef PG8_LDA
#undef PG8_LDB
#undef PG8_MMA
#undef PG8_WAIT_V
#undef PG8_WAIT_L
#undef PG8_BAR
#undef PG8_SCHED
}
}

#include <hip/hip_bf16.h>
#include <cmath>
namespace attn_body {
using bf16=__hip_bfloat16;
using bf16x8=__attribute__((ext_vector_type(8)))short;
using s16x4=__attribute__((ext_vector_type(4)))short;
using f32x16=__attribute__((ext_vector_type(16)))float;
using u32x4=__attribute__((ext_vector_type(4)))unsigned;
constexpr int D=64,QP=256,KP=128,VP=128,OP=1024;
constexpr int NW=8,QBLK=32,QB=QBLK*NW,KVBLK=64;
constexpr int ATTN_UNIT_ROWS=QB;
__device__ __forceinline__ int crow(int r,int hi){return (r&3)+8*(r>>2)+4*hi;}
#define SBAR() __builtin_amdgcn_sched_barrier(0)
constexpr int NSLOT=3, SLOTB=8192;
constexpr int LDS_K=0, LDS_V=NSLOT*SLOTB, LDS_WS=2*NSLOT*SLOTB, LDS_OST=LDS_WS+NW*64*4, LDS_BYTES=LDS_OST+NW*4096;
constexpr float C2=0.125f*1.4426950408889634f;
__device__ __forceinline__ void glds16(const void*gsrc,unsigned lds_dst){unsigned keep;
  asm volatile("s_mov_b32 %0, m0\n\ts_mov_b32 m0, %2\n\ts_nop 0\n\tglobal_load_lds_dwordx4 %1, off\n\ts_mov_b32 m0, %0":"=&s"(keep):"v"(gsrc),"s"(lds_dst):"memory");}
__device__ __forceinline__ float max3f(float a,float b,float c){float r;asm("v_max3_f32 %0, %1, %2, %3":"=v"(r):"v"(a),"v"(b),"v"(c));return r;}
__device__ __forceinline__ float max2f(float a,float b){float r;asm("v_max_f32_e32 %0, %1, %2":"=v"(r):"v"(a),"v"(b));return r;}
__device__ __forceinline__ float fadd_s(float a,float b){float r;asm("v_add_f32_e32 %0, %1, %2":"=v"(r):"v"(a),"v"(b));return r;}
__device__ __forceinline__ float fsub_s(float a,float b){float r;asm("v_sub_f32_e32 %0, %1, %2":"=v"(r):"v"(a),"v"(b));return r;}
typedef float f32x2_t __attribute__((ext_vector_type(2))); typedef __bf16 bf16x2_t __attribute__((ext_vector_type(2)));
__device__ __forceinline__ unsigned cvtpk_s(float lo,float hi){f32x2_t v={lo,hi};bf16x2_t b=__builtin_convertvector(v,bf16x2_t);return __builtin_bit_cast(unsigned,b);}
#define WAIT_BAR(N) asm volatile("s_waitcnt vmcnt(" #N ") lgkmcnt(0)\n\ts_barrier":::"memory")

__device__ __forceinline__ void qkt(f32x16&p0,f32x16&p1,const char*Kslot,const bf16x8*qr,const f32x16&negm,int r32,int hi){
  const char*kb=Kslot+hi*1024+r32*16;
  #pragma unroll
  for(int d0=0;d0<4;++d0){
    const bf16x8 b0=*reinterpret_cast<const bf16x8*>(kb+d0*2048);
    const bf16x8 b1=*reinterpret_cast<const bf16x8*>(kb+d0*2048+512);
    if(d0==0){p0=__builtin_amdgcn_mfma_f32_32x32x16_bf16(b0,qr[0],negm,0,0,0);p1=__builtin_amdgcn_mfma_f32_32x32x16_bf16(b1,qr[0],negm,0,0,0);}
    else{p0=__builtin_amdgcn_mfma_f32_32x32x16_bf16(b0,qr[d0],p0,0,0,0);p1=__builtin_amdgcn_mfma_f32_32x32x16_bf16(b1,qr[d0],p1,0,0,0);}}
}
typedef __attribute__((address_space(3))) const char* lds_cptr;
typedef short v4i16_t __attribute__((ext_vector_type(4)));
__device__ __forceinline__ void kload8(bf16x8*kf,lds_cptr kp){
  kf[0]=*(const __attribute__((address_space(3))) bf16x8*)(kp);      kf[1]=*(const __attribute__((address_space(3))) bf16x8*)(kp+512);
  kf[2]=*(const __attribute__((address_space(3))) bf16x8*)(kp+2048); kf[3]=*(const __attribute__((address_space(3))) bf16x8*)(kp+2560);
  kf[4]=*(const __attribute__((address_space(3))) bf16x8*)(kp+4096); kf[5]=*(const __attribute__((address_space(3))) bf16x8*)(kp+4608);
  kf[6]=*(const __attribute__((address_space(3))) bf16x8*)(kp+6144); kf[7]=*(const __attribute__((address_space(3))) bf16x8*)(kp+6656);
}
__device__ __forceinline__ void kload2(bf16x8*kf,lds_cptr kp,int j){ kf[2*j]=*(const __attribute__((address_space(3))) bf16x8*)(kp+j*2048); kf[2*j+1]=*(const __attribute__((address_space(3))) bf16x8*)(kp+j*2048+512); }
__device__ __forceinline__ s16x4 vtr(lds_cptr p){ return __builtin_bit_cast(s16x4,__builtin_amdgcn_ds_read_tr16_b64_v4i16((__attribute__((address_space(3))) v4i16_t*)p)); }
__device__ __forceinline__ float rowmax(const f32x16&p0,const f32x16&p1){
  float a=max3f(p0[0],p0[1],p1[0]),b=max3f(p0[2],p0[3],p1[1]);a=max3f(a,p1[2],p1[3]);
  #pragma unroll
  for(int r=4;r<16;r+=4){a=max3f(a,p0[r],p0[r+1]);b=max3f(b,p0[r+2],p0[r+3]);a=max3f(a,p1[r],p1[r+1]);b=max3f(b,p1[r+2],p1[r+3]);}
  const float m=max2f(a,b);
  auto rr=__builtin_amdgcn_permlane32_swap(__float_as_uint(m),__float_as_uint(m),false,false);
  return max2f(__uint_as_float(rr[0]),__uint_as_float(rr[1]));
}
__device__ __forceinline__ void pv(f32x16*o,int vb,bf16x8 pa0,bf16x8 pa1,bf16x8 pa2,bf16x8 pa3){
  #pragma unroll
  for(int d0=0;d0<2;++d0){s16x4 lo[4],hi[4];
    #pragma unroll
    for(int ks=0;ks<4;++ks){
      asm volatile("ds_read_b64_tr_b16 %0,%1 offset:%c2":"=&v"(lo[ks]):"v"(vb),"i"(d0*4096+ks*1024):"memory");
      asm volatile("ds_read_b64_tr_b16 %0,%1 offset:%c2":"=&v"(hi[ks]):"v"(vb),"i"(d0*4096+ks*1024+512):"memory");}
    asm volatile("s_waitcnt lgkmcnt(0)":::"memory");SBAR();
    #define PK(k) (bf16x8){lo[k][0],lo[k][1],lo[k][2],lo[k][3],hi[k][0],hi[k][1],hi[k][2],hi[k][3]}
    o[d0]=__builtin_amdgcn_mfma_f32_32x32x16_bf16(pa0,PK(0),o[d0],0,0,0);
    o[d0]=__builtin_amdgcn_mfma_f32_32x32x16_bf16(pa1,PK(1),o[d0],0,0,0);
    o[d0]=__builtin_amdgcn_mfma_f32_32x32x16_bf16(pa2,PK(2),o[d0],0,0,0);
    o[d0]=__builtin_amdgcn_mfma_f32_32x32x16_bf16(pa3,PK(3),o[d0],0,0,0);
    #undef PK
  }
}

#ifndef ATTN_STORE16
#define ATTN_STORE16(p,v) (*(u32x4*)(p)=(v))
#endif
template<int THRL> __device__ __forceinline__ void attn_unit(const long rowbase,const int h,const int q0,const int NT,const bf16*Q,const bf16*__restrict__ K,const bf16*__restrict__ V,bf16*O,char*shm){
  int tid_=threadIdx.x; asm volatile("":"+v"(tid_)); const int tid=tid_,lane=tid&63,r32=lane&31,hi=lane>>5; const int wid=__builtin_amdgcn_readfirstlane(tid>>6);
  const bf16*Qw=Q+(rowbase+q0+wid*QBLK)*QP+h*D;
  const bf16*Kh=K+rowbase*KP+(h>>1)*D,*Vh=V+rowbase*VP+(h>>1)*D;
  const unsigned lds0=(unsigned)(uintptr_t)shm;
  float*wsf=(float*)(shm+LDS_WS)+wid*64;
  const bf16*ksrc=Kh+(long)lane*KP+wid*8;
  const bf16*vsrc=Vh+(long)(16*(wid&3)+(lane>>2))*VP+(wid>>2)*32+(lane&3)*8;
  const unsigned kdst=lds0+LDS_K+wid*1024, vdst=lds0+LDS_V+wid*1024;
  #define DMA_K(t,slot) glds16(ksrc+(long)(t)*KVBLK*KP,(unsigned)__builtin_amdgcn_readfirstlane(kdst+(slot)))
  #define DMA_V(t,slot) glds16(vsrc+(long)(t)*KVBLK*VP,(unsigned)__builtin_amdgcn_readfirstlane(vdst+(slot)))
  const int vb0=(int)(lds0+LDS_V)+((lane>>4)&1)*32+(lane&3)*8+(4*hi+((lane&15)>>2))*64;
  const char*Kbase=shm+LDS_K; bf16x8 kf[8];
  const lds_cptr shm3=(lds_cptr)shm; const lds_cptr kp0=shm3+LDS_K+hi*1024+r32*16; const lds_cptr vp0=shm3+LDS_V+((lane>>4)&1)*32+(lane&3)*8+(4*hi+((lane&15)>>2))*64;
  DMA_K(0,0);DMA_V(0,0);DMA_K(1,SLOTB);
  bf16x8 qr[4];
  #pragma unroll
  for(int d0=0;d0<4;++d0)qr[d0]=*reinterpret_cast<const bf16x8*>(&Qw[(long)r32*QP+d0*16+hi*8]);
  float mhat=0.f,l_reg=0.f;f32x16 o[2];o[0]=f32x16{};o[1]=f32x16{};f32x16 negm=f32x16{};asm volatile("":"+v"(negm));
  #define CMASK(P0,P1,t) do{}while(0)
  bool resc=false;
  #define START(P0,P1) do{ const float rm=rowmax(P0,P1); resc=false; \
    { const float dl=rm; mhat=fadd_s(mhat,dl); \
      _Pragma("unroll") for(int r=0;r<16;++r){P0[r]=fsub_s(P0[r],dl);P1[r]=fsub_s(P1[r],dl);} \
      _Pragma("unroll") for(int r=0;r<16;++r)negm[r]=-mhat; asm volatile("":"+v"(negm)); } \
    _Pragma("unroll") for(int r=0;r<16;++r)P0[r]=__builtin_amdgcn_exp2f(P0[r]); }while(0)
  #define RESC() do{ if(resc){ asm volatile("s_waitcnt lgkmcnt(0)":::"memory"); \
      _Pragma("unroll") for(int d_=0;d_<2;++d_) _Pragma("unroll") for(int r=0;r<16;++r)o[d_][r]*=wsf[crow(r,hi)]; } }while(0)
  f32x16 pA0,pA1,pB0,pB1;
  int sl_prev=0,sl_cur=0,sl_next=SLOTB;
  #define ROT() do{sl_prev=sl_cur;sl_cur=sl_next;sl_next=(sl_next==(NSLOT-1)*SLOTB)?0:sl_next+SLOTB;}while(0)
  DMA_K(2,2*SLOTB);
  WAIT_BAR(3);
  qkt(pA0,pA1,Kbase,qr,negm,r32,hi);asm volatile("s_nop 15\n\ts_nop 7":"+v"(pA0),"+v"(pA1));CMASK(pA0,pA1,0);
  START(pA0,pA1);
  _Pragma("unroll") for(int r=0;r<16;++r)pA1[r]=__builtin_amdgcn_exp2f(pA1[r]);
  WAIT_BAR(0);
  DMA_K(3,0);DMA_V(1,SLOTB);
  ROT();
  kload8(kf,kp0+sl_cur);
  WAIT_BAR(2);
  s16x4 vlo[8],vhi[8]; u32x4 pw0,pw1,pw2,pw3;
  #define PKW(P,B) cvtpk_s(P[B],P[B+1])
  #define PAF(k) __builtin_bit_cast(bf16x8,pw##k)
  #define VFR(i) (bf16x8){vlo[i][0],vlo[i][1],vlo[i][2],vlo[i][3],vhi[i][0],vhi[i][1],vhi[i][2],vhi[i][3]}
  #define PIN(x) asm volatile("":"+v"(x))
  #define MX3(a,b,c) __builtin_fmaxf(__builtin_fmaxf((a),(b)),(c))
  #define GAPA(MF,A0,A1,A2,A3,W0,W1,PW) do{ MF; sacc+=A0; sacc+=A1; sacc+=A2; sacc+=A3; PIN(sacc); W0; W1; PIN(PW); SBAR(); }while(0)
  #define EX(v) __builtin_amdgcn_exp2f(v)
  #define GAPB(MF,X,B) do{ MF; X[B]=EX(X[B]); X[B+1]=EX(X[B+1]); X[B+2]=EX(X[B+2]); X[B+3]=EX(X[B+3]); PIN(X); SBAR(); }while(0)
  #define VRD(i) do{ vlo[i]=vtr(vp_+(((i)>>2)*4096+((i)&3)*1024)); vhi[i]=vtr(vp_+(((i)>>2)*4096+((i)&3)*1024+512)); }while(0)
  #define KRD(G,j) do{ if(G){ kload2(kf,kp0+sl_next,j); SBAR(); } }while(0)
  #define STEP(C0,C1,P0,P1,t,GK,GV,GL) do{ SBAR(); \
    const lds_cptr vp_=vp0+sl_prev; \
    VRD(0); SBAR(); float sacc=(P0[0]+P0[1]); \
    GAPA(C0=__builtin_amdgcn_mfma_f32_32x32x16_bf16(kf[0],qr[0],negm,0,0,0), P0[2],P0[3],P0[4],P0[5],     pw0[0]=PKW(P0,0), pw0[1]=PKW(P0,2), pw0); \
    VRD(4); SBAR(); GAPA(C1=__builtin_amdgcn_mfma_f32_32x32x16_bf16(kf[1],qr[0],negm,0,0,0), P0[6],P0[7],P0[8],P0[9],     pw0[2]=PKW(P0,4), pw0[3]=PKW(P0,6), pw0); \
    VRD(1); SBAR(); GAPA(C0=__builtin_amdgcn_mfma_f32_32x32x16_bf16(kf[2],qr[1],C0,0,0,0),   P0[10],P0[11],P0[12],P0[13], pw1[0]=PKW(P0,8), pw1[1]=PKW(P0,10), pw1); \
    VRD(5); SBAR(); GAPA(C1=__builtin_amdgcn_mfma_f32_32x32x16_bf16(kf[3],qr[1],C1,0,0,0),   P0[14],P0[15],P1[0],P1[1],   pw1[2]=PKW(P0,12),pw1[3]=PKW(P0,14), pw1); \
    VRD(2); SBAR(); GAPA(C0=__builtin_amdgcn_mfma_f32_32x32x16_bf16(kf[4],qr[2],C0,0,0,0),   P1[2],P1[3],P1[4],P1[5],     pw2[0]=PKW(P1,0), pw2[1]=PKW(P1,2), pw2); \
    VRD(6); SBAR(); GAPA(C1=__builtin_amdgcn_mfma_f32_32x32x16_bf16(kf[5],qr[2],C1,0,0,0),   P1[6],P1[7],P1[8],P1[9],     pw2[2]=PKW(P1,4), pw2[3]=PKW(P1,6), pw2); \
    VRD(3); SBAR(); GAPA(C0=__builtin_amdgcn_mfma_f32_32x32x16_bf16(kf[6],qr[3],C0,0,0,0),   P1[10],P1[11],P1[12],P1[13], pw3[0]=PKW(P1,8), pw3[1]=PKW(P1,10), pw3); \
    VRD(7); SBAR(); GAPA(C1=__builtin_amdgcn_mfma_f32_32x32x16_bf16(kf[7],qr[3],C1,0,0,0),   P1[14],P1[15],0.f,0.f,       pw3[2]=PKW(P1,12),pw3[3]=PKW(P1,14), pw3); \
    l_reg+=sacc; \
    if(GK){DMA_K((t)+3,sl_cur);} if(GV){DMA_V((t)+1,sl_next);} \
    CMASK(C0,C1,t); \
    { float a=MX3(C0[0],C0[1],C1[0]),b=MX3(C0[2],C0[3],C1[1]); a=MX3(a,C1[2],C1[3]); \
      _Pragma("unroll") for(int r=4;r<16;r+=4){a=MX3(a,C0[r],C0[r+1]);b=MX3(b,C0[r+2],C0[r+3]);a=MX3(a,C1[r],C1[r+1]);b=MX3(b,C1[r+2],C1[r+3]);} \
      float rm=__builtin_fmaxf(a,b); { auto rr=__builtin_amdgcn_permlane32_swap(__float_as_uint(rm),__float_as_uint(rm),false,false); rm=__builtin_fmaxf(__uint_as_float(rr[0]),__uint_as_float(rr[1])); } \
      resc=false; \
      if(__builtin_expect(__any(rm>(float)THRL),0)){ const float dl=__builtin_fmaxf(rm,0.f); mhat+=dl; \
        _Pragma("unroll") for(int r=0;r<16;++r){C0[r]-=dl;C1[r]-=dl;} \
        _Pragma("unroll") for(int r=0;r<16;++r)negm[r]=-mhat; asm volatile("":"+v"(negm)); \
        const float f=__builtin_amdgcn_exp2f(-dl); l_reg*=f; if(hi==0)wsf[r32]=f; resc=true; } } \
    SBAR(); \
    GAPB(o[0]=__builtin_amdgcn_mfma_f32_32x32x16_bf16(PAF(0),VFR(0),o[0],0,0,0), C0,0); \
    GAPB(o[1]=__builtin_amdgcn_mfma_f32_32x32x16_bf16(PAF(0),VFR(4),o[1],0,0,0), C0,4); \
    KRD(GL,0); GAPB(o[0]=__builtin_amdgcn_mfma_f32_32x32x16_bf16(PAF(1),VFR(1),o[0],0,0,0), C0,8); \
    KRD(GL,1); GAPB(o[1]=__builtin_amdgcn_mfma_f32_32x32x16_bf16(PAF(1),VFR(5),o[1],0,0,0), C0,12); \
    KRD(GL,2); GAPB(o[0]=__builtin_amdgcn_mfma_f32_32x32x16_bf16(PAF(2),VFR(2),o[0],0,0,0), C1,0); \
    KRD(GL,3); GAPB(o[1]=__builtin_amdgcn_mfma_f32_32x32x16_bf16(PAF(2),VFR(6),o[1],0,0,0), C1,4); \
    GAPB(o[0]=__builtin_amdgcn_mfma_f32_32x32x16_bf16(PAF(3),VFR(3),o[0],0,0,0), C1,8); \
    GAPB(o[1]=__builtin_amdgcn_mfma_f32_32x32x16_bf16(PAF(3),VFR(7),o[1],0,0,0), C1,12); \
    }while(0)
  int t=1;
  #undef CMASK
  #define CMASK(P0,P1,t) do{}while(0)
  for(;t+5<NT;t+=2){
    STEP(pB0,pB1,pA0,pA1,t,true,true,true);     WAIT_BAR(2); RESC(); ROT();
    STEP(pA0,pA1,pB0,pB1,t+1,true,true,true);   WAIT_BAR(2); RESC(); ROT();
  }
  #undef CMASK
  #define CMASK(P0,P1,t) do{}while(0)
  #define ENDW(tt) do{ if((tt)+3<NT){WAIT_BAR(2);} else if((tt)+2<NT){WAIT_BAR(1);} else {WAIT_BAR(0);} }while(0)
  for(;t+1<NT;t+=2){
    STEP(pB0,pB1,pA0,pA1,t,(t+3<NT),(t+1<NT),(t+1<NT));       ENDW(t);   RESC(); ROT();
    STEP(pA0,pA1,pB0,pB1,t+1,(t+4<NT),(t+2<NT),(t+2<NT));     ENDW(t+1); RESC(); ROT();
  }
  STEP(pB0,pB1,pA0,pA1,NT-1,false,false,false); RESC();
  { float sacc=pB0[0]+pB0[1]; _Pragma("unroll") for(int r=2;r<16;++r)sacc+=pB0[r]; _Pragma("unroll") for(int r=0;r<16;++r)sacc+=pB1[r]; l_reg+=sacc;
    pw0=(u32x4){PKW(pB0,0),PKW(pB0,2),PKW(pB0,4),PKW(pB0,6)};pw1=(u32x4){PKW(pB0,8),PKW(pB0,10),PKW(pB0,12),PKW(pB0,14)};pw2=(u32x4){PKW(pB1,0),PKW(pB1,2),PKW(pB1,4),PKW(pB1,6)};pw3=(u32x4){PKW(pB1,8),PKW(pB1,10),PKW(pB1,12),PKW(pB1,14)};
    SBAR(); pv(o,vb0+sl_cur,PAF(0),PAF(1),PAF(2),PAF(3)); }
  #undef PKW
  #undef PAF
  #undef VFR
  #undef PIN
  #undef MX3
  #undef GAPA
  #undef GAPB
  #undef EX
  #undef VRD
  #undef KRD
  #undef STEP
  #undef ENDW
  {auto rr=__builtin_amdgcn_permlane32_swap(__float_as_uint(l_reg),__float_as_uint(l_reg),false,false);l_reg=__uint_as_float(rr[0])+__uint_as_float(rr[1]);}
  if(hi==0)wsf[32+r32]=l_reg;asm volatile("s_waitcnt lgkmcnt(0)":::"memory");
  float rli[16];
  #pragma unroll
  for(int r=0;r<16;++r)rli[r]=__builtin_amdgcn_rcpf(wsf[32+crow(r,hi)]);
  bf16*Ow=O+(rowbase+q0+wid*QBLK)*OP+h*D;
  { bf16*stg=(bf16*)(shm+LDS_OST)+wid*2048;
    #pragma unroll
    for(int r=0;r<16;++r){const int orow=crow(r,hi);
      #pragma unroll
      for(int d0=0;d0<2;++d0)stg[orow*64+d0*32+r32]=__float2bfloat16(o[d0][r]*rli[r]);}
    asm volatile("s_waitcnt lgkmcnt(0)":::"memory");
    #pragma unroll
    for(int i=0;i<4;++i){const int row=i*8+(lane>>3),ch=lane&7; const u32x4 v=*(const u32x4*)(stg+row*64+ch*8); ATTN_STORE16(Ow+(long)row*OP+ch*8,v);} }
  asm volatile("s_waitcnt lgkmcnt(0)\n\ts_barrier":::"memory");
  #undef DMA_K
  #undef DMA_V
  #undef CMASK
  #undef START
  #undef RESC
  #undef ROT
}
constexpr int ATTN_LDS_BYTES=LDS_BYTES;
#undef SBAR
#undef WAIT_BAR
}

#define GAS __attribute__((address_space(1)))
#define LAS __attribute__((address_space(3)))
typedef unsigned short bf16;
typedef unsigned v4u __attribute__((ext_vector_type(4)));
typedef float f32x4 __attribute__((ext_vector_type(4)));
typedef short bf16x8 __attribute__((ext_vector_type(8)));
typedef GAS unsigned gu32;
typedef GAS unsigned long long gu64;
#define RLX_AGENT __ATOMIC_RELAXED, __HIP_MEMORY_SCOPE_AGENT
#define LDS_WAIT() asm volatile("s_waitcnt lgkmcnt(0)" ::: "memory")
#define VM_WAIT() asm volatile("s_waitcnt vmcnt(0)" ::: "memory")
__device__ __forceinline__ unsigned long long rt() { return __builtin_amdgcn_s_memrealtime(); }
__device__ __forceinline__ unsigned f2bf(float f) { unsigned u = __builtin_bit_cast(unsigned, f); return (u + 0x7fffu + ((u >> 16) & 1u)) >> 16; }
__device__ __forceinline__ unsigned pk2(float lo, float hi) { return f2bf(lo) | (f2bf(hi) << 16); }

#define XB_TMO      128
#define XB_XCNT(j)  (256  + 64 * (j))
#define XB_XSUB(j)  (1280 + 64 * (j))
#define XB_XGEN(j)  (2304 + 64 * (j))
#define XB_TOP      3328
#define XB_TOPGEN   3392
#define XCD_BAR_WORDS 3456
#define XB_SPIN_CAP (1u << 18)

__device__ __forceinline__ unsigned xb_ld(unsigned* p)              { return __hip_atomic_load(p, __ATOMIC_RELAXED, __HIP_MEMORY_SCOPE_AGENT); }
__device__ __forceinline__ unsigned xb_add(unsigned* p, unsigned v) { return __hip_atomic_fetch_add(p, v, __ATOMIC_RELAXED, __HIP_MEMORY_SCOPE_AGENT); }
__device__ __forceinline__ unsigned xb_xcc_id() { return (unsigned)__builtin_amdgcn_s_getreg((3 << 11) | 20) & 0xFu; }
#define XB_SPIN(cond, bar) do { unsigned _sp = 0; while (cond) { __builtin_amdgcn_s_sleep(1); \
    if ((++_sp & 255u) == 0u) { if (xb_ld(&(bar)[XB_TMO])) break; if (_sp > XB_SPIN_CAP) { atomicAdd(&(bar)[XB_TMO], 1u); break; } } } } while (0)

struct XcdBarrier {
    unsigned* bar; unsigned x;
    volatile LAS unsigned* st;
};

__device__ __forceinline__ XcdBarrier xcd_barrier_post(unsigned* bar, volatile LAS unsigned* st) {
    XcdBarrier b; b.bar = bar; b.x = xb_xcc_id(); b.st = st;
    if (threadIdx.x == 0) (void)xb_add(&bar[XB_XCNT(b.x)], 1u);
    return b;
}
__device__ __forceinline__ void xcd_barrier_complete(unsigned* bar, unsigned x, unsigned& nloc, unsigned& nx) {
    const unsigned G = gridDim.x * gridDim.y * gridDim.z;
    unsigned sum, cnt, mine, sp = 0u;
    for (;;) {
        sum = 0u; cnt = 0u; mine = 0u;
#pragma unroll
        for (unsigned j = 0; j < 16; ++j) { const unsigned c = xb_ld(&bar[XB_XCNT(j)]); sum += c; cnt += (c > 0u) ? 1u : 0u; mine = (j == x) ? c : mine; }
        if (sum == G) break;
        __builtin_amdgcn_s_sleep(1);
        if ((++sp & 255u) == 0u) { if (xb_ld(&bar[XB_TMO])) break; if (sp > XB_SPIN_CAP) { atomicAdd(&bar[XB_TMO], 1u); break; } }
    }
    nloc = mine > 0u ? mine : 1u; nx = cnt > 0u ? cnt : 1u;
}

__device__ __forceinline__ void xcd_barrier(const XcdBarrier& b) {
    asm volatile("s_waitcnt vmcnt(0)" ::: "memory");
    __syncthreads();
    if (threadIdx.x == 0) {
        unsigned* bar = b.bar;
        __builtin_amdgcn_s_waitcnt(0);
        unsigned nloc = b.st[0], nx = b.st[1];
        if (nloc == 0u) { xcd_barrier_complete(bar, b.x, nloc, nx); b.st[0] = nloc; b.st[1] = nx; }
        const unsigned old = xb_add(&bar[XB_XSUB(b.x)], 1u);
        const unsigned gen = old / nloc;
        if (old + 1u == (gen + 1u) * nloc) {
            __builtin_amdgcn_fence(__ATOMIC_RELEASE, "agent");
            asm volatile("s_waitcnt vmcnt(0)" ::: "memory");
            const unsigned og = xb_add(&bar[XB_TOP], 1u);
            const unsigned tg = og / nx;
            if (og + 1u == (tg + 1u) * nx) xb_add(&bar[XB_TOPGEN], 1u);
            else XB_SPIN(xb_ld(&bar[XB_TOPGEN]) == tg, bar);
            __builtin_amdgcn_fence(__ATOMIC_ACQUIRE, "agent");
            xb_add(&bar[XB_XGEN(b.x)], 1u);
            asm volatile("s_waitcnt vmcnt(0)" ::: "memory");
        } else {
            XB_SPIN(xb_ld(&bar[XB_XGEN(b.x)]) == gen, bar);
            __builtin_amdgcn_fence(__ATOMIC_ACQUIRE, "agent");
            asm volatile("s_waitcnt vmcnt(0)" ::: "memory");
        }
    }
    __syncthreads();
}

__device__ __forceinline__ float bf2f(unsigned short h) { return __builtin_bit_cast(float, (unsigned)h << 16); }
__device__ __forceinline__ float bflo(unsigned w) { return __builtin_bit_cast(float, w << 16); }
__device__ __forceinline__ float bfhi(unsigned w) { return __builtin_bit_cast(float, w & 0xffff0000u); }
__device__ __forceinline__ float wave_sum(float v) {
#pragma unroll
    for (int o = 1; o < 64; o <<= 1) v += __shfl_xor(v, o);
    return v;
}
__device__ __forceinline__ float sigmoidf_(float x) { return __builtin_amdgcn_rcpf(1.0f + __expf(-x)); }
typedef float f32x16 __attribute__((ext_vector_type(16)));

struct Frame {
    LAS unsigned char* lds;
    volatile LAS unsigned* MISC;
    unsigned char* ws;
    int tid, lane, wave, vcu, G;
};
__device__ __forceinline__ void p0_transpose_item(const float* W, int ldw, int k0, int sc0, bf16* WT, int ldt, int dr0, LAS float* scr, int lane) {
#pragma unroll 8
    for (int i = 0; i < 32; ++i) { const int kk = 2 * i + (lane >> 5); scr[kk * 33 + (lane & 31)] = W[(size_t)(k0 + kk) * ldw + sc0 + (lane & 31)]; }
    LDS_WAIT(); asm volatile("" ::: "memory");
    const int c = lane & 7;
#pragma unroll
    for (int j = 0; j < 4; ++j) { const int n = (lane >> 3) + 8 * j; const LAS float* s = scr + (8 * c) * 33 + n;
        v4u o; o.x = pk2(s[0 * 33], s[1 * 33]); o.y = pk2(s[2 * 33], s[3 * 33]); o.z = pk2(s[4 * 33], s[5 * 33]); o.w = pk2(s[6 * 33], s[7 * 33]);
        *(GAS v4u*)(WT + (size_t)(dr0 + n) * ldt + k0 + 8 * c) = o; }
    LDS_WAIT(); asm volatile("" ::: "memory");
}
__device__ __forceinline__ void s0_prologue(Frame& F) {
    LAS float* scr = (LAS float*)(F.lds + RING_OFF + F.wave * 16384);
    const int gw = F.vcu * NWAVES + F.wave, NGW = F.G * NWAVES, lane = F.lane;
    unsigned char* ws = F.ws;
    {
        float* modpart = (float*)(ws + SM_MODPART);
        for (int it = gw; it < DEPTH * 16 * 24; it += NGW) {
            const int l = it / (16 * 24), kc = (it / 24) % 16, jb = it % 24, j0 = jb * 256 + 4 * lane, k0 = kc * 64;
            const float c0 = inptr(F.lds, IN_C)[k0 + lane], c1 = inptr(F.lds, IN_C)[1024 + k0 + lane], c2 = inptr(F.lds, IN_CCTX)[k0 + lane];
            const float s0 = c0 * sigmoidf_(c0), s1 = c1 * sigmoidf_(c1), s2 = c2 * sigmoidf_(c2);
            f32x4 a0 = {0.f, 0.f, 0.f, 0.f}, a1 = a0, a2 = a0;
            const float* wp = inptr(F.lds, IN_WMOD) + ((size_t)l * 1024 + k0) * 6144 + j0;
#pragma unroll 16
            for (int kk = 0; kk < 64; ++kk) { const f32x4 w = *(const f32x4*)(wp + (size_t)kk * 6144);
                a0 += w * __shfl(s0, kk); a1 += w * __shfl(s1, kk); a2 += w * __shfl(s2, kk); }
            float* mp = modpart + ((size_t)(l * 16 + kc) * 3) * 6144 + j0;
            *(f32x4*)mp = a0; *(f32x4*)(mp + 6144) = a1; *(f32x4*)(mp + 2 * 6144) = a2;
        }
    }
    {
        constexpr int I_WINA = 16 * 16, I_WINB = 24 * 16, I_WFI = 176 * 16, I_WFO = 32 * 44, I_WO = 32 * 4, I_L = I_WINA + I_WINB + I_WFI + I_WFO + I_WO;
        for (int it = gw; it < DEPTH * I_L; it += NGW) {
            const int l = it / I_L; int r = it % I_L;
            bf16* WinT = (bf16*)(ws + WS_WIN + l * WIN_STRIDE); bf16* WoT = (bf16*)(ws + WS_WO + l * WO_STRIDE);
            bf16* WfiT = (bf16*)(ws + WS_WFI + l * WFI_STRIDE); bf16* WfoT = (bf16*)(ws + WS_WFO + l * WFO_STRIDE);
            const float* w_in = inptr(F.lds, IN_WIN) + (size_t)l * 1024 * DIN0;
            if (r < I_WINA) { const int kb = r / 16, nb = r % 16; p0_transpose_item(w_in, DIN0, 64 * kb, 32 * nb, WinT, 1024, 32 * nb, scr, lane); continue; } r -= I_WINA;
            if (r < I_WINB) { const int kb = r / 24, nb = r % 24; p0_transpose_item(w_in, DIN0, 64 * kb, 768 + 32 * nb, WinT, 1024, 1024 + 32 * nb, scr, lane); continue; } r -= I_WINB;
            if (r < I_WFI) { const int kb = r / 176, nb = r % 176, d0 = 32 * nb, pn = d0 >> 8, hb = (d0 >> 7) & 1, i0 = d0 & 127;
                p0_transpose_item(inptr(F.lds, IN_WFI) + (size_t)l * 1024 * 2 * DFF, 2 * DFF, 64 * kb, hb * DFF + 128 * pn + i0, WfiT, 1024, d0, scr, lane); continue; } r -= I_WFI;
            if (r < I_WFO) { const int kb = r / 32, nb = r % 32; p0_transpose_item(inptr(F.lds, IN_WFO) + (size_t)l * DFF * 1024, 1024, 64 * kb, 32 * nb, WfoT, DFF, 32 * nb, scr, lane); continue; } r -= I_WFO;
            { const int kb = r / 32, nb = r % 32; p0_transpose_item(inptr(F.lds, IN_WO) + (size_t)l * 1024 * 1024, 1024, 64 * kb, 32 * nb, WoT, 1024, 32 * nb, scr, lane); }
        }
    }
    {
        LAS float* tab = scr;
        { float sn, cs; sincospif((float)lane * (1.0f / 32.0f), &sn, &cs); tab[lane] = cs; tab[64 + lane] = sn; }
        LDS_WAIT(); asm volatile("" ::: "memory");
        for (int it = gw; it < DEPTH * 64; it += NGW) {
            const int l = it / 64, kb = (it / 4) % 16, h = it % 4, k = kb * 64 + lane;
            const float* src = inptr(F.lds, IN_WIN) + ((size_t)l * 1024 + k) * DIN0 + 512 + h * 64;
            float u[64];
#pragma unroll
            for (int c = 0; c < 16; ++c) { const f32x4 t = *(const f32x4*)(src + 4 * c); u[4 * c] = t[0]; u[4 * c + 1] = t[1]; u[4 * c + 2] = t[2]; u[4 * c + 3] = t[3]; }
            bf16* WinT = (bf16*)(ws + WS_WIN + l * WIN_STRIDE);
            for (int cp = 0; cp < 64; ++cp) { float ar = 0.f, ai = 0.f;
#pragma unroll
                for (int c = 0; c < 64; ++c) { const int j = (c * cp) & 63; ar += u[c] * tab[j]; ai -= u[c] * tab[64 + j]; }
                WinT[(size_t)(512 + h * 64 + cp) * 1024 + k] = (bf16)f2bf(ar); WinT[(size_t)(768 + h * 64 + cp) * 1024 + k] = (bf16)f2bf(ai); }
        }
        LDS_WAIT(); asm volatile("" ::: "memory");
    }
    for (int it = gw; it < DEPTH * 96 * 16; it += NGW) {
        const int l = it / (96 * 16), ib = (it / 16) % 96, nb = it % 16, i0 = ib * 8, n = nb * 64 + lane;
        const int br = i0 >> 8;
        const float* wo = inptr(F.lds, IN_WO) + (size_t)l * 1024 * 1024;
        float acc[8];
#pragma unroll
        for (int q = 0; q < 8; ++q) acc[q] = 0.f;
        if (br < 2) { const float* wx = (br == 0 ? inptr(F.lds, IN_WF) : inptr(F.lds, IN_WPW)) + (size_t)l * 65536 + (size_t)(i0 & 255) * 256;
            const float* wrow = wo + (size_t)(256 + br * 256) * 1024 + n;
#pragma unroll 4
            for (int j = 0; j < 256; ++j) { const float w = wrow[(size_t)j * 1024];
#pragma unroll
                for (int q = 0; q < 8; ++q) acc[q] += wx[q * 256 + j] * w; }
        } else { const int g = (i0 - 512) >> 6, c0 = (i0 - 512) & 63;
            const float* wx = inptr(F.lds, IN_WPL) + (size_t)l * 4 * 4096 + (size_t)g * 4096 + (size_t)c0 * 64; const float* ps = inptr(F.lds, IN_PLS) + l * 256 + g * 64;
            const float* wrow = wo + (size_t)(768 + g * 64) * 1024 + n;
#pragma unroll 4
            for (int j = 0; j < 64; ++j) { const float w = wrow[(size_t)j * 1024] * ps[j];
#pragma unroll
                for (int q = 0; q < 8; ++q) acc[q] += wx[q * 64 + j] * w; }
        }
        bf16* WoT = (bf16*)(ws + WS_WO + l * WO_STRIDE);
        v4u o; o.x = pk2(acc[0], acc[1]); o.y = pk2(acc[2], acc[3]); o.z = pk2(acc[4], acc[5]); o.w = pk2(acc[6], acc[7]);
        *(GAS v4u*)(WoT + (size_t)n * 1024 + 256 + i0) = o;
    }
    {
        const int gt = (F.vcu * NWAVES + F.wave) * 64 + lane, NGT = NGW * 64;
        float* rope = (float*)(ws + SM_ROPE); float* tw = (float*)(ws + SM_TW);
        bf16* M1 = (bf16*)(ws + SM_M1); bf16* M2 = (bf16*)(ws + SM_M2); bf16* M3 = (bf16*)(ws + SM_M3);
        for (int i = gt; i < 128 * 16; i += NGT) { const int p = i >> 4, f = i & 15; const float inv = powf(10000.0f, -(float)f * (1.0f / 16.0f)); const float a = (float)p * inv;
            rope[2 * i] = cosf(a); rope[2 * i + 1] = sinf(a); }
        for (int i = gt; i < 8192; i += NGT) { float sn, cs; sincospif((float)i * (1.0f / 4096.0f), &sn, &cs); tw[2 * i] = cs; tw[2 * i + 1] = sn; }
        for (int i = gt; i < 256 * 256; i += NGT) { const int m = i >> 8, k = i & 255, rip = m >> 7, k1 = m & 127, ri = k >> 7, t1 = k & 127;
            float sn, cs; sincospif((float)((k1 * t1) & 127) * (1.0f / 64.0f), &sn, &cs);
            const float vv = (rip == ri) ? cs : (rip == 0 ? sn : -sn); M1[i] = (bf16)f2bf(vv); }
        for (int i = gt; i < 64 * 128; i += NGT) { const int k2 = i >> 7, k = i & 127, t2 = k >> 1, ri = k & 1;
            float sn, cs; sincospif((float)((k2 * t2) & 63) * (1.0f / 32.0f), &sn, &cs); M2[i] = (bf16)f2bf(ri ? sn : cs); }
        for (int i = gt; i < 256 * 512; i += NGT) { const int kq = i >> 9, k = i & 511, ri = k >> 8, t = k & 255;
            float sn, cs; sincospif((float)((kq * t) & 255) * (1.0f / 128.0f), &sn, &cs); M3[i] = (bf16)f2bf(ri ? sn : cs); }
    }
}
__device__ __forceinline__ void s0b_modsum(Frame& F) {
    const int gt = (F.vcu * NWAVES + F.wave) * 64 + F.lane, NGT = F.G * NWAVES * 64;
    const float* modpart = (const float*)(F.ws + SM_MODPART); float* mod = (float*)(F.ws + WS_CTL + CTL_MOD); const float* bm = inptr(F.lds, IN_BMOD);
    for (int i = gt; i < DEPTH * 3 * 6144; i += NGT) { const int l = i / (3 * 6144), v = (i / 6144) % 3, j = i % 6144; float s = bm[l * 6144 + j];
#pragma unroll
        for (int kc = 0; kc < 16; ++kc) s += modpart[((size_t)(l * 16 + kc) * 3 + v) * 6144 + j];
        mod[i] = s; }
}
__device__ __forceinline__ void s1_prologue(Frame& F) {
    const int gw = F.vcu * NWAVES + F.wave, NGW = F.G * NWAVES, lane = F.lane;
    unsigned char* ws = F.ws;
    const float* mod = (const float*)(ws + WS_CTL + CTL_MOD);
    {
        bf16* ACT = (bf16*)(ws + WS_ACT); float* rss = (float*)(ws + WS_RPART);
        for (int r = gw; r < R; r += NGW) {
            const int b = r / SPB, rr = r % SPB, v = rr < CTXL ? 2 : b;
            const float* xrow = rr < CTXL ? inptr(F.lds, IN_CTX) + ((size_t)b * CTXL + rr) * DM : inptr(F.lds, IN_X) + ((size_t)b * SEQ + rr - CTXL) * DM;
            float s = 0.f; unsigned long long o[4];
#pragma unroll
            for (int j = 0; j < 4; ++j) { const int c = 4 * lane + 256 * j; const f32x4 x = *(const f32x4*)(xrow + c);
                const f32x4 g = *(const f32x4*)(inptr(F.lds, IN_G1) + c) * (*(const f32x4*)(mod + v * 6144 + 1024 + c) + 1.0f);
                s += (x[0] * x[0] + x[1] * x[1]) + (x[2] * x[2] + x[3] * x[3]); const f32x4 a = x * g;
                o[j] = (unsigned long long)pk2(a[0], a[1]) | ((unsigned long long)pk2(a[2], a[3]) << 32); }
            s = wave_sum(s);
#pragma unroll
            for (int j = 0; j < 4; ++j) *(unsigned long long*)(ACT + (size_t)r * DM + 4 * lane + 256 * j) = o[j];
            if (lane < 16) rss[(size_t)r * 16 + lane] = lane == 0 ? s : 0.f;
        }
    }
    for (int it = gw; it < DEPTH * (NIN + 2 * DFF); it += NGW) {
        const int l = it / (NIN + 2 * DFF), n = it % (NIN + 2 * DFF);
        const bool isin = n < NIN; const int nn = isin ? n : n - NIN;
        const bf16* wrow = isin ? (const bf16*)(ws + WS_WIN + l * WIN_STRIDE) + (size_t)nn * 1024 : (const bf16*)(ws + WS_WFI + l * WFI_STRIDE) + (size_t)nn * 1024;
        const float* sh = mod + (size_t)l * 3 * 6144 + (isin ? 0 : 3072);
        float a0 = 0.f, a1 = 0.f, a2 = 0.f;
#pragma unroll
        for (int j = 0; j < 2; ++j) { const int k = 8 * lane + 512 * j; const v4u w = *(const GAS v4u*)(wrow + k);
            float wf[8] = {bflo(w.x), bfhi(w.x), bflo(w.y), bfhi(w.y), bflo(w.z), bfhi(w.z), bflo(w.w), bfhi(w.w)};
#pragma unroll
            for (int q = 0; q < 8; ++q) { a0 += wf[q] * sh[k + q]; a1 += wf[q] * sh[6144 + k + q]; a2 += wf[q] * sh[2 * 6144 + k + q]; } }
        a0 = wave_sum(a0); a1 = wave_sum(a1); a2 = wave_sum(a2);
        if (lane == 0) { float* dst = isin ? (float*)(ws + SM_BIN) + (size_t)l * 3 * NIN + nn : (float*)(ws + SM_BFF) + (size_t)l * 3 * 2 * DFF + nn;
            const int st = isin ? NIN : 2 * DFF; dst[0] = a0; dst[st] = a1; dst[2 * st] = a2; }
    }
}
__device__ __forceinline__ void unpack8(const v4u w, float (&x)[8]) { x[0] = bflo(w.x); x[1] = bfhi(w.x); x[2] = bflo(w.y); x[3] = bfhi(w.y); x[4] = bflo(w.z); x[5] = bfhi(w.z); x[6] = bflo(w.w); x[7] = bfhi(w.w); }
__device__ __forceinline__ void p2_qkv(Frame& F, int l) {
    const int gw = F.vcu * NWAVES + F.wave, NGW = F.G * NWAVES, lane = F.lane;
    unsigned char* ws = F.ws;
    const bf16* P = (const bf16*)(ws + WS_P); bf16* Q = (bf16*)(ws + WS_Q); bf16* K = (bf16*)(ws + WS_K); bf16* V = (bf16*)(ws + WS_V);
    const float* rope = (const float*)(ws + SM_ROPE);
    const int head = lane >> 3, sub = lane & 7;
    float g[8];
#pragma unroll
    for (int j = 0; j < 8; ++j) g[j] = head < 4 ? inptr(F.lds, IN_QG)[l * 64 + sub * 8 + j] * QSCALE : (head < 6 ? inptr(F.lds, IN_KG)[l * 64 + sub * 8 + j] : 1.0f);
    for (int r = gw; r < R; r += NGW) {
        const int rr = r % SPB; const v4u raw = *(const GAS v4u*)(P + (size_t)r * NIN + lane * 8);
        float x[8]; unpack8(raw, x);
        if (head < 6) {
            float ss = 0.f;
#pragma unroll
            for (int j = 0; j < 8; ++j) ss += x[j] * x[j];
            ss += __shfl_xor(ss, 1); ss += __shfl_xor(ss, 2); ss += __shfl_xor(ss, 4);
            const float rs = rsqrtf(ss * (1.0f / 64.0f) + EPS);
#pragma unroll
            for (int j = 0; j < 8; ++j) x[j] = x[j] * rs * g[j];
            if (rr >= CTXL) { const int t = rr - CTXL; const int pos = sub < 4 ? (t >> 6) : (t & 63); const float* cs = rope + ((size_t)pos * 16 + (sub & 3) * 4) * 2;
#pragma unroll
                for (int p = 0; p < 4; ++p) { const float c = cs[2 * p], s = cs[2 * p + 1], x0 = x[2 * p], x1 = x[2 * p + 1]; x[2 * p] = x0 * c - x1 * s; x[2 * p + 1] = x0 * s + x1 * c; } }
        }
        v4u o; o.x = pk2(x[0], x[1]); o.y = pk2(x[2], x[3]); o.z = pk2(x[4], x[5]); o.w = pk2(x[6], x[7]);
        bf16* dst = head < 4 ? Q + (size_t)r * 256 + lane * 8 : (head < 6 ? K + (size_t)r * 128 + (lane - 32) * 8 : V + (size_t)r * 128 + (lane - 48) * 8);
        *(GAS v4u*)dst = o;
    }
}
__device__ __forceinline__ void p2_convpool_unit(Frame& F, int l, int unit) {
    unsigned char* ws = F.ws; const int tid = F.tid, lane = F.lane, w = F.wave;
    const bf16* P = (const bf16*)(ws + WS_P); bf16* MIX = (bf16*)(ws + WS_MIX);
    LAS float* buf = (LAS float*)(F.lds + RING_OFF);
    const int r0 = unit * 64, b = r0 / SPB, rr0 = r0 % SPB;
    const int seq_lo = rr0 < CTXL ? b * SPB : b * SPB + CTXL, seq_hi = rr0 < CTXL ? b * SPB + CTXL : (b + 1) * SPB;
    for (int idx = tid; idx < 94 * 32; idx += NWAVES * 64) { const int ri = idx >> 5, cg = idx & 31, r = r0 - 15 + ri;
        f32x4 o0 = {0.f, 0.f, 0.f, 0.f}, o1 = o0;
        if (r >= seq_lo && r < seq_hi) { const v4u a8 = *(const GAS v4u*)(P + (size_t)r * NIN + 1024 + cg * 8), g8 = *(const GAS v4u*)(P + (size_t)r * NIN + 1280 + cg * 8);
            float a[8], g[8]; unpack8(a8, a); unpack8(g8, g);
            o0 = (f32x4){a[0] * sigmoidf_(g[0]), a[1] * sigmoidf_(g[1]), a[2] * sigmoidf_(g[2]), a[3] * sigmoidf_(g[3])};
            o1 = (f32x4){a[4] * sigmoidf_(g[4]), a[5] * sigmoidf_(g[5]), a[6] * sigmoidf_(g[6]), a[7] * sigmoidf_(g[7])}; }
        *(LAS f32x4*)(buf + ri * 256 + cg * 8) = o0; *(LAS f32x4*)(buf + ri * 256 + cg * 8 + 4) = o1; }
    __syncthreads();
    {
        const float* dww = inptr(F.lds, IN_DWW) + (size_t)l * 31 * 256 + 4 * lane;
        f32x4 wt[31];
#pragma unroll
        for (int j = 0; j < 31; ++j) wt[j] = *(const f32x4*)(dww + j * 256);
        const f32x4 bias = *(const f32x4*)(inptr(F.lds, IN_DWB) + l * 256 + 4 * lane);
        const f32x4 lng = *(const f32x4*)(inptr(F.lds, IN_LNG) + l * 256 + 4 * lane), lnb = *(const f32x4*)(inptr(F.lds, IN_LNB) + l * 256 + 4 * lane);
        f32x4 acc[8];
#pragma unroll
        for (int o = 0; o < 8; ++o) acc[o] = bias;
#pragma unroll
        for (int i = 0; i < 38; ++i) { const f32x4 v = *(const LAS f32x4*)(buf + (w * 8 + i) * 256 + 4 * lane);
#pragma unroll
            for (int o = 0; o < 8; ++o) { const int j = i - o; if (j >= 0 && j < 31) acc[o] += v * wt[j]; } }
#pragma unroll
        for (int o = 0; o < 8; ++o) { const f32x4 a = acc[o];
            const float mean = wave_sum((a[0] + a[1]) + (a[2] + a[3])) * (1.0f / 256.0f); const f32x4 d = a - mean;
            const float var = wave_sum((d[0] * d[0] + d[1] * d[1]) + (d[2] * d[2] + d[3] * d[3])) * (1.0f / 256.0f);
            f32x4 y = d * rsqrtf(var + EPS) * lng + lnb;
#pragma unroll
            for (int q = 0; q < 4; ++q) y[q] = y[q] * sigmoidf_(y[q]);
            *(unsigned long long*)(MIX + (size_t)(r0 + w * 8 + o) * 1024 + 512 + 4 * lane) = (unsigned long long)pk2(y[0], y[1]) | ((unsigned long long)pk2(y[2], y[3]) << 32); }
    }
    __syncthreads();
    for (int idx = tid; idx < 80 * 32; idx += NWAVES * 64) { const int ri = idx >> 5, cg = idx & 31, r = r0 - 8 + ri;
        f32x4 o0 = {0.f, 0.f, 0.f, 0.f}, o1 = o0;
        if (r >= seq_lo && r < seq_hi) { const v4u a8 = *(const GAS v4u*)(P + (size_t)r * NIN + 1536 + cg * 8); float a[8]; unpack8(a8, a);
            o0 = (f32x4){a[0], a[1], a[2], a[3]}; o1 = (f32x4){a[4], a[5], a[6], a[7]}; }
        *(LAS f32x4*)(buf + ri * 256 + cg * 8) = o0; *(LAS f32x4*)(buf + ri * 256 + cg * 8 + 4) = o1; }
    __syncthreads();
    {
        const int win = 2 << (lane >> 4), half = win >> 1;
#pragma unroll
        for (int o = 0; o < 8; ++o) { const int t = r0 + w * 8 + o;
            int lo = t - half, hi = t - half + win; lo = lo < seq_lo ? seq_lo : lo; hi = hi > seq_hi ? seq_hi : hi;
            f32x4 s = {0.f, 0.f, 0.f, 0.f};
#pragma unroll
            for (int j = 0; j < 16; ++j) { if (j < win) s += *(const LAS f32x4*)(buf + (t - half + j - r0 + 8) * 256 + 4 * lane); }
            const f32x4 self = *(const LAS f32x4*)(buf + (t - r0 + 8) * 256 + 4 * lane);
            const f32x4 y = s * (1.0f / (float)(hi - lo)) - self;
            *(unsigned long long*)(MIX + (size_t)t * 1024 + 768 + 4 * lane) = (unsigned long long)pk2(y[0], y[1]) | ((unsigned long long)pk2(y[2], y[3]) << 32); }
    }
    __syncthreads();
}
#define MFMA32(a, b, c) __builtin_amdgcn_mfma_f32_32x32x16_bf16(a, b, c, 0, 0, 0)
__device__ __forceinline__ void f1_unit(Frame& F, int unit) {
    unsigned char* ws = F.ws; const int tid = F.tid, lane = F.lane, w = F.wave, r = lane & 31, h = lane >> 5;
    const int b = unit >> 7, t2 = (unit >> 1) & 63, ch = unit & 1;
    const bf16* P = (const bf16*)(ws + WS_P); bf16* GP = (bf16*)(ws + WS_GP); const bf16* M1 = (const bf16*)(ws + SM_M1); const float* tw = (const float*)(ws + SM_TW);
    LAS bf16* ZT = (LAS bf16*)(F.lds + RING_OFF);
    for (int idx = tid; idx < 4096; idx += NWAVES * 64) { const int k = idx >> 4, pc = idx & 15, ri = k >> 7, t1 = k & 127;
        const size_t row = (size_t)b * SPB + CTXL + t1 * 64 + t2; const v4u raw = *(const GAS v4u*)(P + row * NIN + 512 + ri * 256 + ch * 128 + pc * 8);
        LAS bf16* d = ZT + (pc * 8) * 264 + k;
        d[0] = (bf16)(raw.x & 0xffff); d[264] = (bf16)(raw.x >> 16); d[2 * 264] = (bf16)(raw.y & 0xffff); d[3 * 264] = (bf16)(raw.y >> 16);
        d[4 * 264] = (bf16)(raw.z & 0xffff); d[5 * 264] = (bf16)(raw.z >> 16); d[6 * 264] = (bf16)(raw.w & 0xffff); d[7 * 264] = (bf16)(raw.w >> 16); }
    __syncthreads();
    const int nt = w & 3, mh = w >> 2;
    f32x16 acc[2][2];
#pragma unroll
    for (int a = 0; a < 2; ++a)
#pragma unroll
        for (int c = 0; c < 2; ++c) acc[a][c] = f32x16{};
#pragma unroll 4
    for (int kt = 0; kt < 16; ++kt) { const bf16x8 bf = *(const LAS bf16x8*)(ZT + (nt * 32 + r) * 264 + kt * 16 + 8 * h);
#pragma unroll
        for (int pi = 0; pi < 2; ++pi)
#pragma unroll
            for (int rip = 0; rip < 2; ++rip) { const int mt = 2 * mh + pi + 4 * rip; const bf16x8 af = *(const bf16x8*)(M1 + (size_t)(mt * 32 + r) * 256 + kt * 16 + 8 * h);
                acc[pi][rip] = MFMA32(af, bf, acc[pi][rip]); } }
    const int cc = ch * 128 + nt * 32 + r;
#pragma unroll
    for (int pi = 0; pi < 2; ++pi)
#pragma unroll
        for (int q = 0; q < 16; ++q) { const int k1 = (2 * mh + pi) * 32 + (q & 3) + 8 * (q >> 2) + 4 * h; const float c = tw[2 * (t2 * k1)], s = tw[2 * (t2 * k1) + 1];
            const float gr = acc[pi][0][q], gi = acc[pi][1][q];
            bf16* dst = GP + ((((size_t)b * 128 + k1) * 64 + t2) * 2) * 256 + cc;
            dst[0] = (bf16)f2bf(c * gr + s * gi); dst[256] = (bf16)f2bf(c * gi - s * gr); }
    __syncthreads();
}
__device__ __forceinline__ void f2_unit(Frame& F, int unit) {
    unsigned char* ws = F.ws; const int tid = F.tid, lane = F.lane, w = F.wave, r = lane & 31, h = lane >> 5;
    const int b = unit >> 7, k1 = unit & 127;
    const bf16* GP = (const bf16*)(ws + WS_GP) + ((size_t)b * 128 + k1) * 64 * 2 * 256; bf16* MIX = (bf16*)(ws + WS_MIX); const bf16* M2 = (const bf16*)(ws + SM_M2);
    LAS bf16* GT = (LAS bf16*)(F.lds + RING_OFF);
    for (int idx = tid; idx < 4096; idx += NWAVES * 64) { const int k = idx >> 5, pc = idx & 31;
        const v4u raw = *(const GAS v4u*)(GP + (size_t)k * 256 + pc * 8);
        LAS bf16* d = GT + (pc * 8) * 136 + k;
        d[0] = (bf16)(raw.x & 0xffff); d[136] = (bf16)(raw.x >> 16); d[2 * 136] = (bf16)(raw.y & 0xffff); d[3 * 136] = (bf16)(raw.y >> 16);
        d[4 * 136] = (bf16)(raw.z & 0xffff); d[5 * 136] = (bf16)(raw.z >> 16); d[6 * 136] = (bf16)(raw.w & 0xffff); d[7 * 136] = (bf16)(raw.w >> 16); }
    __syncthreads();
    f32x16 acc[2]; acc[0] = f32x16{}; acc[1] = f32x16{};
#pragma unroll
    for (int kt = 0; kt < 8; ++kt) { const bf16x8 bf = *(const LAS bf16x8*)(GT + (w * 32 + r) * 136 + kt * 16 + 8 * h);
#pragma unroll
        for (int mt = 0; mt < 2; ++mt) { const bf16x8 af = *(const bf16x8*)(M2 + (size_t)(mt * 32 + r) * 128 + kt * 16 + 8 * h); acc[mt] = MFMA32(af, bf, acc[mt]); } }
    const float SC = 1.0f / 724.0773439350246f;
#pragma unroll
    for (int mt = 0; mt < 2; ++mt)
#pragma unroll
        for (int q = 0; q < 16; ++q) { const int k2 = mt * 32 + (q & 3) + 8 * (q >> 2) + 4 * h; const size_t row = (size_t)b * SPB + CTXL + k1 + 128 * k2;
            MIX[row * 1024 + 256 + w * 32 + r] = (bf16)f2bf(acc[mt][q] * SC); }
    __syncthreads();
}
__device__ __forceinline__ void fctx_unit(Frame& F, int unit) {
    unsigned char* ws = F.ws; const int tid = F.tid, lane = F.lane, w = F.wave, r = lane & 31, h = lane >> 5;
    const int b = unit >> 3, cb = unit & 7;
    const bf16* P = (const bf16*)(ws + WS_P); bf16* MIX = (bf16*)(ws + WS_MIX); const bf16* M3 = (const bf16*)(ws + SM_M3);
    LAS bf16* ZT = (LAS bf16*)(F.lds + RING_OFF);
    for (int idx = tid; idx < 2048; idx += NWAVES * 64) { const int k = idx >> 2, pc = idx & 3, ri = k >> 8, t = k & 255;
        const size_t row = (size_t)b * SPB + t; const v4u raw = *(const GAS v4u*)(P + row * NIN + 512 + ri * 256 + cb * 32 + pc * 8);
        LAS bf16* d = ZT + (pc * 8) * 520 + k;
        d[0] = (bf16)(raw.x & 0xffff); d[520] = (bf16)(raw.x >> 16); d[2 * 520] = (bf16)(raw.y & 0xffff); d[3 * 520] = (bf16)(raw.y >> 16);
        d[4 * 520] = (bf16)(raw.z & 0xffff); d[5 * 520] = (bf16)(raw.z >> 16); d[6 * 520] = (bf16)(raw.w & 0xffff); d[7 * 520] = (bf16)(raw.w >> 16); }
    __syncthreads();
    f32x16 acc = f32x16{};
#pragma unroll 4
    for (int kt = 0; kt < 32; ++kt) { const bf16x8 bf = *(const LAS bf16x8*)(ZT + r * 520 + kt * 16 + 8 * h);
        const bf16x8 af = *(const bf16x8*)(M3 + (size_t)(w * 32 + r) * 512 + kt * 16 + 8 * h); acc = MFMA32(af, bf, acc); }
#pragma unroll
    for (int q = 0; q < 16; ++q) { const int kq = w * 32 + (q & 3) + 8 * (q >> 2) + 4 * h; const size_t row = (size_t)b * SPB + kq;
        MIX[row * 1024 + 256 + cb * 32 + r] = (bf16)f2bf(acc[q] * (1.0f / 128.0f)); }
    __syncthreads();
}
#ifndef MK_N_LAUNCHES
#define MK_N_LAUNCHES 1
#endif
constexpr int N_PHASES = 3 + 6 * DEPTH;
struct Args { const float* in[22]; float* out; unsigned char* ws; int ph_lo, ph_hi; };
__global__ void __launch_bounds__(NWAVES * 64, 2) fwd_kernel(Args args) {
    extern __shared__ __attribute__((aligned(16))) unsigned char lds[];
    Frame F;
    F.lds = (LAS unsigned char*)lds;
    F.MISC = (volatile LAS unsigned*)(F.lds + MISC_OFF);
    F.tid = threadIdx.x; F.lane = F.tid & 63; F.wave = __builtin_amdgcn_readfirstlane(F.tid >> 6);
    F.G = gridDim.x; { const int bx = blockIdx.x; F.vcu = (F.G % 8 == 0) ? (bx % 8) * (F.G / 8) + bx / 8 : bx; }
    F.ws = args.ws;
    unsigned char* ws = args.ws;
    for (int u = F.tid; u < (LDS_BYTES - LDSCTL_OFF) / 4; u += NWAVES * 64) ((LAS unsigned*)(F.lds + LDSCTL_OFF))[u] = 0u;
    __syncthreads();
    if (F.tid == 0) { LAS unsigned long long* tab = (LAS unsigned long long*)(F.lds + PTAB_OFF);
#pragma unroll
        for (int i = 0; i < N_IN; ++i) tab[i] = (unsigned long long)args.in[i];
        tab[IN_OUT] = (unsigned long long)args.out; }
    __syncthreads();
    XcdBarrier bar; bar.bar = (unsigned*)(ws + WS_CTL) + CW_BAR; bar.x = 0; bar.st = nullptr;
    if (MK_N_LAUNCHES == 1) bar = xcd_barrier_post((unsigned*)(ws + WS_CTL) + CW_BAR, F.MISC + 8);
    const int lo = args.ph_lo, hi = args.ph_hi;
#define IN(k) (lo <= (k) && (k) < hi)
#define SEAM(k) do { if ((k) + 1 < hi) xcd_barrier(bar); } while (0)
#define ENTER() do { int t_ = threadIdx.x; asm volatile("" : "+v"(t_)); F.tid = t_; F.lane = t_ & 63; F.wave = __builtin_amdgcn_readfirstlane(t_ >> 6); \
        unsigned long long w_ = (unsigned long long)args.ws; asm volatile("" : "+s"(w_)); ws = (unsigned char*)w_; F.ws = ws; } while (0)

    if (IN(0)) { ENTER(); s0_prologue(F); SEAM(0); }
    if (IN(1)) { ENTER(); s0b_modsum(F); SEAM(1); }
    if (IN(2)) { ENTER(); s1_prologue(F); SEAM(2); }
#pragma unroll 1
    for (int l = 0; l < DEPTH; ++l) {
        const int p0 = 3 + 6 * l; const bool last = (l == DEPTH - 1);
        if (IN(p0)) {
            ENTER();
            pg8::Gemm g{(const bf16*)(ws + WS_ACT), (const bf16*)(ws + WS_WIN + l * WIN_STRIDE), R, NIN, DM}; pg8::StaticOrder S; S.init(R, NIN, F.G, (int)blockIdx.x, 0);
            pg8::EpiInProj E{ws, l};
            pg8::gemm_phase<pg8::EpiInProj, pg8::StaticOrder, true, true>(F.lds + RING_OFF, g, S, E);
            SEAM(p0);
        }
        if (IN(p0 + 1)) {
            ENTER();
            p2_qkv(F, l);
            for (int u = F.vcu; u < 256; u += F.G) f1_unit(F, u);
            for (int u = F.vcu; u < R / 64; u += F.G) p2_convpool_unit(F, l, u);
            SEAM(p0 + 1);
        }
        if (IN(p0 + 2)) {
            ENTER();
            for (int u = F.vcu; u < 256; u += F.G) f2_unit(F, u);
            if (!last) for (int u = F.vcu; u < 16; u += F.G) fctx_unit(F, u);
            const int nun = last ? 256 : 264;
            for (int u = F.vcu; u < nun; u += F.G) {
                int bh, q0, NT; if (u < 256) { bh = u >> 5; q0 = 256 * (1 + (u & 31)); NT = SPB / 64; } else { bh = u - 256; q0 = 0; NT = CTXL / 64; }
                attn_body::attn_unit<8>((long)(bh >> 2) * SPB, bh & 3, q0, NT, (const attn_body::bf16*)(ws + WS_Q), (const attn_body::bf16*)(ws + WS_K), (const attn_body::bf16*)(ws + WS_V),
                                        (attn_body::bf16*)(ws + WS_MIX), (char*)lds + RING_OFF);
            }
            SEAM(p0 + 2);
        }
        if (IN(p0 + 3)) {
            ENTER();
            pg8::Gemm g{(const bf16*)(ws + WS_MIX), (const bf16*)(ws + WS_WO + l * WO_STRIDE), R, DM, DM}; pg8::StaticOrder S; S.init(last ? 64 * 256 : R, DM, F.G, (int)blockIdx.x, last ? 1 : 0);
            pg8::EpiRes E{F.lds, ws, l, 0};
            pg8::gemm_phase<pg8::EpiRes, pg8::StaticOrder, true, true>(F.lds + RING_OFF, g, S, E);
            SEAM(p0 + 3);
        }
        if (IN(p0 + 4)) {
            ENTER();
            pg8::Gemm g{(const bf16*)(ws + WS_ACT), (const bf16*)(ws + WS_WFI + l * WFI_STRIDE), R, 2 * DFF, DM}; pg8::StaticOrder S; S.init(last ? 64 * 256 : R, 2 * DFF, F.G, (int)blockIdx.x, last ? 1 : 0);
            pg8::EpiFfnIn E{ws, l};
            pg8::gemm_phase<pg8::EpiFfnIn, pg8::StaticOrder, true, true>(F.lds + RING_OFF, g, S, E);
            SEAM(p0 + 4);
        }
        if (IN(p0 + 5)) {
            ENTER();
            pg8::Gemm g{(const bf16*)(ws + WS_H), (const bf16*)(ws + WS_WFO + l * WFO_STRIDE), R, DM, DFF}; pg8::StaticOrder S; S.init(last ? 64 * 256 : R, DM, F.G, (int)blockIdx.x, last ? 1 : 0);
            pg8::EpiRes E{F.lds, ws, l, 1};
            pg8::gemm_phase<pg8::EpiRes, pg8::StaticOrder, true, true>(F.lds + RING_OFF, g, S, E);
            SEAM(p0 + 5);
        }
    }
#undef IN
#undef SEAM
}

extern "C" void kernel_launch(void* const* d_in, const int* in_sizes, int n_in, void* d_out, int out_size, void* d_ws, size_t ws_size, hipStream_t stream) {
    static int grid = 0;
    if (grid == 0) {
        if (n_in != 22 || out_size != BATCH * SEQ * DM || ws_size < WS_END) { fprintf(stderr, "kernel_launch: unexpected shapes (n_in %d out %d ws %zu)\n", n_in, out_size, ws_size); grid = -1; return; }
        int dev = 0, cus = 0, per_cu = 0;
        if (hipGetDevice(&dev) != hipSuccess || hipDeviceGetAttribute(&cus, hipDeviceAttributeMultiprocessorCount, dev) != hipSuccess) { grid = -1; return; }
        if (hipFuncSetAttribute((const void*)fwd_kernel, hipFuncAttributeMaxDynamicSharedMemorySize, LDS_BYTES) != hipSuccess) { fprintf(stderr, "kernel_launch: hipFuncSetAttribute failed\n"); grid = -1; return; }
        if (hipOccupancyMaxActiveBlocksPerMultiprocessor(&per_cu, (const void*)fwd_kernel, NWAVES * 64, LDS_BYTES) != hipSuccess || per_cu < 1) { fprintf(stderr, "kernel_launch: occupancy query says %d\n", per_cu); (void)hipGetLastError(); per_cu = 1; }
        grid = cus;
    }
    if (grid < 0) return;
    (void)hipMemsetAsync((char*)d_ws + WS_CTL, 0, CTL_ZERO_BYTES, stream);
    Args a{};
    for (int i = 0; i < 22; ++i) a.in[i] = (const float*)d_in[i];
    a.out = (float*)d_out; a.ws = (unsigned char*)d_ws;
#if MK_N_LAUNCHES == 1
    a.ph_lo = 0; a.ph_hi = N_PHASES;
    void* kargs[] = {&a};
    hipError_t e = hipLaunchCooperativeKernel((const void*)fwd_kernel, dim3(grid), dim3(NWAVES * 64), kargs, LDS_BYTES, stream);
    if (e != hipSuccess) { fprintf(stderr, "kernel_launch: cooperative launch failed: %s\n", hipGetErrorString(e)); }
#else
    for (int p = 0; p < N_PHASES; ++p) { a.ph_lo = p; a.ph_hi = p + 1; hipLaunchKernelGGL(fwd_kernel, dim3(grid), dim3(NWAVES * 64), LDS_BYTES, stream, a); }
#endif
}
```

```cpp
#include <hip/hip_runtime.h>
#include <hip/hip_bf16.h>
#include <cstdio>
#include <cstdint>
#include <cmath>
constexpr int NWAVES = 8;
constexpr int BATCH = 2, SEQ = 8192, CTXL = 256, DM = 1024, DEPTH = 2, DFF = 2816, DIN0 = 1536, NIN = 1792;
constexpr int SPB = SEQ + CTXL;
constexpr int R = BATCH * SPB;
constexpr float EPS = 1e-6f;
constexpr float QSCALE = 0.125f * 1.4426950408889634f;
constexpr size_t MiB = 1u << 20, KiB = 1024;
constexpr size_t WS_CTL = 0, CTL_ZERO_BYTES = 32 * 1024;
constexpr size_t CTL_MOD = 64 * 1024;
constexpr size_t WS_WIN = 1 * MiB, WIN_STRIDE = 3584 * KiB;
constexpr size_t WS_WO = 8 * MiB, WO_STRIDE = 2 * MiB;
constexpr size_t WS_WFI = 12 * MiB, WFI_STRIDE = 11 * MiB;
constexpr size_t WS_WFO = 34 * MiB, WFO_STRIDE = 5632 * KiB;
constexpr size_t WS_SMALL = 45 * MiB;
constexpr size_t SM_BIN = WS_SMALL;
constexpr size_t SM_BFF = SM_BIN + 64 * 1024;
constexpr size_t SM_ROPE = SM_BFF + 192 * 1024;
constexpr size_t SM_TW = SM_ROPE + 16 * 1024;
constexpr size_t SM_M1 = SM_TW + 64 * 1024;
constexpr size_t SM_M2 = SM_M1 + 128 * 1024;
constexpr size_t SM_M3 = SM_M2 + 16 * 1024;
constexpr size_t SM_MODPART = 46 * MiB;
constexpr size_t WS_CTXRES = 48 * MiB + 512 * KiB;
constexpr size_t WS_ACT = 51 * MiB;
constexpr size_t WS_P = 84 * MiB;
constexpr size_t WS_Q = 142 * MiB;
constexpr size_t WS_K = 150 * MiB + 512 * KiB;
constexpr size_t WS_V = 155 * MiB;
constexpr size_t WS_GP = 159 * MiB + 512 * KiB;
constexpr size_t WS_H = 84 * MiB;
constexpr size_t WS_MIX = 176 * MiB;
constexpr size_t WS_RPART = 209 * MiB;
constexpr size_t WS_PART = 213 * MiB + 512 * KiB;
constexpr size_t WS_RES = 222 * MiB;
constexpr size_t WS_END = 254 * MiB;
static_assert(WS_H + (size_t)R * DFF * 2 <= WS_MIX && WS_GP + 16 * MiB <= WS_MIX && WS_P + (size_t)R * NIN * 2 <= WS_Q && WS_Q + (size_t)R * 512 <= WS_K && WS_K + (size_t)R * 256 <= WS_V && WS_V + (size_t)R * 256 <= WS_GP, "d_ws map");
static_assert(WS_WIN + 2 * WIN_STRIDE <= WS_WO && WS_WO + 2 * WO_STRIDE <= WS_WFI && WS_WFI + 2 * WFI_STRIDE <= WS_WFO && WS_WFO + 2 * WFO_STRIDE <= WS_SMALL && SM_M3 + 256 * KiB <= SM_MODPART && SM_MODPART + 2304 * KiB <= WS_CTXRES && WS_CTXRES + 2 * MiB <= WS_ACT, "d_ws map (weights)");
static_assert(WS_ACT + (size_t)R * 2048 <= WS_P && WS_MIX + (size_t)R * 2048 <= WS_RPART && WS_RPART + (size_t)4 * R * 64 <= WS_PART && WS_PART + 8 * MiB <= WS_RES && WS_RES + 32 * MiB <= WS_END && WS_END <= 256 * MiB, "d_ws map (tail)");
constexpr int CW_BAR = 4096;
constexpr int RING_OFF = 0, RING_BYTES = 131072;
constexpr int LDSCTL_OFF = 146432, MISC_OFF = LDSCTL_OFF + 320;
constexpr int LDS_BYTES = 147456;
typedef unsigned u32x2_t __attribute__((ext_vector_type(2)));
constexpr int PTAB_OFF = LDSCTL_OFF + 512;
#define N_IN 22
__device__ __forceinline__ const float* inptr(__attribute__((address_space(3))) unsigned char* lds, int i) {
    const unsigned long long v = *(const __attribute__((address_space(3))) unsigned long long*)(lds + PTAB_OFF + 8 * i);
    const unsigned lo = __builtin_amdgcn_readfirstlane((unsigned)v), hi = __builtin_amdgcn_readfirstlane((unsigned)(v >> 32));
    return (const float*)(((unsigned long long)hi << 32) | lo);
}
#define IN_X 0
#define IN_C 1
#define IN_CTX 2
#define IN_CCTX 3
#define IN_WMOD 4
#define IN_BMOD 5
#define IN_G1 6
#define IN_G2 7
#define IN_WIN 8
#define IN_QG 9
#define IN_KG 10
#define IN_WF 11
#define IN_DWW 12
#define IN_DWB 13
#define IN_LNG 14
#define IN_LNB 15
#define IN_WPW 16
#define IN_WPL 17
#define IN_PLS 18
#define IN_WO 19
#define IN_WFI 20
#define IN_WFO 21
#define IN_OUT 22
__device__ __forceinline__ float row_rstd(const float* rpart, int r) {
    typedef float f4 __attribute__((ext_vector_type(4)));
    const f4* p = (const f4*)(rpart + (size_t)r * 16); const f4 a = p[0], b = p[1], c = p[2], d = p[3];
    const float s = (((a[0] + a[1]) + (a[2] + a[3])) + ((b[0] + b[1]) + (b[2] + b[3]))) + (((c[0] + c[1]) + (c[2] + c[3])) + ((d[0] + d[1]) + (d[2] + d[3])));
    return rsqrtf(s * (1.0f / 1024.0f) + 1e-6f);
}
namespace pg8 {
#define PG8_LAS __attribute__((address_space(3)))
typedef unsigned short bf16_t;
typedef short bf16x8 __attribute__((ext_vector_type(8)));
typedef float f32x4 __attribute__((ext_vector_type(4)));
typedef unsigned u32x4 __attribute__((ext_vector_type(4)));
constexpr int BM = 256, BK = 64, HALF = 128, HTB = HALF * BK * 2  , STAGE_BYTES = 8 * HTB, NXCD = 8, WGM = 8;

__host__ __device__ __forceinline__ int lds_byte(int r, int c) { const int st = (r >> 4) * 2 + (c >> 5), rr = r & 15, cc = c & 31, ob = rr * 64 + cc * 2; return st * 1024 + (ob ^ (((ob >> 9) & 1) << 5)); }
__host__ __device__ __forceinline__ void stage_rc(int b, int& R, int& C) { const int st = b / 1024, sb = b % 1024, swz = sb ^ (((sb >> 9) & 1) << 5); R = (st >> 1) * 16 + swz / 64; C = (st & 1) * 32 + (swz % 64) / 2; }
__host__ __device__ __forceinline__ int perm32(int rho) { const int n = rho >> 4, i = rho & 15; return 8 * (i >> 2) + 4 * n + (i & 3); }

struct Unit { int pm, pn, kx;
    __host__ __device__ __forceinline__ int nt() const { return kx & 255; }
    __host__ __device__ __forceinline__ int kt0() const { return (kx >> 8) & 255; }
    __host__ __device__ __forceinline__ int kc() const { return (kx >> 16) - 1; } };
struct Gemm { const bf16_t* A; const bf16_t* Bt; int M, N, K; };

struct StaticOrder {
    int nM, nN, nwg, G, c, skip, ntk;
    __host__ __device__ void init(int M, int N, int K, int G_, int c_, int skip_) { nM = M / BM; nN = N / BM; nwg = skip_ == 2 ? 0 : nM * nN; G = G_; c = c_; skip = skip_; ntk = K / BK; }
    __host__ __device__ bool next(int i, Unit& u) const {
        const long L = (long)i * G + c;
        u.kx = ntk;
        if (skip == 2 && L >= nwg) { const int idx = (int)(L - nwg); if (idx >= 32) return false; const int tile = idx >> 2, kc = idx & 3, base = (ntk >> 2) & ~1, rem2 = (ntk - 4 * base) >> 1;
            u.pm = (tile >> 2) * 33; u.pn = tile & 3; u.kx = ((kc + 1) << 16) | ((kc * base + 2 * (kc < rem2 ? kc : rem2)) << 8) | (base + (kc < rem2 ? 2 : 0)); return true; }
        if (L >= nwg) return false;
        int wgid = (int)L; { const int q = nwg / NXCD, r = nwg % NXCD, xcd = wgid % NXCD, off = wgid / NXCD; wgid = (xcd < r ? xcd * (q + 1) : r * (q + 1) + (xcd - r) * q) + off; }
        const int nig = WGM * nN, gid = wgid / nig, fm = gid * WGM, gsz = (nM - fm) < WGM ? (nM - fm) : WGM;
        u.pm = fm + ((wgid % nig) % gsz); u.pn = (wgid % nig) / gsz; if (skip) u.pm += 1 + u.pm / 32; return true;
    }
    __device__ __forceinline__ void a_ready(const Unit&) const {}
    __device__ __forceinline__ void done(const Unit&) const {}
};

__device__ __forceinline__ unsigned cvt_pk_bf16(float lo, float hi) { unsigned r; asm volatile("v_cvt_pk_bf16_f32 %0, %1, %2" : "=v"(r) : "v"(lo), "v"(hi)); return r; }
constexpr int RT = 33;
__device__ __forceinline__ int tile_v(int pm) { return (pm % RT == 0) ? 2 : pm / RT; }
typedef unsigned u32x2 __attribute__((ext_vector_type(2)));

struct EpiInProj {
    static constexpr bool PERM = true, AFTER_DRAIN = false;
    PG8_LAS unsigned char* lds; unsigned char* ws; int l;
    __device__ __forceinline__ void operator()(const f32x4 (&acc)[2][2][4][2], const Unit& u, int wr, int wc, int fr, int fq) const {
        if (u.pn < 2) { qkv(acc, u, wr, wc, fr, fq); return; }
        bf16_t* O = (bf16_t*)(ws + WS_P); const float* rowss = (const float*)(ws + WS_RPART) + (size_t)(2 * l) * R * 16; const float* bias = (const float*)(ws + SM_BIN) + (size_t)l * 3 * NIN;
        const int row0 = u.pm * BM + wr * 64 + fr, v = tile_v(u.pm), col0 = u.pn * BM + wc * 32 + 8 * fq;
        const float* bp = bias + v * 1792 + col0;
        f32x4 bv[2][2];
#pragma unroll
        for (int bj = 0; bj < 2; ++bj)
#pragma unroll
            for (int n = 0; n < 2; ++n) bv[bj][n] = *(const f32x4*)(bp + bj * HALF + 4 * n);
        float rsv[8];
        { f32x4 pq[8];
#pragma unroll
          for (int q = 0; q < 8; ++q) pq[q] = *(const f32x4*)(rowss + (size_t)(row0 + (q >> 2) * HALF + (q & 3) * 16) * 16 + 4 * fq);
#pragma unroll
          for (int q = 0; q < 8; ++q) { float s = (pq[q][0] + pq[q][1]) + (pq[q][2] + pq[q][3]); s += __shfl_xor(s, 16); s += __shfl_xor(s, 32); rsv[q] = rsqrtf(s * (1.0f / 1024.0f) + 1e-6f); } }
#pragma unroll
        for (int ai = 0; ai < 2; ++ai)
#pragma unroll
            for (int m = 0; m < 4; ++m) { const int r = row0 + ai * HALF + m * 16; const float rs = rsv[ai * 4 + m];
                bf16_t* rowp = O + (size_t)r * 1792 + col0;
#pragma unroll
                for (int bj = 0; bj < 2; ++bj) { const f32x4 v0 = acc[ai][bj][m][0] * rs + bv[bj][0], v1 = acc[ai][bj][m][1] * rs + bv[bj][1];
                    u32x4 w; w.x = cvt_pk_bf16(v0[0], v0[1]); w.y = cvt_pk_bf16(v0[2], v0[3]); w.z = cvt_pk_bf16(v1[0], v1[1]); w.w = cvt_pk_bf16(v1[2], v1[3]);
                    *(u32x4*)(rowp + bj * HALF) = w; } }
    }
    __device__ __forceinline__ void qkv(const f32x4 (&acc)[2][2][4][2], const Unit& u, int wr, int wc, int fr, int fq) const {
        const float* rowss = (const float*)(ws + WS_RPART) + (size_t)(2 * l) * R * 16; const float* bias = (const float*)(ws + SM_BIN) + (size_t)l * 3 * NIN;
        const float* rope = (const float*)(ws + SM_ROPE);
        const int row0 = u.pm * BM + wr * 64 + fr, v = tile_v(u.pm), col0 = u.pn * BM + wc * 32 + 8 * fq;
        const bool isq = u.pn == 0, norm = isq || wc < 2, lat = (u.pm % RT) != 0;
        const float* bp = bias + v * 1792 + col0;
        f32x4 bv[2][2], gg[2][2];
#pragma unroll
        for (int bj = 0; bj < 2; ++bj)
#pragma unroll
            for (int n = 0; n < 2; ++n) { bv[bj][n] = *(const f32x4*)(bp + bj * HALF + 4 * n);
                gg[bj][n] = (f32x4){1.f, 1.f, 1.f, 1.f};
                if (norm) gg[bj][n] = *(const f32x4*)((isq ? inptr(lds, IN_QG) : inptr(lds, IN_KG)) + l * 64 + 32 * bj + 8 * fq + 4 * n) * (isq ? QSCALE : 1.0f); }
        bf16_t* ob = isq ? (bf16_t*)(ws + WS_Q) + wc * 64 + 8 * fq : (wc < 2 ? (bf16_t*)(ws + WS_K) + wc * 64 + 8 * fq : (bf16_t*)(ws + WS_V) + (wc - 2) * 64 + 8 * fq);
        const int opitch = isq ? 256 : 128;
#pragma unroll
        for (int ai = 0; ai < 2; ++ai) {
            f32x4 cr[2] = {{1.f, 0.f, 1.f, 0.f}, {1.f, 0.f, 1.f, 0.f}};
            if (norm && lat) { const int prow = (u.pm % RT - 1) * 4 + 2 * ai + wr; const float* p = rope + ((size_t)prow * 16 + 4 * fq) * 2; cr[0] = *(const f32x4*)p; cr[1] = *(const f32x4*)(p + 4); }
#pragma unroll
            for (int m = 0; m < 4; ++m) { const int r = row0 + ai * HALF + m * 16;
                float rs; { const f32x4 pq = *(const f32x4*)(rowss + (size_t)r * 16 + 4 * fq); float s = (pq[0] + pq[1]) + (pq[2] + pq[3]); s += __shfl_xor(s, 16); s += __shfl_xor(s, 32); rs = rsqrtf(s * (1.0f / 1024.0f) + 1e-6f); }
                f32x4 x[2][2];
#pragma unroll
                for (int bj = 0; bj < 2; ++bj)
#pragma unroll
                    for (int n = 0; n < 2; ++n) x[bj][n] = acc[ai][bj][m][n] * rs + bv[bj][n];
                if (norm) {
                    float ss = 0.f;
#pragma unroll
                    for (int bj = 0; bj < 2; ++bj)
#pragma unroll
                        for (int n = 0; n < 2; ++n) ss += (x[bj][n][0] * x[bj][n][0] + x[bj][n][1] * x[bj][n][1]) + (x[bj][n][2] * x[bj][n][2] + x[bj][n][3] * x[bj][n][3]);
                    ss += __shfl_xor(ss, 16); ss += __shfl_xor(ss, 32);
                    const float rn = rsqrtf(ss * (1.0f / 64.0f) + 1e-6f);
#pragma unroll
                    for (int bj = 0; bj < 2; ++bj)
#pragma unroll
                        for (int n = 0; n < 2; ++n) x[bj][n] = x[bj][n] * rn * gg[bj][n];
                    if (lat) { const float* p = rope + ((size_t)(16 * m + fr) * 16 + 4 * fq) * 2; const f32x4 cc[2] = {*(const f32x4*)p, *(const f32x4*)(p + 4)};
#pragma unroll
                        for (int n = 0; n < 2; ++n) { f32x4 a = x[0][n], b = x[1][n]; const f32x4 c0 = cr[n], c1 = cc[n];
                            x[0][n] = (f32x4){a[0] * c0[0] - a[1] * c0[1], a[0] * c0[1] + a[1] * c0[0], a[2] * c0[2] - a[3] * c0[3], a[2] * c0[3] + a[3] * c0[2]};
                            x[1][n] = (f32x4){b[0] * c1[0] - b[1] * c1[1], b[0] * c1[1] + b[1] * c1[0], b[2] * c1[2] - b[3] * c1[3], b[2] * c1[3] + b[3] * c1[2]}; } }
                }
#pragma unroll
                for (int bj = 0; bj < 2; ++bj) { u32x4 w; w.x = cvt_pk_bf16(x[bj][0][0], x[bj][0][1]); w.y = cvt_pk_bf16(x[bj][0][2], x[bj][0][3]); w.z = cvt_pk_bf16(x[bj][1][0], x[bj][1][1]); w.w = cvt_pk_bf16(x[bj][1][2], x[bj][1][3]);
                    *(u32x4*)(ob + (size_t)r * opitch + 32 * bj) = w; } } }
    }
};
struct EpiFfnIn {
    static constexpr bool PERM = true, AFTER_DRAIN = false;
    unsigned char* ws; int l;
    __device__ __forceinline__ void operator()(const f32x4 (&acc)[2][2][4][2], const Unit& u, int wr, int wc, int fr, int fq) const {
        bf16_t* H = (bf16_t*)(ws + WS_H); const float* rowss = (const float*)(ws + WS_RPART) + (size_t)(2 * l + 1) * R * 16; const float* bias = (const float*)(ws + SM_BFF) + (size_t)l * 3 * 2 * DFF;
        const int row0 = u.pm * BM + wr * 64 + fr, v = tile_v(u.pm), hc = wc * 32 + 8 * fq;
        const float* bp = bias + v * 5632 + u.pn * BM + hc;
        f32x4 bv[2][2];
#pragma unroll
        for (int bj = 0; bj < 2; ++bj)
#pragma unroll
            for (int n = 0; n < 2; ++n) bv[bj][n] = *(const f32x4*)(bp + bj * HALF + 4 * n);
        float rsv[8];
        { f32x4 pq[8];
#pragma unroll
          for (int q = 0; q < 8; ++q) pq[q] = *(const f32x4*)(rowss + (size_t)(row0 + (q >> 2) * HALF + (q & 3) * 16) * 16 + 4 * fq);
#pragma unroll
          for (int q = 0; q < 8; ++q) { float s = (pq[q][0] + pq[q][1]) + (pq[q][2] + pq[q][3]); s += __shfl_xor(s, 16); s += __shfl_xor(s, 32); rsv[q] = rsqrtf(s * (1.0f / 1024.0f) + 1e-6f); } }
#pragma unroll
        for (int ai = 0; ai < 2; ++ai)
#pragma unroll
            for (int m = 0; m < 4; ++m) { const int r = row0 + ai * HALF + m * 16; const float rs = rsv[ai * 4 + m];
                float o[8];
#pragma unroll
                for (int n = 0; n < 2; ++n) { const f32x4 a = acc[ai][0][m][n] * rs + bv[0][n], g = acc[ai][1][m][n] * rs + bv[1][n];
#pragma unroll
                    for (int i = 0; i < 4; ++i) o[4 * n + i] = a[i] * __builtin_amdgcn_rcpf(1.0f + __expf(-a[i])) * g[i]; }
                u32x4 w; w.x = cvt_pk_bf16(o[0], o[1]); w.y = cvt_pk_bf16(o[2], o[3]); w.z = cvt_pk_bf16(o[4], o[5]); w.w = cvt_pk_bf16(o[6], o[7]);
                *(u32x4*)(H + (size_t)r * 2816 + u.pn * HALF + hc) = w; }
    }
};
struct EpiRes {
    static constexpr bool PERM = false, AFTER_DRAIN = false;
    PG8_LAS unsigned char* lds; unsigned char* ws; int l; int kind;
    __device__ __forceinline__ void operator()(const f32x4 (&acc)[2][2][4][2], const Unit& u, int wr, int wc, int fr, int fq) const {
        const float* mod = (const float*)(ws + WS_CTL + CTL_MOD) + (size_t)l * 3 * 6144;
        const bool lastffn = (kind == 1 && l == DEPTH - 1);
        const float* xin = (kind == 0 && l == 0) ? inptr(lds, IN_X) : nullptr; const float* ctxin = xin ? inptr(lds, IN_CTX) : nullptr;
        float* dout = (float*)inptr(lds, IN_OUT); float* ctxres = (float*)(ws + WS_CTXRES);
        const float* gate = mod + (kind == 0 ? 2048 : 5120);
        const float* gn = lastffn ? nullptr : (kind == 0 ? inptr(lds, IN_G2) + l * DM : inptr(lds, IN_G1) + (l + 1) * DM);
        const float* sc = kind == 0 ? mod + 4096 : mod + 3 * 6144 + 1024;
        bf16_t* A = lastffn ? nullptr : (bf16_t*)(ws + WS_ACT);
        float* rowss = (float*)(ws + WS_RPART) + (size_t)(2 * l + 1 + kind) * R * 16;
        const int v = tile_v(u.pm), rr = u.pm % RT, b = u.pm / RT;
        const float* src; float* dst;
        if (rr == 0) { dst = ctxres + (size_t)b * 256 * 1024; src = xin ? ctxin + (size_t)b * 256 * 1024 : dst; }
        else { const size_t off = ((size_t)b * 8192 + (size_t)(rr - 1) * 256) * 1024; dst = dout + off; src = xin ? xin + off : dst; }
        const int col0 = u.pn * BM + wc * 32 + 4 * fq;
        f32x4 gv[2][2], gs[2][2];
#pragma unroll
        for (int bj = 0; bj < 2; ++bj)
#pragma unroll
            for (int n = 0; n < 2; ++n) { const int c = col0 + bj * HALF + n * 16; gv[bj][n] = *(const f32x4*)(gate + v * 6144 + c);
                if (A) gs[bj][n] = *(const f32x4*)(gn + c) * (*(const f32x4*)(sc + v * 6144 + c) + 1.0f); else gs[bj][n] = (f32x4){0.f, 0.f, 0.f, 0.f}; }
#pragma unroll
        for (int ai = 0; ai < 2; ++ai)
#pragma unroll
            for (int m = 0; m < 4; ++m) { const int lr = ai * HALF + wr * 64 + m * 16 + fr; float ss = 0.f;
#pragma unroll
                for (int bj = 0; bj < 2; ++bj)
#pragma unroll
                    for (int n = 0; n < 2; ++n) { const size_t o = (size_t)lr * 1024 + col0 + bj * HALF + n * 16;
                        const f32x4 xs = *(const f32x4*)(src + o); const f32x4 xo = xs + gv[bj][n] * acc[ai][bj][m][n];
                        *(f32x4*)(dst + o) = xo;
                        if (A) { ss += (xo[0] * xo[0] + xo[1] * xo[1]) + (xo[2] * xo[2] + xo[3] * xo[3]); const f32x4 a = xo * gs[bj][n];
                            u32x2 w; w.x = cvt_pk_bf16(a[0], a[1]); w.y = cvt_pk_bf16(a[2], a[3]); *(u32x2*)(A + (size_t)(u.pm * BM + lr) * 1024 + col0 + bj * HALF + n * 16) = w; } }
                if (A) { ss += __shfl_xor(ss, 16); ss += __shfl_xor(ss, 32);
                    if (fq == 0) rowss[(size_t)(u.pm * BM + lr) * 16 + u.pn * 4 + wc] = ss; }
                asm volatile("" ::: "memory"); }
    }
};
struct EpiPart {
    static constexpr bool PERM = false, AFTER_DRAIN = false;
    unsigned char* ws;
    __device__ __forceinline__ void operator()(const f32x4 (&acc)[2][2][4][2], const Unit& u, int wr, int wc, int fr, int fq) const {
        float* part = (float*)(ws + WS_PART) + ((size_t)(u.kc()) * 512 + (size_t)(u.pm / RT) * 256 + wr * 64 + fr) * 1024 + u.pn * BM + wc * 32 + 4 * fq;
#pragma unroll
        for (int ai = 0; ai < 2; ++ai)
#pragma unroll
            for (int m = 0; m < 4; ++m)
#pragma unroll
                for (int bj = 0; bj < 2; ++bj)
#pragma unroll
                    for (int n = 0; n < 2; ++n) *(f32x4*)(part + (ai * HALF + m * 16) * 1024 + bj * HALF + n * 16) = acc[ai][bj][m][n];
    }
};
struct EpiRes2 {
    static constexpr bool PERM = false, AFTER_DRAIN = true;
    PG8_LAS unsigned char* lds; unsigned char* ws; int l; int kind;
    __device__ __forceinline__ void operator()(const f32x4 (&acc)[2][2][4][2], const Unit& u, int wr, int wc, int fr, int fq) const {}
    __device__ __forceinline__ void fused(f32x4 (&acc)[2][2][4][2], const Unit& u, int wr, int wc, int fr, int fq, PG8_LAS unsigned char* ring, int wid, int lane) const {
        const float* mod = (const float*)(ws + WS_CTL + CTL_MOD) + (size_t)l * 3 * 6144;
        const bool lastffn = (kind == 1 && l == DEPTH - 1);
        const float* xin = (kind == 0 && l == 0) ? inptr(lds, IN_X) : nullptr;
        float* dout = (float*)inptr(lds, IN_OUT);
        const float* gate = mod + (kind == 0 ? 2048 : 5120);
        const float* gn = lastffn ? nullptr : (kind == 0 ? inptr(lds, IN_G2) + l * DM : inptr(lds, IN_G1) + (l + 1) * DM);
        const float* sc = kind == 0 ? mod + 4096 : mod + 3 * 6144 + 1024;
        bf16_t* A = lastffn ? nullptr : (bf16_t*)(ws + WS_ACT);
        float* rowss = (float*)(ws + WS_RPART) + (size_t)(2 * l + 1 + kind) * R * 16;
        const int v = tile_v(u.pm), rr0 = u.pm % RT, b = u.pm / RT;
        const size_t off = ((size_t)b * 8192 + (size_t)(rr0 - 1) * 256) * 1024;
        const float* src32 = xin ? xin + off : nullptr;
        bf16_t* res = (bf16_t*)(ws + WS_RES) + off;
        float* dst32 = lastffn ? dout + off : nullptr;
        PG8_LAS float* T = (PG8_LAS float*)ring;
        const int c = u.pn * BM + 4 * lane;
        const f32x4 gvv = *(const f32x4*)(gate + v * 6144 + c);
        f32x4 gsv = {0.f, 0.f, 0.f, 0.f}; if (A) gsv = *(const f32x4*)(gn + c) * (*(const f32x4*)(sc + v * 6144 + c) + 1.0f);
#pragma unroll
        for (int ai = 0; ai < 2; ++ai) {
#pragma unroll
            for (int m = 0; m < 4; ++m) { const int row = wr * 64 + m * 16 + fr;
#pragma unroll
                for (int bj = 0; bj < 2; ++bj)
#pragma unroll
                    for (int n = 0; n < 2; ++n) { const int g = ((bj * HALF + wc * 32 + n * 16) >> 2) + fq; *(PG8_LAS f32x4*)(T + row * 256 + ((g ^ (row & 15)) << 2)) = acc[ai][bj][m][n]; } }
            asm volatile("s_waitcnt lgkmcnt(0)" ::: "memory"); __builtin_amdgcn_s_barrier(); asm volatile("" ::: "memory");
#pragma unroll
            for (int rq = 0; rq < 4; ++rq) {
                f32x4 xs[4], tv[4];
#pragma unroll
                for (int k = 0; k < 4; ++k) { const int rr = wid * 16 + rq * 4 + k; const size_t o = (size_t)(ai * HALF + rr) * 1024 + c;
                    if (src32) xs[k] = *(const f32x4*)(src32 + o);
                    else { const u32x2 w = *(const u32x2*)(res + o); xs[k] = (f32x4){__builtin_bit_cast(float, w.x << 16), __builtin_bit_cast(float, w.x & 0xffff0000u), __builtin_bit_cast(float, w.y << 16), __builtin_bit_cast(float, w.y & 0xffff0000u)}; }
                    tv[k] = *(const PG8_LAS f32x4*)(T + rr * 256 + ((lane ^ (rr & 15)) << 2)); }
                asm volatile("" ::: "memory");
#pragma unroll
                for (int k = 0; k < 4; ++k) { const int lr = ai * HALF + wid * 16 + rq * 4 + k; const f32x4 xo = xs[k] + gvv * tv[k];
                    if (dst32) *(f32x4*)(dst32 + (size_t)lr * 1024 + c) = xo;
                    else { u32x2 w; w.x = cvt_pk_bf16(xo[0], xo[1]); w.y = cvt_pk_bf16(xo[2], xo[3]); *(u32x2*)(res + (size_t)lr * 1024 + c) = w; }
                    if (A) { const f32x4 a = xo * gsv; u32x2 w; w.x = cvt_pk_bf16(a[0], a[1]); w.y = cvt_pk_bf16(a[2], a[3]); *(u32x2*)(A + (size_t)(u.pm * BM + lr) * 1024 + c) = w;
                        float ss = (xo[0] * xo[0] + xo[1] * xo[1]) + (xo[2] * xo[2] + xo[3] * xo[3]);
                        ss += __builtin_bit_cast(float, __builtin_amdgcn_update_dpp(0, __builtin_bit_cast(int, ss), 0xB1, 0xf, 0xf, false));
                        ss += __builtin_bit_cast(float, __builtin_amdgcn_update_dpp(0, __builtin_bit_cast(int, ss), 0x4E, 0xf, 0xf, false));
                        ss += __builtin_bit_cast(float, __builtin_amdgcn_update_dpp(0, __builtin_bit_cast(int, ss), 0x141, 0xf, 0xf, false));
                        ss += __builtin_bit_cast(float, __builtin_amdgcn_update_dpp(0, __builtin_bit_cast(int, ss), 0x140, 0xf, 0xf, false));
                        ss += __builtin_bit_cast(float, __builtin_amdgcn_update_dpp(0, __builtin_bit_cast(int, ss), 0x142, 0xa, 0xf, false));
                        ss += __builtin_bit_cast(float, __builtin_amdgcn_update_dpp(0, __builtin_bit_cast(int, ss), 0x143, 0xc, 0xf, false));
                        if (lane == 63) *(f32x4*)(rowss + (size_t)(u.pm * BM + lr) * 16 + u.pn * 4) = (f32x4){ss, 0.f, 0.f, 0.f}; } }
                asm volatile("" ::: "memory"); }
            asm volatile("s_waitcnt lgkmcnt(0)" ::: "memory"); __builtin_amdgcn_s_barrier(); asm volatile("" ::: "memory");
        }
    }
};
template <class Epi, class Sched, bool ALIGN_EPI = false, bool SP2 = false>
__device__ __forceinline__ void gemm_phase(PG8_LAS unsigned char* lds, const Gemm g, const Sched& S, const Epi& E) {
    int tid_ = threadIdx.x; asm volatile("" : "+v"(tid_));
    const int tid = tid_, wid = __builtin_amdgcn_readfirstlane(tid >> 6), lane = tid & 63, wr = wid >> 2, wc = wid & 3, fr = lane & 15, fq = lane >> 4;
    const int K = g.K, nt = K / BK;
    unsigned voffA[2], voffB[2];
#pragma unroll
    for (int i = 0; i < 2; ++i) { int R, C; stage_rc(tid * 16 + i * 8192, R, C); const int Rb = Epi::PERM ? ((R & ~31) + perm32(R & 31)) : R;
        voffA[i] = (unsigned)(R * K + C) * 2u; voffB[i] = (unsigned)(Rb * K + C) * 2u; }
    const size_t kstep = (size_t)(BK * 2);
    const size_t hstep = (size_t)HALF * K * 2;
    const size_t tstep = 2 * hstep;
    const unsigned ldsw = (unsigned)wid * 1024u;
    const int aoff = lds_byte(wr * 64 + fr, fq * 8), boff = lds_byte(wc * 32 + fr, fq * 8);
#define PG8_SA(b, h) (((b) * 2 + (h)) * HTB)
#define PG8_SB(b, h) ((4 + (b) * 2 + (h)) * HTB)
#define PG8_STAGE(bufoff, gbase, voff) do { _Pragma("unroll") for (int _i = 0; _i < 2; ++_i) \
        __builtin_amdgcn_global_load_lds((const unsigned*)((const char*)(gbase) + (voff)[_i]), (PG8_LAS unsigned*)(lds + (bufoff) + ldsw + _i * 8192), 16, 0, 0); } while (0)
#define PG8_LDA(dst, b, h) do { _Pragma("unroll") for (int m = 0; m < 4; ++m) _Pragma("unroll") for (int k = 0; k < 2; ++k) dst[m][k] = *(const PG8_LAS bf16x8*)(lds + PG8_SA(b, h) + aoff + m * 2048 + k * 1024); } while (0)
#define PG8_LDB(dst, b, h) do { _Pragma("unroll") for (int n = 0; n < 2; ++n) _Pragma("unroll") for (int k = 0; k < 2; ++k) dst[n][k] = *(const PG8_LAS bf16x8*)(lds + PG8_SB(b, h) + boff + n * 2048 + k * 1024); } while (0)
#define PG8_MMA(ai, bj, At, Bt) do { __builtin_amdgcn_s_setprio(1); _Pragma("unroll") for (int m = 0; m < 4; ++m) _Pragma("unroll") for (int n = 0; n < 2; ++n) _Pragma("unroll") for (int k = 0; k < 2; ++k) \
        acc[ai][bj][m][n] = __builtin_amdgcn_mfma_f32_16x16x32_bf16(Bt[n][k], At[m][k], acc[ai][bj][m][n], 0, 0, 0); __builtin_amdgcn_s_setprio(0); } while (0)
#define PG8_WAIT_V(n) asm volatile("s_waitcnt vmcnt(" #n ")" ::: "memory")
#define PG8_WAIT_L(n) asm volatile("s_waitcnt lgkmcnt(" #n ")" ::: "memory")
#define PG8_BAR __builtin_amdgcn_s_barrier()
#define PG8_SCHED __builtin_amdgcn_sched_barrier(0)
    Unit cur, nxt; int ui = 0;
    if (!S.next(0, cur)) return;
    f32x4 acc[2][2][4][2];
#pragma unroll
    for (int a = 0; a < 2; ++a)
#pragma unroll
        for (int b = 0; b < 2; ++b)
#pragma unroll
            for (int m = 0; m < 4; ++m)
#pragma unroll
                for (int n = 0; n < 2; ++n) acc[a][b][m][n] = (f32x4){0.f, 0.f, 0.f, 0.f};
    bf16x8 At[4][2], B0[2][2], B1[2][2];
    const char* cA = (const char*)g.A + (size_t)cur.pm * tstep + (size_t)cur.kt0() * kstep; const char* cB = (const char*)g.Bt + (size_t)cur.pn * tstep + (size_t)cur.kt0() * kstep;
    S.a_ready(cur);
    if constexpr (SP2) {
        PG8_STAGE(PG8_SB(0, 0), cB, voffB); PG8_STAGE(PG8_SB(0, 1), cB + hstep, voffB); PG8_STAGE(PG8_SA(0, 0), cA, voffA); PG8_STAGE(PG8_SA(0, 1), cA + hstep, voffA);
        if (wr == 1) PG8_BAR;
        PG8_WAIT_V(2); PG8_BAR;
        PG8_STAGE(PG8_SB(1, 0), cB + kstep, voffB); PG8_STAGE(PG8_SA(1, 0), cA + kstep, voffA); PG8_STAGE(PG8_SB(1, 1), cB + hstep + kstep, voffB);
        PG8_WAIT_V(6); PG8_BAR;
    } else {
        PG8_STAGE(PG8_SB(0, 0), cB, voffB); PG8_STAGE(PG8_SA(0, 0), cA, voffA); PG8_STAGE(PG8_SB(0, 1), cB + hstep, voffB); PG8_STAGE(PG8_SA(0, 1), cA + hstep, voffA);
        if (wr == 1) PG8_BAR;
        PG8_WAIT_V(4); PG8_BAR;
        PG8_STAGE(PG8_SB(1, 0), cB + kstep, voffB); PG8_STAGE(PG8_SA(1, 0), cA + kstep, voffA); PG8_STAGE(PG8_SB(1, 1), cB + hstep + kstep, voffB);
        PG8_WAIT_V(6); PG8_BAR;
    }
    for (;;) {
        const bool has_next = S.next(ui + 1, nxt);
        const char* nA = has_next ? (const char*)g.A + (size_t)nxt.pm * tstep + (size_t)nxt.kt0() * kstep : cA; const char* nB = has_next ? (const char*)g.Bt + (size_t)nxt.pn * tstep + (size_t)nxt.kt0() * kstep : cB;
        const int ntc = cur.nt();
        for (int t = 0; t < ntc; t += 2) {
            const bool last = (t == ntc - 2);
            const char* a1 = cA + (size_t)(t + 1) * kstep;
            const char* a2 = last ? nA : cA + (size_t)(t + 2) * kstep; const char* b2 = last ? nB : cB + (size_t)(t + 2) * kstep;
            const char* a3 = a2 + kstep; const char* b3 = b2 + kstep;
            if (last && has_next) S.a_ready(nxt);
            if constexpr (SP2) {
            PG8_LDB(B0, 0, 0); PG8_LDB(B1, 0, 1); PG8_SCHED; PG8_LDA(At, 0, 0); PG8_STAGE(PG8_SA(1, 1), a1 + hstep, voffA);
            PG8_WAIT_V(8); PG8_WAIT_L(0); PG8_BAR; PG8_MMA(0, 0, At, B0); PG8_MMA(0, 1, At, B1); PG8_BAR; PG8_SCHED;
            PG8_LDA(At, 0, 1); PG8_STAGE(PG8_SB(0, 0), b2, voffB); PG8_STAGE(PG8_SB(0, 1), b2 + hstep, voffB); PG8_STAGE(PG8_SA(0, 0), a2, voffA);
            PG8_WAIT_V(8); PG8_WAIT_L(0); PG8_BAR; PG8_MMA(1, 0, At, B0); PG8_MMA(1, 1, At, B1); PG8_BAR; PG8_SCHED;
            PG8_LDB(B0, 1, 0); PG8_LDB(B1, 1, 1); PG8_SCHED; PG8_LDA(At, 1, 0); PG8_STAGE(PG8_SA(0, 1), a2 + hstep, voffA);
            PG8_WAIT_V(8); PG8_WAIT_L(0); PG8_BAR; PG8_MMA(0, 0, At, B0); PG8_MMA(0, 1, At, B1); PG8_BAR; PG8_SCHED;
            PG8_LDA(At, 1, 1); PG8_STAGE(PG8_SB(1, 0), b3, voffB); PG8_STAGE(PG8_SB(1, 1), b3 + hstep, voffB); PG8_STAGE(PG8_SA(1, 0), a3, voffA);
            PG8_WAIT_V(8); PG8_WAIT_L(0); PG8_BAR; PG8_MMA(1, 0, At, B0); PG8_MMA(1, 1, At, B1); PG8_BAR; PG8_SCHED;
            } else {
            PG8_LDB(B0, 0, 0); PG8_SCHED; PG8_LDA(At, 0, 0); PG8_STAGE(PG8_SA(1, 1), a1 + hstep, voffA);
            PG8_WAIT_L(8); PG8_BAR; PG8_WAIT_L(0); PG8_MMA(0, 0, At, B0); PG8_BAR; PG8_SCHED;
            PG8_LDB(B1, 0, 1); PG8_STAGE(PG8_SB(0, 0), b2, voffB);
            PG8_BAR; PG8_WAIT_L(0); PG8_MMA(0, 1, At, B1); PG8_BAR;
            PG8_LDA(At, 0, 1); PG8_STAGE(PG8_SA(0, 0), a2, voffA);
            PG8_BAR; PG8_WAIT_L(0); PG8_MMA(1, 0, At, B0); PG8_BAR; PG8_SCHED;
            PG8_STAGE(PG8_SB(0, 1), b2 + hstep, voffB);
            PG8_WAIT_V(6); PG8_BAR; PG8_MMA(1, 1, At, B1); PG8_BAR;
            PG8_LDB(B0, 1, 0); PG8_SCHED; PG8_LDA(At, 1, 0); PG8_STAGE(PG8_SA(0, 1), a2 + hstep, voffA);
            PG8_WAIT_L(8); PG8_BAR; PG8_WAIT_L(0); PG8_MMA(0, 0, At, B0); PG8_BAR; PG8_SCHED;
            PG8_LDB(B1, 1, 1); PG8_STAGE(PG8_SB(1, 0), b3, voffB);
            PG8_BAR; PG8_WAIT_L(0); PG8_MMA(0, 1, At, B1); PG8_BAR;
            PG8_LDA(At, 1, 1); PG8_STAGE(PG8_SA(1, 0), a3, voffA);
            PG8_BAR; PG8_WAIT_L(0); PG8_MMA(1, 0, At, B0); PG8_BAR; PG8_SCHED;
            PG8_STAGE(PG8_SB(1, 1), b3 + hstep, voffB);
            PG8_WAIT_V(6); PG8_BAR; PG8_MMA(1, 1, At, B1); PG8_BAR;
            }
        }
        if constexpr (ALIGN_EPI) { if (wr == 0) PG8_BAR; }
        if constexpr (!Epi::AFTER_DRAIN) { E(acc, cur, wr, wc, fr, fq); S.done(cur); }
        if (!has_next) break;
#pragma unroll
        for (int a = 0; a < 2; ++a)
#pragma unroll
            for (int b = 0; b < 2; ++b)
#pragma unroll
                for (int m = 0; m < 4; ++m)
#pragma unroll
                    for (int n = 0; n < 2; ++n) acc[a][b][m][n] = (f32x4){0.f, 0.f, 0.f, 0.f};
        cur = nxt; cA = nA; cB = nB; ++ui;
        if constexpr (ALIGN_EPI) { if (wr == 1) PG8_BAR; }
    }
    PG8_WAIT_V(0);
    if constexpr (!ALIGN_EPI) { if (wr == 0) PG8_BAR; }
    PG8_BAR;
    if constexpr (Epi::AFTER_DRAIN) { E.fused(acc, cur, wr, wc, fr, fq, lds, wid, lane); S.done(cur); }
#undef PG8_SA
#undef PG8_SB
#undef PG8_STAGE
#undef PG8_LDA
#undef PG8_LDB
#undef PG8_MMA
#undef PG8_WAIT_V
#undef PG8_WAIT_L
#undef PG8_BAR
#undef PG8_SCHED
}
}

#include <hip/hip_bf16.h>
#include <cmath>
namespace attn_body {
using bf16=__hip_bfloat16;
using bf16x8=__attribute__((ext_vector_type(8)))short;
using s16x4=__attribute__((ext_vector_type(4)))short;
using f32x16=__attribute__((ext_vector_type(16)))float;
using u32x4=__attribute__((ext_vector_type(4)))unsigned;
constexpr int D=64,QP=256,KP=128,VP=128,OP=1024;
constexpr int NW=8,QBLK=32,QB=QBLK*NW,KVBLK=64;
constexpr int ATTN_UNIT_ROWS=QB;
__device__ __forceinline__ int crow(int r,int hi){return (r&3)+8*(r>>2)+4*hi;}
#define SBAR() __builtin_amdgcn_sched_barrier(0)
constexpr int NSLOT=3, SLOTB=8192;
constexpr int LDS_K=0, LDS_V=NSLOT*SLOTB, LDS_WS=2*NSLOT*SLOTB, LDS_OST=LDS_WS+NW*64*4, LDS_BYTES=LDS_OST+NW*4096;
constexpr float C2=0.125f*1.4426950408889634f;
__device__ __forceinline__ void glds16(const void*gsrc,unsigned lds_dst){unsigned keep;
  asm volatile("s_mov_b32 %0, m0\n\ts_mov_b32 m0, %2\n\ts_nop 0\n\tglobal_load_lds_dwordx4 %1, off\n\ts_mov_b32 m0, %0":"=&s"(keep):"v"(gsrc),"s"(lds_dst):"memory");}
__device__ __forceinline__ float max3f(float a,float b,float c){float r;asm("v_max3_f32 %0, %1, %2, %3":"=v"(r):"v"(a),"v"(b),"v"(c));return r;}
__device__ __forceinline__ float max2f(float a,float b){float r;asm("v_max_f32_e32 %0, %1, %2":"=v"(r):"v"(a),"v"(b));return r;}
__device__ __forceinline__ float fadd_s(float a,float b){float r;asm("v_add_f32_e32 %0, %1, %2":"=v"(r):"v"(a),"v"(b));return r;}
__device__ __forceinline__ float fsub_s(float a,float b){float r;asm("v_sub_f32_e32 %0, %1, %2":"=v"(r):"v"(a),"v"(b));return r;}
typedef float f32x2_t __attribute__((ext_vector_type(2))); typedef __bf16 bf16x2_t __attribute__((ext_vector_type(2)));
__device__ __forceinline__ unsigned cvtpk_s(float lo,float hi){f32x2_t v={lo,hi};bf16x2_t b=__builtin_convertvector(v,bf16x2_t);return __builtin_bit_cast(unsigned,b);}
#define WAIT_BAR(N) asm volatile("s_waitcnt vmcnt(" #N ") lgkmcnt(0)\n\ts_barrier":::"memory")

__device__ __forceinline__ void qkt(f32x16&p0,f32x16&p1,const char*Kslot,const bf16x8*qr,const f32x16&negm,int r32,int hi){
  const char*kb=Kslot+hi*1024+r32*16;
  #pragma unroll
  for(int d0=0;d0<4;++d0){
    const bf16x8 b0=*reinterpret_cast<const bf16x8*>(kb+d0*2048);
    const bf16x8 b1=*reinterpret_cast<const bf16x8*>(kb+d0*2048+512);
    if(d0==0){p0=__builtin_amdgcn_mfma_f32_32x32x16_bf16(b0,qr[0],negm,0,0,0);p1=__builtin_amdgcn_mfma_f32_32x32x16_bf16(b1,qr[0],negm,0,0,0);}
    else{p0=__builtin_amdgcn_mfma_f32_32x32x16_bf16(b0,qr[d0],p0,0,0,0);p1=__builtin_amdgcn_mfma_f32_32x32x16_bf16(b1,qr[d0],p1,0,0,0);}}
}
typedef __attribute__((address_space(3))) const char* lds_cptr;
typedef short v4i16_t __attribute__((ext_vector_type(4)));
__device__ __forceinline__ void kload8(bf16x8*kf,lds_cptr kp){
  kf[0]=*(const __attribute__((address_space(3))) bf16x8*)(kp);      kf[1]=*(const __attribute__((address_space(3))) bf16x8*)(kp+512);
  kf[2]=*(const __attribute__((address_space(3))) bf16x8*)(kp+2048); kf[3]=*(const __attribute__((address_space(3))) bf16x8*)(kp+2560);
  kf[4]=*(const __attribute__((address_space(3))) bf16x8*)(kp+4096); kf[5]=*(const __attribute__((address_space(3))) bf16x8*)(kp+4608);
  kf[6]=*(const __attribute__((address_space(3))) bf16x8*)(kp+6144); kf[7]=*(const __attribute__((address_space(3))) bf16x8*)(kp+6656);
}
__device__ __forceinline__ void kload2(bf16x8*kf,lds_cptr kp,int j){ kf[2*j]=*(const __attribute__((address_space(3))) bf16x8*)(kp+j*2048); kf[2*j+1]=*(const __attribute__((address_space(3))) bf16x8*)(kp+j*2048+512); }
__device__ __forceinline__ s16x4 vtr(lds_cptr p){ return __builtin_bit_cast(s16x4,__builtin_amdgcn_ds_read_tr16_b64_v4i16((__attribute__((address_space(3))) v4i16_t*)p)); }
__device__ __forceinline__ float rowmax(const f32x16&p0,const f32x16&p1){
  float a=max3f(p0[0],p0[1],p1[0]),b=max3f(p0[2],p0[3],p1[1]);a=max3f(a,p1[2],p1[3]);
  #pragma unroll
  for(int r=4;r<16;r+=4){a=max3f(a,p0[r],p0[r+1]);b=max3f(b,p0[r+2],p0[r+3]);a=max3f(a,p1[r],p1[r+1]);b=max3f(b,p1[r+2],p1[r+3]);}
  const float m=max2f(a,b);
  auto rr=__builtin_amdgcn_permlane32_swap(__float_as_uint(m),__float_as_uint(m),false,false);
  return max2f(__uint_as_float(rr[0]),__uint_as_float(rr[1]));
}
__device__ __forceinline__ void pv(f32x16*o,int vb,bf16x8 pa0,bf16x8 pa1,bf16x8 pa2,bf16x8 pa3){
  #pragma unroll
  for(int d0=0;d0<2;++d0){s16x4 lo[4],hi[4];
    #pragma unroll
    for(int ks=0;ks<4;++ks){
      asm volatile("ds_read_b64_tr_b16 %0,%1 offset:%c2":"=&v"(lo[ks]):"v"(vb),"i"(d0*4096+ks*1024):"memory");
      asm volatile("ds_read_b64_tr_b16 %0,%1 offset:%c2":"=&v"(hi[ks]):"v"(vb),"i"(d0*4096+ks*1024+512):"memory");}
    asm volatile("s_waitcnt lgkmcnt(0)":::"memory");SBAR();
    #define PK(k) (bf16x8){lo[k][0],lo[k][1],lo[k][2],lo[k][3],hi[k][0],hi[k][1],hi[k][2],hi[k][3]}
    o[d0]=__builtin_amdgcn_mfma_f32_32x32x16_bf16(pa0,PK(0),o[d0],0,0,0);
    o[d0]=__builtin_amdgcn_mfma_f32_32x32x16_bf16(pa1,PK(1),o[d0],0,0,0);
    o[d0]=__builtin_amdgcn_mfma_f32_32x32x16_bf16(pa2,PK(2),o[d0],0,0,0);
    o[d0]=__builtin_amdgcn_mfma_f32_32x32x16_bf16(pa3,PK(3),o[d0],0,0,0);
    #undef PK
  }
}

#ifndef ATTN_STORE16
#define ATTN_STORE16(p,v) (*(u32x4*)(p)=(v))
#endif
template<int THRL> __device__ __forceinline__ void attn_unit(const long rowbase,const int h,const int q0,const int NT,const bf16*Q,const bf16*__restrict__ K,const bf16*__restrict__ V,bf16*O,char*shm){
  int tid_=threadIdx.x; asm volatile("":"+v"(tid_)); const int tid=tid_,lane=tid&63,r32=lane&31,hi=lane>>5; const int wid=__builtin_amdgcn_readfirstlane(tid>>6);
  const bf16*Qw=Q+(rowbase+q0+wid*QBLK)*QP+h*D;
  const bf16*Kh=K+rowbase*KP+(h>>1)*D,*Vh=V+rowbase*VP+(h>>1)*D;
  const unsigned lds0=(unsigned)(uintptr_t)shm;
  float*wsf=(float*)(shm+LDS_WS)+wid*64;
  const bf16*ksrc=Kh+(long)lane*KP+wid*8;
  const bf16*vsrc=Vh+(long)(16*(wid&3)+(lane>>2))*VP+(wid>>2)*32+(lane&3)*8;
  const unsigned kdst=lds0+LDS_K+wid*1024, vdst=lds0+LDS_V+wid*1024;
  #define DMA_K(t,slot) glds16(ksrc+(long)(t)*KVBLK*KP,(unsigned)__builtin_amdgcn_readfirstlane(kdst+(slot)))
  #define DMA_V(t,slot) glds16(vsrc+(long)(t)*KVBLK*VP,(unsigned)__builtin_amdgcn_readfirstlane(vdst+(slot)))
  const int vb0=(int)(lds0+LDS_V)+((lane>>4)&1)*32+(lane&3)*8+(4*hi+((lane&15)>>2))*64;
  const char*Kbase=shm+LDS_K; bf16x8 kf[8];
  const lds_cptr shm3=(lds_cptr)shm; const lds_cptr kp0=shm3+LDS_K+hi*1024+r32*16; const lds_cptr vp0=shm3+LDS_V+((lane>>4)&1)*32+(lane&3)*8+(4*hi+((lane&15)>>2))*64;
  DMA_K(0,0);DMA_V(0,0);DMA_K(1,SLOTB);
  bf16x8 qr[4];
  #pragma unroll
  for(int d0=0;d0<4;++d0)qr[d0]=*reinterpret_cast<const bf16x8*>(&Qw[(long)r32*QP+d0*16+hi*8]);
  float mhat=0.f,l_reg=0.f;f32x16 o[2];o[0]=f32x16{};o[1]=f32x16{};f32x16 negm=f32x16{};asm volatile("":"+v"(negm));
  #define CMASK(P0,P1,t) do{}while(0)
  bool resc=false;
  #define START(P0,P1) do{ const float rm=rowmax(P0,P1); resc=false; \
    { const float dl=rm; mhat=fadd_s(mhat,dl); \
      _Pragma("unroll") for(int r=0;r<16;++r){P0[r]=fsub_s(P0[r],dl);P1[r]=fsub_s(P1[r],dl);} \
      _Pragma("unroll") for(int r=0;r<16;++r)negm[r]=-mhat; asm volatile("":"+v"(negm)); } \
    _Pragma("unroll") for(int r=0;r<16;++r)P0[r]=__builtin_amdgcn_exp2f(P0[r]); }while(0)
  #define RESC() do{ if(resc){ asm volatile("s_waitcnt lgkmcnt(0)":::"memory"); \
      _Pragma("unroll") for(int d_=0;d_<2;++d_) _Pragma("unroll") for(int r=0;r<16;++r)o[d_][r]*=wsf[crow(r,hi)]; } }while(0)
  f32x16 pA0,pA1,pB0,pB1;
  int sl_prev=0,sl_cur=0,sl_next=SLOTB;
  #define ROT() do{sl_prev=sl_cur;sl_cur=sl_next;sl_next=(sl_next==(NSLOT-1)*SLOTB)?0:sl_next+SLOTB;}while(0)
  DMA_K(2,2*SLOTB);
  WAIT_BAR(3);
  qkt(pA0,pA1,Kbase,qr,negm,r32,hi);asm volatile("s_nop 15\n\ts_nop 7":"+v"(pA0),"+v"(pA1));CMASK(pA0,pA1,0);
  START(pA0,pA1);
  _Pragma("unroll") for(int r=0;r<16;++r)pA1[r]=__builtin_amdgcn_exp2f(pA1[r]);
  WAIT_BAR(0);
  DMA_K(3,0);DMA_V(1,SLOTB);
  ROT();
  kload8(kf,kp0+sl_cur);
  WAIT_BAR(2);
  s16x4 vlo[8],vhi[8]; u32x4 pw0,pw1,pw2,pw3;
  #define PKW(P,B) cvtpk_s(P[B],P[B+1])
  #define PAF(k) __builtin_bit_cast(bf16x8,pw##k)
  #define VFR(i) (bf16x8){vlo[i][0],vlo[i][1],vlo[i][2],vlo[i][3],vhi[i][0],vhi[i][1],vhi[i][2],vhi[i][3]}
  #define PIN(x) asm volatile("":"+v"(x))
  #define MX3(a,b,c) __builtin_fmaxf(__builtin_fmaxf((a),(b)),(c))
  #define GAPA(MF,A0,A1,A2,A3,W0,W1,PW) do{ MF; sacc+=A0; sacc+=A1; sacc+=A2; sacc+=A3; PIN(sacc); W0; W1; PIN(PW); SBAR(); }while(0)
  #define EX(v) __builtin_amdgcn_exp2f(v)
  #define GAPB(MF,X,B) do{ MF; X[B]=EX(X[B]); X[B+1]=EX(X[B+1]); X[B+2]=EX(X[B+2]); X[B+3]=EX(X[B+3]); PIN(X); SBAR(); }while(0)
  #define VRD(i) do{ vlo[i]=vtr(vp_+(((i)>>2)*4096+((i)&3)*1024)); vhi[i]=vtr(vp_+(((i)>>2)*4096+((i)&3)*1024+512)); }while(0)
  #define KRD(G,j) do{ if(G){ kload2(kf,kp0+sl_next,j); SBAR(); } }while(0)
  #define STEP(C0,C1,P0,P1,t,GK,GV,GL) do{ SBAR(); \
    const lds_cptr vp_=vp0+sl_prev; \
    VRD(0); SBAR(); float sacc=(P0[0]+P0[1]); \
    GAPA(C0=__builtin_amdgcn_mfma_f32_32x32x16_bf16(kf[0],qr[0],negm,0,0,0), P0[2],P0[3],P0[4],P0[5],     pw0[0]=PKW(P0,0), pw0[1]=PKW(P0,2), pw0); \
    VRD(4); SBAR(); GAPA(C1=__builtin_amdgcn_mfma_f32_32x32x16_bf16(kf[1],qr[0],negm,0,0,0), P0[6],P0[7],P0[8],P0[9],     pw0[2]=PKW(P0,4), pw0[3]=PKW(P0,6), pw0); \
    VRD(1); SBAR(); GAPA(C0=__builtin_amdgcn_mfma_f32_32x32x16_bf16(kf[2],qr[1],C0,0,0,0),   P0[10],P0[11],P0[12],P0[13], pw1[0]=PKW(P0,8), pw1[1]=PKW(P0,10), pw1); \
    VRD(5); SBAR(); GAPA(C1=__builtin_amdgcn_mfma_f32_32x32x16_bf16(kf[3],qr[1],C1,0,0,0),   P0[14],P0[15],P1[0],P1[1],   pw1[2]=PKW(P0,12),pw1[3]=PKW(P0,14), pw1); \
    VRD(2); SBAR(); GAPA(C0=__builtin_amdgcn_mfma_f32_32x32x16_bf16(kf[4],qr[2],C0,0,0,0),   P1[2],P1[3],P1[4],P1[5],     pw2[0]=PKW(P1,0), pw2[1]=PKW(P1,2), pw2); \
    VRD(6); SBAR(); GAPA(C1=__builtin_amdgcn_mfma_f32_32x32x16_bf16(kf[5],qr[2],C1,0,0,0),   P1[6],P1[7],P1[8],P1[9],     pw2[2]=PKW(P1,4), pw2[3]=PKW(P1,6), pw2); \
    VRD(3); SBAR(); GAPA(C0=__builtin_amdgcn_mfma_f32_32x32x16_bf16(kf[6],qr[3],C0,0,0,0),   P1[10],P1[11],P1[12],P1[13], pw3[0]=PKW(P1,8), pw3[1]=PKW(P1,10), pw3); \
    VRD(7); SBAR(); GAPA(C1=__builtin_amdgcn_mfma_f32_32x32x16_bf16(kf[7],qr[3],C1,0,0,0),   P1[14],P1[15],0.f,0.f,       pw3[2]=PKW(P1,12),pw3[3]=PKW(P1,14), pw3); \
    l_reg+=sacc; \
    if(GK){DMA_K((t)+3,sl_cur);} if(GV){DMA_V((t)+1,sl_next);} \
    CMASK(C0,C1,t); \
    { float a=MX3(C0[0],C0[1],C1[0]),b=MX3(C0[2],C0[3],C1[1]); a=MX3(a,C1[2],C1[3]); \
      _Pragma("unroll") for(int r=4;r<16;r+=4){a=MX3(a,C0[r],C0[r+1]);b=MX3(b,C0[r+2],C0[r+3]);a=MX3(a,C1[r],C1[r+1]);b=MX3(b,C1[r+2],C1[r+3]);} \
      float rm=__builtin_fmaxf(a,b); { auto rr=__builtin_amdgcn_permlane32_swap(__float_as_uint(rm),__float_as_uint(rm),false,false); rm=__builtin_fmaxf(__uint_as_float(rr[0]),__uint_as_float(rr[1])); } \
      resc=false; \
      if(__builtin_expect(__any(rm>(float)THRL),0)){ const float dl=__builtin_fmaxf(rm,0.f); mhat+=dl; \
        _Pragma("unroll") for(int r=0;r<16;++r){C0[r]-=dl;C1[r]-=dl;} \
        _Pragma("unroll") for(int r=0;r<16;++r)negm[r]=-mhat; asm volatile("":"+v"(negm)); \
        const float f=__builtin_amdgcn_exp2f(-dl); l_reg*=f; if(hi==0)wsf[r32]=f; resc=true; } } \
    SBAR(); \
    GAPB(o[0]=__builtin_amdgcn_mfma_f32_32x32x16_bf16(PAF(0),VFR(0),o[0],0,0,0), C0,0); \
    GAPB(o[1]=__builtin_amdgcn_mfma_f32_32x32x16_bf16(PAF(0),VFR(4),o[1],0,0,0), C0,4); \
    KRD(GL,0); GAPB(o[0]=__builtin_amdgcn_mfma_f32_32x32x16_bf16(PAF(1),VFR(1),o[0],0,0,0), C0,8); \
    KRD(GL,1); GAPB(o[1]=__builtin_amdgcn_mfma_f32_32x32x16_bf16(PAF(1),VFR(5),o[1],0,0,0), C0,12); \
    KRD(GL,2); GAPB(o[0]=__builtin_amdgcn_mfma_f32_32x32x16_bf16(PAF(2),VFR(2),o[0],0,0,0), C1,0); \
    KRD(GL,3); GAPB(o[1]=__builtin_amdgcn_mfma_f32_32x32x16_bf16(PAF(2),VFR(6),o[1],0,0,0), C1,4); \
    GAPB(o[0]=__builtin_amdgcn_mfma_f32_32x32x16_bf16(PAF(3),VFR(3),o[0],0,0,0), C1,8); \
    GAPB(o[1]=__builtin_amdgcn_mfma_f32_32x32x16_bf16(PAF(3),VFR(7),o[1],0,0,0), C1,12); \
    }while(0)
  int t=1;
  #undef CMASK
  #define CMASK(P0,P1,t) do{}while(0)
  for(;t+5<NT;t+=2){
    STEP(pB0,pB1,pA0,pA1,t,true,true,true);     WAIT_BAR(2); RESC(); ROT();
    STEP(pA0,pA1,pB0,pB1,t+1,true,true,true);   WAIT_BAR(2); RESC(); ROT();
  }
  #undef CMASK
  #define CMASK(P0,P1,t) do{}while(0)
  #define ENDW(tt) do{ if((tt)+3<NT){WAIT_BAR(2);} else if((tt)+2<NT){WAIT_BAR(1);} else {WAIT_BAR(0);} }while(0)
  for(;t+1<NT;t+=2){
    STEP(pB0,pB1,pA0,pA1,t,(t+3<NT),(t+1<NT),(t+1<NT));       ENDW(t);   RESC(); ROT();
    STEP(pA0,pA1,pB0,pB1,t+1,(t+4<NT),(t+2<NT),(t+2<NT));     ENDW(t+1); RESC(); ROT();
  }
  STEP(pB0,pB1,pA0,pA1,NT-1,false,false,false); RESC();
  { float sacc=pB0[0]+pB0[1]; _Pragma("unroll") for(int r=2;r<16;++r)sacc+=pB0[r]; _Pragma("unroll") for(int r=0;r<16;++r)sacc+=pB1[r]; l_reg+=sacc;
    pw0=(u32x4){PKW(pB0,0),PKW(pB0,2),PKW(pB0,4),PKW(pB0,6)};pw1=(u32x4){PKW(pB0,8),PKW(pB0,10),PKW(pB0,12),PKW(pB0,14)};pw2=(u32x4){PKW(pB1,0),PKW(pB1,2),PKW(pB1,4),PKW(pB1,6)};pw3=(u32x4){PKW(pB1,8),PKW(pB1,10),PKW(pB1,12),PKW(pB1,14)};
    SBAR(); pv(o,vb0+sl_cur,PAF(0),PAF(1),PAF(2),PAF(3)); }
  #undef PKW
  #undef PAF
  #undef VFR
  #undef PIN
  #undef MX3
  #undef GAPA
  #undef GAPB
  #undef EX
  #undef VRD
  #undef KRD
  #undef STEP
  #undef ENDW
  {auto rr=__builtin_amdgcn_permlane32_swap(__float_as_uint(l_reg),__float_as_uint(l_reg),false,false);l_reg=__uint_as_float(rr[0])+__uint_as_float(rr[1]);}
  if(hi==0)wsf[32+r32]=l_reg;asm volatile("s_waitcnt lgkmcnt(0)":::"memory");
  float rli[16];
  #pragma unroll
  for(int r=0;r<16;++r)rli[r]=__builtin_amdgcn_rcpf(wsf[32+crow(r,hi)]);
  bf16*Ow=O+(rowbase+q0+wid*QBLK)*OP+h*D;
  { bf16*stg=(bf16*)(shm+LDS_OST)+wid*2048;
    #pragma unroll
    for(int r=0;r<16;++r){const int orow=crow(r,hi);
      #pragma unroll
      for(int d0=0;d0<2;++d0)stg[orow*64+d0*32+r32]=__float2bfloat16(o[d0][r]*rli[r]);}
    asm volatile("s_waitcnt lgkmcnt(0)":::"memory");
    #pragma unroll
    for(int i=0;i<4;++i){const int row=i*8+(lane>>3),ch=lane&7; const u32x4 v=*(const u32x4*)(stg+row*64+ch*8); ATTN_STORE16(Ow+(long)row*OP+ch*8,v);} }
  asm volatile("s_waitcnt lgkmcnt(0)\n\ts_barrier":::"memory");
  #undef DMA_K
  #undef DMA_V
  #undef CMASK
  #undef START
  #undef RESC
  #undef ROT
}
constexpr int ATTN_LDS_BYTES=LDS_BYTES;
#undef SBAR
#undef WAIT_BAR
}

#define GAS __attribute__((address_space(1)))
#define LAS __attribute__((address_space(3)))
typedef unsigned short bf16;
typedef unsigned v4u __attribute__((ext_vector_type(4)));
typedef float f32x4 __attribute__((ext_vector_type(4)));
typedef short bf16x8 __attribute__((ext_vector_type(8)));
typedef GAS unsigned gu32;
typedef GAS unsigned long long gu64;
#define RLX_AGENT __ATOMIC_RELAXED, __HIP_MEMORY_SCOPE_AGENT
#define LDS_WAIT() asm volatile("s_waitcnt lgkmcnt(0)" ::: "memory")
#define VM_WAIT() asm volatile("s_waitcnt vmcnt(0)" ::: "memory")
__device__ __forceinline__ unsigned long long rt() { return __builtin_amdgcn_s_memrealtime(); }
__device__ __forceinline__ unsigned f2bf(float f) { unsigned u = __builtin_bit_cast(unsigned, f); return (u + 0x7fffu + ((u >> 16) & 1u)) >> 16; }
__device__ __forceinline__ unsigned pk2(float lo, float hi) { return f2bf(lo) | (f2bf(hi) << 16); }

#define XB_TMO      128
#define XB_XCNT(j)  (256  + 64 * (j))
#define XB_XSUB(j)  (1280 + 64 * (j))
#define XB_XGEN(j)  (2304 + 64 * (j))
#define XB_TOP      3328
#define XB_TOPGEN   3392
#define XCD_BAR_WORDS 3456
#define XB_SPIN_CAP (1u << 18)

__device__ __forceinline__ unsigned xb_ld(unsigned* p)              { return __hip_atomic_load(p, __ATOMIC_RELAXED, __HIP_MEMORY_SCOPE_AGENT); }
__device__ __forceinline__ unsigned xb_add(unsigned* p, unsigned v) { return __hip_atomic_fetch_add(p, v, __ATOMIC_RELAXED, __HIP_MEMORY_SCOPE_AGENT); }
__device__ __forceinline__ unsigned xb_xcc_id() { return (unsigned)__builtin_amdgcn_s_getreg((3 << 11) | 20) & 0xFu; }
#define XB_SPIN(cond, bar) do { unsigned _sp = 0; while (cond) { __builtin_amdgcn_s_sleep(1); \
    if ((++_sp & 255u) == 0u) { if (xb_ld(&(bar)[XB_TMO])) break; if (_sp > XB_SPIN_CAP) { atomicAdd(&(bar)[XB_TMO], 1u); break; } } } } while (0)

struct XcdBarrier {
    unsigned* bar; unsigned x;
    volatile LAS unsigned* st;
};

__device__ __forceinline__ XcdBarrier xcd_barrier_post(unsigned* bar, volatile LAS unsigned* st) {
    XcdBarrier b; b.bar = bar; b.x = xb_xcc_id(); b.st = st;
    if (threadIdx.x == 0) (void)xb_add(&bar[XB_XCNT(b.x)], 1u);
    return b;
}
__device__ __forceinline__ void xcd_barrier_complete(unsigned* bar, unsigned x, unsigned& nloc, unsigned& nx) {
    const unsigned G = gridDim.x * gridDim.y * gridDim.z;
    unsigned sum, cnt, mine, sp = 0u;
    for (;;) {
        sum = 0u; cnt = 0u; mine = 0u;
#pragma unroll
        for (unsigned j = 0; j < 16; ++j) { const unsigned c = xb_ld(&bar[XB_XCNT(j)]); sum += c; cnt += (c > 0u) ? 1u : 0u; mine = (j == x) ? c : mine; }
        if (sum == G) break;
        __builtin_amdgcn_s_sleep(1);
        if ((++sp & 255u) == 0u) { if (xb_ld(&bar[XB_TMO])) break; if (sp > XB_SPIN_CAP) { atomicAdd(&bar[XB_TMO], 1u); break; } }
    }
    nloc = mine > 0u ? mine : 1u; nx = cnt > 0u ? cnt : 1u;
}

__device__ __forceinline__ void xcd_barrier(const XcdBarrier& b) {
    asm volatile("s_waitcnt vmcnt(0)" ::: "memory");
    __syncthreads();
    if (threadIdx.x == 0) {
        unsigned* bar = b.bar;
        __builtin_amdgcn_s_waitcnt(0);
        unsigned nloc = b.st[0], nx = b.st[1];
        if (nloc == 0u) { xcd_barrier_complete(bar, b.x, nloc, nx); b.st[0] = nloc; b.st[1] = nx; }
        const unsigned old = xb_add(&bar[XB_XSUB(b.x)], 1u);
        const unsigned gen = old / nloc;
        if (old + 1u == (gen + 1u) * nloc) {
            __builtin_amdgcn_fence(__ATOMIC_RELEASE, "agent");
            asm volatile("s_waitcnt vmcnt(0)" ::: "memory");
            const unsigned og = xb_add(&bar[XB_TOP], 1u);
            const unsigned tg = og / nx;
            if (og + 1u == (tg + 1u) * nx) xb_add(&bar[XB_TOPGEN], 1u);
            else XB_SPIN(xb_ld(&bar[XB_TOPGEN]) == tg, bar);
            __builtin_amdgcn_fence(__ATOMIC_ACQUIRE, "agent");
            xb_add(&bar[XB_XGEN(b.x)], 1u);
            asm volatile("s_waitcnt vmcnt(0)" ::: "memory");
        } else {
            XB_SPIN(xb_ld(&bar[XB_XGEN(b.x)]) == gen, bar);
            __builtin_amdgcn_fence(__ATOMIC_ACQUIRE, "agent");
            asm volatile("s_waitcnt vmcnt(0)" ::: "memory");
        }
    }
    __syncthreads();
}

__device__ __forceinline__ float bf2f(unsigned short h) { return __builtin_bit_cast(float, (unsigned)h << 16); }
__device__ __forceinline__ float bflo(unsigned w) { return __builtin_bit_cast(float, w << 16); }
__device__ __forceinline__ float bfhi(unsigned w) { return __builtin_bit_cast(float, w & 0xffff0000u); }
__device__ __forceinline__ float wave_sum(float v) {
    v += __builtin_bit_cast(float, __builtin_amdgcn_update_dpp(0, __builtin_bit_cast(int, v), 0xB1, 0xf, 0xf, false));
    v += __builtin_bit_cast(float, __builtin_amdgcn_update_dpp(0, __builtin_bit_cast(int, v), 0x4E, 0xf, 0xf, false));
    v += __builtin_bit_cast(float, __builtin_amdgcn_update_dpp(0, __builtin_bit_cast(int, v), 0x141, 0xf, 0xf, false));
    v += __builtin_bit_cast(float, __builtin_amdgcn_update_dpp(0, __builtin_bit_cast(int, v), 0x140, 0xf, 0xf, false));
    v += __builtin_bit_cast(float, __builtin_amdgcn_update_dpp(0, __builtin_bit_cast(int, v), 0x142, 0xa, 0xf, false));
    v += __builtin_bit_cast(float, __builtin_amdgcn_update_dpp(0, __builtin_bit_cast(int, v), 0x143, 0xc, 0xf, false));
    return __builtin_bit_cast(float, __builtin_amdgcn_readlane(__builtin_bit_cast(int, v), 63));
}
__device__ __forceinline__ float sigmoidf_(float x) { return __builtin_amdgcn_rcpf(1.0f + __expf(-x)); }
typedef float f32x16 __attribute__((ext_vector_type(16)));

struct Frame {
    LAS unsigned char* lds;
    volatile LAS unsigned* MISC;
    unsigned char* ws;
    int tid, lane, wave, vcu, G;
};
struct TrItem { const float* W; bf16* WT; int ldw, k0, sc0, ldt, dr0; };
__device__ __forceinline__ void p0_tr_load(const TrItem& q, int lane, f32x4 (&t)[8]) {
#pragma unroll
    for (int i = 0; i < 8; ++i) t[i] = *(const f32x4*)(q.W + (size_t)(q.k0 + (lane >> 3) + 8 * i) * q.ldw + q.sc0 + 4 * (lane & 7));
}
__device__ __forceinline__ void p0_tr_finish(const TrItem& q, const f32x4 (&t)[8], LAS float* scr, int lane) {
#pragma unroll
    for (int i = 0; i < 8; ++i) { LAS float* d = scr + ((lane >> 3) + 8 * i) * 33 + 4 * (lane & 7); d[0] = t[i][0]; d[1] = t[i][1]; d[2] = t[i][2]; d[3] = t[i][3]; }
    LDS_WAIT(); asm volatile("" ::: "memory");
    const int c = lane & 7;
#pragma unroll
    for (int j = 0; j < 4; ++j) { const int n = (lane >> 3) + 8 * j; const LAS float* s = scr + (8 * c) * 33 + n;
        v4u o; o.x = pk2(s[0 * 33], s[1 * 33]); o.y = pk2(s[2 * 33], s[3 * 33]); o.z = pk2(s[4 * 33], s[5 * 33]); o.w = pk2(s[6 * 33], s[7 * 33]);
        *(GAS v4u*)(q.WT + (size_t)(q.dr0 + n) * q.ldt + q.k0 + 8 * c) = o; }
    LDS_WAIT(); asm volatile("" ::: "memory");
}
__device__ __forceinline__ void s0_prologue(Frame& F) {
    LAS float* scr = (LAS float*)(F.lds + RING_OFF + F.wave * 16384);
    const int gw = F.vcu * NWAVES + F.wave, NGW = F.G * NWAVES, lane = F.lane;
    unsigned char* ws = F.ws;
    {
        float* modpart = (float*)(ws + SM_MODPART);
        for (int it = gw; it < DEPTH * 16 * 24; it += NGW) {
            const int l = it / (16 * 24), kc = (it / 24) % 16, jb = it % 24, j0 = jb * 256 + 4 * lane, k0 = kc * 64;
            const float c0 = inptr(F.lds, IN_C)[k0 + lane], c1 = inptr(F.lds, IN_C)[1024 + k0 + lane], c2 = inptr(F.lds, IN_CCTX)[k0 + lane];
            const float s0 = c0 * sigmoidf_(c0), s1 = c1 * sigmoidf_(c1), s2 = c2 * sigmoidf_(c2);
            f32x4 a0 = {0.f, 0.f, 0.f, 0.f}, a1 = a0, a2 = a0;
            const float* wp = inptr(F.lds, IN_WMOD) + ((size_t)l * 1024 + k0) * 6144 + j0;
#pragma unroll 16
            for (int kk = 0; kk < 64; ++kk) { const f32x4 w = *(const f32x4*)(wp + (size_t)kk * 6144);
                a0 += w * __shfl(s0, kk); a1 += w * __shfl(s1, kk); a2 += w * __shfl(s2, kk); }
            float* mp = modpart + ((size_t)(l * 16 + kc) * 3) * 6144 + j0;
            *(f32x4*)mp = a0; *(f32x4*)(mp + 6144) = a1; *(f32x4*)(mp + 2 * 6144) = a2;
        }
    }
    {
        constexpr int I_WINA = 16 * 16, I_WINB = 24 * 16, I_WFI = 176 * 16, I_WFO = 32 * 44, I_WO = 32 * 4, I_L = I_WINA + I_WINB + I_WFI + I_WFO + I_WO;
        auto decode = [&](int it) { TrItem q;
            const int l = it / I_L; int r = it % I_L;
            bf16* WinT = (bf16*)(ws + WS_WIN + l * WIN_STRIDE); bf16* WoT = (bf16*)(ws + WS_WO + l * WO_STRIDE);
            bf16* WfiT = (bf16*)(ws + WS_WFI + l * WFI_STRIDE); bf16* WfoT = (bf16*)(ws + WS_WFO + l * WFO_STRIDE);
            const float* w_in = inptr(F.lds, IN_WIN) + (size_t)l * 1024 * DIN0;
            if (r < I_WINA) { const int kb = r / 16, nb = r % 16; q = TrItem{w_in, WinT, DIN0, 64 * kb, 32 * nb, 1024, (nb >> 3) * 256 + (nb & 1) * 128 + ((nb >> 1) & 3) * 32}; return q; } r -= I_WINA;
            if (r < I_WINB) { const int kb = r / 24, nb = r % 24; q = TrItem{w_in, WinT, DIN0, 64 * kb, 768 + 32 * nb, 1024, 1024 + 32 * nb}; return q; } r -= I_WINB;
            if (r < I_WFI) { const int kb = r / 176, nb = r % 176, d0 = 32 * nb, pn = d0 >> 8, hb = (d0 >> 7) & 1, i0 = d0 & 127;
                q = TrItem{inptr(F.lds, IN_WFI) + (size_t)l * 1024 * 2 * DFF, WfiT, 2 * DFF, 64 * kb, hb * DFF + 128 * pn + i0, 1024, d0}; return q; } r -= I_WFI;
            if (r < I_WFO) { const int kb = r / 32, nb = r % 32; q = TrItem{inptr(F.lds, IN_WFO) + (size_t)l * DFF * 1024, WfoT, 1024, 64 * kb, 32 * nb, DFF, 32 * nb}; return q; } r -= I_WFO;
            { const int kb = r / 32, nb = r % 32; q = TrItem{inptr(F.lds, IN_WO) + (size_t)l * 1024 * 1024, WoT, 1024, 64 * kb, 32 * nb, 1024, 32 * nb}; return q; } };
        const int gA = (3 * NGW) / 8, gB = (5 * NGW) / 8, NIT = DEPTH * I_L, cut = (NIT * 10) / 13;
        const int t_lo = gw < gA ? gw : (gw < gB ? cut + (gw - gA) : NIT), t_hi = gw < gA ? cut : NIT, t_st = gw < gA ? gA : gB - gA;
        for (int it = t_lo; it < t_hi; it += 2 * t_st) {
            const bool two = it + t_st < t_hi;
            const TrItem qa = decode(it), qb = decode(two ? it + t_st : it);
            f32x4 ta[8], tb[8];
            p0_tr_load(qa, lane, ta); if (two) p0_tr_load(qb, lane, tb);
            p0_tr_finish(qa, ta, scr, lane);
            if (two) p0_tr_finish(qb, tb, scr, lane);
        }
    }
    {
        LAS float* tab = scr;
        { float sn, cs; sincospif((float)lane * (1.0f / 32.0f), &sn, &cs); tab[lane] = cs; tab[64 + lane] = sn; }
        LDS_WAIT(); asm volatile("" ::: "memory");
        if (gw >= (3 * NGW) / 8 && gw < (5 * NGW) / 8) for (int it = gw - (3 * NGW) / 8; it < DEPTH * 256; it += (5 * NGW) / 8 - (3 * NGW) / 8) {
            const int l = it / 256, kb = (it / 16) % 16, h = (it / 4) % 4, cq = it % 4, k = kb * 64 + lane;
            const float* src = inptr(F.lds, IN_WIN) + ((size_t)l * 1024 + k) * DIN0 + 512 + h * 64;
            float u[64];
#pragma unroll
            for (int c = 0; c < 16; ++c) { const f32x4 t = *(const f32x4*)(src + 4 * c); u[4 * c] = t[0]; u[4 * c + 1] = t[1]; u[4 * c + 2] = t[2]; u[4 * c + 3] = t[3]; }
            bf16* WinT = (bf16*)(ws + WS_WIN + l * WIN_STRIDE);
            for (int cp = 16 * cq; cp < 16 * cq + 16; ++cp) { float ar = 0.f, ai = 0.f;
#pragma unroll
                for (int c = 0; c < 64; ++c) { const int j = (c * cp) & 63; ar += u[c] * tab[j]; ai -= u[c] * tab[64 + j]; }
                WinT[(size_t)(512 + h * 64 + cp) * 1024 + k] = (bf16)f2bf(ar); WinT[(size_t)(768 + h * 64 + cp) * 1024 + k] = (bf16)f2bf(ai); }
        }
        LDS_WAIT(); asm volatile("" ::: "memory");
    }
    if (gw >= (5 * NGW) / 8) for (int it = gw - (5 * NGW) / 8; it < DEPTH * 96 * 4; it += NGW - (5 * NGW) / 8) {
        const int l = it / (96 * 4), ib = (it / 4) % 96, nb = it % 4, i0 = ib * 8, n0 = nb * 256 + 4 * lane;
        const int br = i0 >> 8;
        const float* wo = inptr(F.lds, IN_WO) + (size_t)l * 1024 * 1024;
        f32x4 acc[8];
#pragma unroll
        for (int q = 0; q < 8; ++q) acc[q] = (f32x4){0.f, 0.f, 0.f, 0.f};
        if (br < 2) { const float* wx = (br == 0 ? inptr(F.lds, IN_WF) : inptr(F.lds, IN_WPW)) + (size_t)l * 65536 + (size_t)(i0 & 255) * 256;
#pragma unroll
            for (int q = 0; q < 8; ++q) *(LAS f32x4*)(scr + q * 256 + 4 * lane) = *(const f32x4*)(wx + q * 256 + 4 * lane);
            LDS_WAIT(); asm volatile("" ::: "memory");
            const float* wrow = wo + (size_t)(256 + br * 256) * 1024 + n0;
#pragma unroll 2
            for (int j = 0; j < 256; j += 4) { f32x4 w[4];
#pragma unroll
                for (int e = 0; e < 4; ++e) w[e] = *(const f32x4*)(wrow + (size_t)(j + e) * 1024);
#pragma unroll
                for (int q = 0; q < 8; ++q) { const f32x4 x = *(const LAS f32x4*)(scr + q * 256 + j); acc[q] += w[0] * x[0]; acc[q] += w[1] * x[1]; acc[q] += w[2] * x[2]; acc[q] += w[3] * x[3]; } }
        } else { const int g = (i0 - 512) >> 6, c0 = (i0 - 512) & 63;
            const float* wx = inptr(F.lds, IN_WPL) + (size_t)l * 4 * 4096 + (size_t)g * 4096 + (size_t)c0 * 64; const float* ps = inptr(F.lds, IN_PLS) + l * 256 + g * 64;
            { const float sv = ps[lane];
#pragma unroll
              for (int q = 0; q < 8; ++q) scr[q * 64 + lane] = wx[q * 64 + lane] * sv; }
            LDS_WAIT(); asm volatile("" ::: "memory");
            const float* wrow = wo + (size_t)(768 + g * 64) * 1024 + n0;
#pragma unroll 2
            for (int j = 0; j < 64; j += 4) { f32x4 w[4];
#pragma unroll
                for (int e = 0; e < 4; ++e) w[e] = *(const f32x4*)(wrow + (size_t)(j + e) * 1024);
#pragma unroll
                for (int q = 0; q < 8; ++q) { const f32x4 x = *(const LAS f32x4*)(scr + q * 64 + j); acc[q] += w[0] * x[0]; acc[q] += w[1] * x[1]; acc[q] += w[2] * x[2]; acc[q] += w[3] * x[3]; } }
        }
        LDS_WAIT(); asm volatile("" ::: "memory");
        bf16* WoT = (bf16*)(ws + WS_WO + l * WO_STRIDE);
#pragma unroll
        for (int e = 0; e < 4; ++e) { v4u o; o.x = pk2(acc[0][e], acc[1][e]); o.y = pk2(acc[2][e], acc[3][e]); o.z = pk2(acc[4][e], acc[5][e]); o.w = pk2(acc[6][e], acc[7][e]);
            *(GAS v4u*)(WoT + (size_t)(n0 + e) * 1024 + 256 + i0) = o; }
    }
    {
        const int gt = (F.vcu * NWAVES + F.wave) * 64 + lane, NGT = NGW * 64;
        float* rope = (float*)(ws + SM_ROPE); float* tw = (float*)(ws + SM_TW);
        bf16* M1 = (bf16*)(ws + SM_M1); bf16* M2 = (bf16*)(ws + SM_M2); bf16* M3 = (bf16*)(ws + SM_M3);
        for (int i = gt; i < 128 * 16; i += NGT) { const int p = i >> 4, f = i & 15; const float inv = powf(10000.0f, -(float)f * (1.0f / 16.0f)); const float a = (float)p * inv;
            rope[2 * i] = cosf(a); rope[2 * i + 1] = sinf(a); }
        for (int i = gt; i < 8192; i += NGT) { float sn, cs; sincospif((float)i * (1.0f / 4096.0f), &sn, &cs); tw[2 * i] = cs; tw[2 * i + 1] = sn; }
        for (int i = gt; i < 2 * 128 * 128; i += NGT) { const int sel = i >> 14, k1 = (i >> 7) & 127, t1 = i & 127;
            float sn, cs; sincospif((float)((k1 * t1) & 127) * (1.0f / 64.0f), &sn, &cs); M1[i] = (bf16)f2bf(sel ? sn : cs); }
        for (int i = gt; i < 64 * 128; i += NGT) { const int k2 = i >> 7, k = i & 127, t2 = k >> 1, ri = k & 1;
            float sn, cs; sincospif((float)((k2 * t2) & 63) * (1.0f / 32.0f), &sn, &cs); M2[i] = (bf16)f2bf(ri ? sn : cs); }
        for (int i = gt; i < 256 * 512; i += NGT) { const int kq = i >> 9, k = i & 511, ri = k >> 8, t = k & 255;
            float sn, cs; sincospif((float)((kq * t) & 255) * (1.0f / 128.0f), &sn, &cs); M3[i] = (bf16)f2bf(ri ? sn : cs); }
    }
}
__device__ __forceinline__ void s0b_modsum(Frame& F) {
    const int gt = (F.vcu * NWAVES + F.wave) * 64 + F.lane, NGT = F.G * NWAVES * 64;
    const float* modpart = (const float*)(F.ws + SM_MODPART); float* mod = (float*)(F.ws + WS_CTL + CTL_MOD); const float* bm = inptr(F.lds, IN_BMOD);
    for (int i = gt; i < DEPTH * 3 * 6144; i += NGT) { const int l = i / (3 * 6144), v = (i / 6144) % 3, j = i % 6144; float s = bm[l * 6144 + j];
#pragma unroll
        for (int kc = 0; kc < 16; ++kc) s += modpart[((size_t)(l * 16 + kc) * 3 + v) * 6144 + j];
        mod[i] = s; }
}
__device__ __forceinline__ void s1_prologue(Frame& F) {
    const int gw = F.vcu * NWAVES + F.wave, NGW = F.G * NWAVES, lane = F.lane;
    unsigned char* ws = F.ws;
    const float* mod = (const float*)(ws + WS_CTL + CTL_MOD);
    {
        bf16* ACT = (bf16*)(ws + WS_ACT); float* rss = (float*)(ws + WS_RPART);
        auto xptr = [&](int r) { const int b = r / SPB, rr = r % SPB; return rr < CTXL ? inptr(F.lds, IN_CTX) + ((size_t)b * CTXL + rr) * DM : inptr(F.lds, IN_X) + ((size_t)b * SEQ + rr - CTXL) * DM; };
        f32x4 xv[4], xn[4];
#pragma unroll
        for (int j = 0; j < 4; ++j) xv[j] = (f32x4){0.f, 0.f, 0.f, 0.f};
        if (gw < R) { const float* xrow = xptr(gw);
#pragma unroll
            for (int j = 0; j < 4; ++j) xv[j] = *(const f32x4*)(xrow + 4 * lane + 256 * j); }
        const float* g1p = inptr(F.lds, IN_G1);
        for (int r = gw; r < R; r += NGW) {
            const int b = r / SPB, rr = r % SPB, v = rr < CTXL ? 2 : b;
#pragma unroll
            for (int j = 0; j < 4; ++j) xn[j] = xv[j];
            if (r + NGW < R) { const float* xrow = xptr(r + NGW);
#pragma unroll
                for (int j = 0; j < 4; ++j) xn[j] = *(const f32x4*)(xrow + 4 * lane + 256 * j); }
            float s = 0.f; unsigned long long o[4];
#pragma unroll
            for (int j = 0; j < 4; ++j) { const int c = 4 * lane + 256 * j; const f32x4 x = xv[j];
                const f32x4 g = *(const f32x4*)(g1p + c) * (*(const f32x4*)(mod + v * 6144 + 1024 + c) + 1.0f);
                s += (x[0] * x[0] + x[1] * x[1]) + (x[2] * x[2] + x[3] * x[3]); const f32x4 a = x * g;
                o[j] = (unsigned long long)pk2(a[0], a[1]) | ((unsigned long long)pk2(a[2], a[3]) << 32); }
            s = wave_sum(s);
#pragma unroll
            for (int j = 0; j < 4; ++j) *(unsigned long long*)(ACT + (size_t)r * DM + 4 * lane + 256 * j) = o[j];
            if (lane < 16) rss[(size_t)r * 16 + lane] = lane == 0 ? s : 0.f;
#pragma unroll
            for (int j = 0; j < 4; ++j) xv[j] = xn[j];
        }
    }
    for (int it = gw; it < DEPTH * (NIN + 2 * DFF); it += NGW) {
        const int l = it / (NIN + 2 * DFF), n = it % (NIN + 2 * DFF);
        const bool isin = n < NIN; const int nn = isin ? n : n - NIN;
        const bf16* wrow = isin ? (const bf16*)(ws + WS_WIN + l * WIN_STRIDE) + (size_t)nn * 1024 : (const bf16*)(ws + WS_WFI + l * WFI_STRIDE) + (size_t)nn * 1024;
        const float* sh = mod + (size_t)l * 3 * 6144 + (isin ? 0 : 3072);
        float a0 = 0.f, a1 = 0.f, a2 = 0.f;
#pragma unroll
        for (int j = 0; j < 2; ++j) { const int k = 8 * lane + 512 * j; const v4u w = *(const GAS v4u*)(wrow + k);
            float wf[8] = {bflo(w.x), bfhi(w.x), bflo(w.y), bfhi(w.y), bflo(w.z), bfhi(w.z), bflo(w.w), bfhi(w.w)};
#pragma unroll
            for (int q = 0; q < 8; ++q) { a0 += wf[q] * sh[k + q]; a1 += wf[q] * sh[6144 + k + q]; a2 += wf[q] * sh[2 * 6144 + k + q]; } }
        a0 = wave_sum(a0); a1 = wave_sum(a1); a2 = wave_sum(a2);
        if (lane == 0) { float* dst = isin ? (float*)(ws + SM_BIN) + (size_t)l * 3 * NIN + nn : (float*)(ws + SM_BFF) + (size_t)l * 3 * 2 * DFF + nn;
            const int st = isin ? NIN : 2 * DFF; dst[0] = a0; dst[st] = a1; dst[2 * st] = a2; }
    }
}
__device__ __forceinline__ void unpack8(const v4u w, float (&x)[8]) { x[0] = bflo(w.x); x[1] = bfhi(w.x); x[2] = bflo(w.y); x[3] = bfhi(w.y); x[4] = bflo(w.z); x[5] = bfhi(w.z); x[6] = bflo(w.w); x[7] = bfhi(w.w); }
__device__ __forceinline__ void p2_qkv(Frame& F, int l) {
    const int gw = F.vcu * NWAVES + F.wave, NGW = F.G * NWAVES, lane = F.lane;
    unsigned char* ws = F.ws;
    const bf16* P = (const bf16*)(ws + WS_P); bf16* Q = (bf16*)(ws + WS_Q); bf16* K = (bf16*)(ws + WS_K); bf16* V = (bf16*)(ws + WS_V);
    const float* rope = (const float*)(ws + SM_ROPE);
    const int head = lane >> 3, sub = lane & 7;
    float g[8];
#pragma unroll
    for (int j = 0; j < 8; ++j) g[j] = head < 4 ? inptr(F.lds, IN_QG)[l * 64 + sub * 8 + j] * QSCALE : (head < 6 ? inptr(F.lds, IN_KG)[l * 64 + sub * 8 + j] : 1.0f);
    auto fetch = [&](int rr_, v4u& w, f32x4& c0, f32x4& c1) {
        w = *(const GAS v4u*)(P + (size_t)rr_ * NIN + lane * 8);
        const int rr = rr_ % SPB; const int t = rr >= CTXL ? rr - CTXL : 0; const int pos = sub < 4 ? (t >> 6) : (t & 63);
        const float* cs = rope + ((size_t)pos * 16 + (sub & 3) * 4) * 2; c0 = *(const f32x4*)cs; c1 = *(const f32x4*)(cs + 4); };
    auto process = [&](int r, const v4u raw, const f32x4 cs0, const f32x4 cs1) {
        const int rr = r % SPB;
        float x[8]; unpack8(raw, x);
        if (head < 6) {
            float ss = 0.f;
#pragma unroll
            for (int j = 0; j < 8; ++j) ss += x[j] * x[j];
            ss += __shfl_xor(ss, 1); ss += __shfl_xor(ss, 2); ss += __shfl_xor(ss, 4);
            const float rs = rsqrtf(ss * (1.0f / 64.0f) + EPS);
#pragma unroll
            for (int j = 0; j < 8; ++j) x[j] = x[j] * rs * g[j];
            if (rr >= CTXL) { const float cc[4] = {cs0[0], cs0[2], cs1[0], cs1[2]}, sn[4] = {cs0[1], cs0[3], cs1[1], cs1[3]};
#pragma unroll
                for (int p = 0; p < 4; ++p) { const float x0 = x[2 * p], x1 = x[2 * p + 1]; x[2 * p] = x0 * cc[p] - x1 * sn[p]; x[2 * p + 1] = x0 * sn[p] + x1 * cc[p]; } }
        }
        v4u o; o.x = pk2(x[0], x[1]); o.y = pk2(x[2], x[3]); o.z = pk2(x[4], x[5]); o.w = pk2(x[6], x[7]);
        bf16* dst = head < 4 ? Q + (size_t)r * 256 + lane * 8 : (head < 6 ? K + (size_t)r * 128 + (lane - 32) * 8 : V + (size_t)r * 128 + (lane - 48) * 8);
        *(GAS v4u*)dst = o; };
    v4u raw[4], rawn[4]; f32x4 c0[4], c1[4], c0n[4], c1n[4];
#pragma unroll
    for (int q = 0; q < 4; ++q) { raw[q] = (v4u){0u, 0u, 0u, 0u}; c0[q] = (f32x4){1.f, 0.f, 1.f, 0.f}; c1[q] = c0[q]; const int r = gw + q * NGW; if (r < R) fetch(r, raw[q], c0[q], c1[q]); }
    for (int rb = gw; rb < R; rb += 4 * NGW) {
#pragma unroll
        for (int q = 0; q < 4; ++q) { rawn[q] = raw[q]; c0n[q] = c0[q]; c1n[q] = c1[q]; const int r = rb + (4 + q) * NGW; if (r < R) fetch(r, rawn[q], c0n[q], c1n[q]); }
#pragma unroll
        for (int q = 0; q < 4; ++q) { const int r = rb + q * NGW; if (r < R) process(r, raw[q], c0[q], c1[q]); }
#pragma unroll
        for (int q = 0; q < 4; ++q) { raw[q] = rawn[q]; c0[q] = c0n[q]; c1[q] = c1n[q]; }
    }
}
template <int TPW  > __device__ __forceinline__ void p2_convpool_unit(Frame& F, int l, const int r0) {
    constexpr int NT = 8 * TPW, CR = NT + 30, PR = NT + 16, CI = (CR * 32 + 511) / 512, PI = (PR * 32) / 512; static_assert((PR * 32) % 512 == 0, "pool fill");
    unsigned char* ws = F.ws; const int tid = F.tid, lane = F.lane, w = F.wave;
    const bf16* P = (const bf16*)(ws + WS_P); bf16* MIX = (bf16*)(ws + WS_MIX);
    LAS float* buf = (LAS float*)(F.lds + RING_OFF);
    LAS float* pbuf = buf + CR * 256;
    const int b = r0 / SPB, rr0 = r0 % SPB;
    const int seq_lo = rr0 < CTXL ? b * SPB : b * SPB + CTXL, seq_hi = rr0 < CTXL ? b * SPB + CTXL : (b + 1) * SPB;
    v4u a8[CI], g8[CI], p8[PI];
#pragma unroll
    for (int it = 0; it < CI; ++it) { const int idx = tid + it * 512, ri = idx >> 5, cg = idx & 31, r = r0 - 15 + ri;
        a8[it] = (v4u){0u, 0u, 0u, 0u}; g8[it] = a8[it];
        if (idx < CR * 32 && r >= seq_lo && r < seq_hi) { a8[it] = *(const GAS v4u*)(P + (size_t)r * NIN + 1024 + cg * 8); g8[it] = *(const GAS v4u*)(P + (size_t)r * NIN + 1280 + cg * 8); } }
#pragma unroll
    for (int it = 0; it < PI; ++it) { const int idx = tid + it * 512, ri = idx >> 5, cg = idx & 31, r = r0 - 8 + ri;
        p8[it] = (v4u){0u, 0u, 0u, 0u};
        if (r >= seq_lo && r < seq_hi) p8[it] = *(const GAS v4u*)(P + (size_t)r * NIN + 1536 + cg * 8); }
#pragma unroll
    for (int it = 0; it < CI; ++it) { const int idx = tid + it * 512, ri = idx >> 5, cg = idx & 31;
        if (idx < CR * 32) { float a[8], g[8]; unpack8(a8[it], a); unpack8(g8[it], g);
            *(LAS f32x4*)(buf + ri * 256 + cg * 8) = (f32x4){a[0] * sigmoidf_(g[0]), a[1] * sigmoidf_(g[1]), a[2] * sigmoidf_(g[2]), a[3] * sigmoidf_(g[3])};
            *(LAS f32x4*)(buf + ri * 256 + cg * 8 + 4) = (f32x4){a[4] * sigmoidf_(g[4]), a[5] * sigmoidf_(g[5]), a[6] * sigmoidf_(g[6]), a[7] * sigmoidf_(g[7])}; } }
#pragma unroll
    for (int it = 0; it < PI; ++it) { const int idx = tid + it * 512, ri = idx >> 5, cg = idx & 31; *(LAS v4u*)((LAS unsigned char*)pbuf + (ri * 256 + cg * 8) * 2) = p8[it]; }
    const float* dww = inptr(F.lds, IN_DWW) + (size_t)l * 31 * 256 + 4 * lane;
    f32x4 wt[31];
#pragma unroll
    for (int j = 0; j < 31; ++j) wt[j] = *(const f32x4*)(dww + j * 256);
    const f32x4 bias = *(const f32x4*)(inptr(F.lds, IN_DWB) + l * 256 + 4 * lane);
    const f32x4 lng = *(const f32x4*)(inptr(F.lds, IN_LNG) + l * 256 + 4 * lane), lnb = *(const f32x4*)(inptr(F.lds, IN_LNB) + l * 256 + 4 * lane);
    __syncthreads();
    {
        f32x4 acc[TPW];
#pragma unroll
        for (int o = 0; o < TPW; ++o) acc[o] = bias;
#pragma unroll
        for (int i = 0; i < TPW + 30; ++i) { const f32x4 v = *(const LAS f32x4*)(buf + (w * TPW + i) * 256 + 4 * lane);
#pragma unroll
            for (int o = 0; o < TPW; ++o) { const int j = i - o; if (j >= 0 && j < 31) acc[o] += v * wt[j]; } }
#pragma unroll
        for (int o = 0; o < TPW; ++o) { const f32x4 a = acc[o];
            const float mean = wave_sum((a[0] + a[1]) + (a[2] + a[3])) * (1.0f / 256.0f); const f32x4 d = a - mean;
            const float var = wave_sum((d[0] * d[0] + d[1] * d[1]) + (d[2] * d[2] + d[3] * d[3])) * (1.0f / 256.0f);
            f32x4 y = d * rsqrtf(var + EPS) * lng + lnb;
#pragma unroll
            for (int q = 0; q < 4; ++q) y[q] = y[q] * sigmoidf_(y[q]);
            *(unsigned long long*)(MIX + (size_t)(r0 + w * TPW + o) * 1024 + 512 + 4 * lane) = (unsigned long long)pk2(y[0], y[1]) | ((unsigned long long)pk2(y[2], y[3]) << 32); }
    }
    {
        const LAS unsigned char* pb = (const LAS unsigned char*)pbuf;
        const int win = 2 << (lane >> 4), half = win >> 1;
#pragma unroll
        for (int o = 0; o < TPW; ++o) { const int t = r0 + w * TPW + o;
            int lo = t - half, hi = t - half + win; lo = lo < seq_lo ? seq_lo : lo; hi = hi > seq_hi ? seq_hi : hi;
            f32x4 s = {0.f, 0.f, 0.f, 0.f};
#pragma unroll
            for (int j = 0; j < 16; ++j) { if (j < win) { const u32x2_t q = *(const LAS u32x2_t*)(pb + ((t - half + j - r0 + 8) * 256 + 4 * lane) * 2); s += (f32x4){bflo(q.x), bfhi(q.x), bflo(q.y), bfhi(q.y)}; } }
            const u32x2_t q = *(const LAS u32x2_t*)(pb + ((t - r0 + 8) * 256 + 4 * lane) * 2); const f32x4 self = {bflo(q.x), bfhi(q.x), bflo(q.y), bfhi(q.y)};
            const f32x4 y = s * (1.0f / (float)(hi - lo)) - self;
            *(unsigned long long*)(MIX + (size_t)t * 1024 + 768 + 4 * lane) = (unsigned long long)pk2(y[0], y[1]) | ((unsigned long long)pk2(y[2], y[3]) << 32); }
    }
    __syncthreads();
}
#define MFMA32(a, b, c) __builtin_amdgcn_mfma_f32_32x32x16_bf16(a, b, c, 0, 0, 0)
__device__ __forceinline__ void tr8x8(const v4u (&in)[8], v4u (&out)[8]) {
#pragma unroll
    for (int j = 0; j < 8; ++j) {
        unsigned d[4];
#pragma unroll
        for (int m = 0; m < 4; ++m) { const unsigned a = in[2 * m][j >> 1], b = in[2 * m + 1][j >> 1]; d[m] = (j & 1) ? ((a >> 16) | (b & 0xffff0000u)) : ((a & 0xffffu) | (b << 16)); }
        out[j] = (v4u){d[0], d[1], d[2], d[3]}; }
}
constexpr int F1_ZT = 0, F1_C = 67584, F1_S = F1_C + 34816, F1_END = F1_S + 34816;
static_assert(F1_END <= LDSCTL_OFF, "f1 LDS");
__device__ __forceinline__ void f1_unit(Frame& F, int unit) {
    unsigned char* ws = F.ws; const int tid = F.tid, lane = F.lane, w = F.wave, r = lane & 31, h = lane >> 5;
    const int b = unit >> 7, t2 = (unit >> 1) & 63, ch = unit & 1;
    const bf16* P = (const bf16*)(ws + WS_P); bf16* GP = (bf16*)(ws + WS_GP); const bf16* CS = (const bf16*)(ws + SM_M1); const float* tw = (const float*)(ws + SM_TW);
    LAS bf16* ZT = (LAS bf16*)(F.lds + F1_ZT); LAS bf16* Cl = (LAS bf16*)(F.lds + F1_C);
    const int nt = w & 3, mh = w >> 2;
    {
        const int kb = tid >> 4, pc = tid & 15, ri = kb >> 4;
        v4u in[8], out[8], tb[8];
#pragma unroll
        for (int i = 0; i < 8; ++i) { const int t1 = (kb * 8 + i) & 127; const size_t row = (size_t)b * SPB + CTXL + t1 * 64 + t2;
            in[i] = *(const GAS v4u*)(P + row * NIN + 512 + ri * 256 + ch * 128 + pc * 8); }
#pragma unroll
        for (int i = 0; i < 8; ++i) tb[i] = *(const GAS v4u*)(CS + (size_t)(tid + i * 512) * 8);
        tr8x8(in, out);
#pragma unroll
        for (int j = 0; j < 8; ++j) *(LAS v4u*)(ZT + (pc * 8 + j) * 264 + kb * 8) = out[j];
#pragma unroll
        for (int i = 0; i < 8; ++i) { const int c = tid + i * 512; *(LAS v4u*)(Cl + (c >> 4) * 136 + (c & 15) * 8) = tb[i]; }
    }
    float twc[2][16], tws[2][16];
#pragma unroll
    for (int pi = 0; pi < 2; ++pi)
#pragma unroll
        for (int q = 0; q < 16; ++q) { const int k1 = (2 * mh + pi) * 32 + (q & 3) + 8 * (q >> 2) + 4 * h; const float* p = tw + 2 * (t2 * k1); twc[pi][q] = p[0]; tws[pi][q] = p[1]; }
    __syncthreads();
    f32x16 ar[2], ai[2];
#pragma unroll
    for (int a = 0; a < 2; ++a) { ar[a] = f32x16{}; ai[a] = f32x16{}; }
#pragma unroll 2
    for (int kt = 0; kt < 8; ++kt) {
        const bf16x8 zr = *(const LAS bf16x8*)(ZT + (nt * 32 + r) * 264 + kt * 16 + 8 * h), zi = *(const LAS bf16x8*)(ZT + (nt * 32 + r) * 264 + 128 + kt * 16 + 8 * h);
#pragma unroll
        for (int pi = 0; pi < 2; ++pi) { const int mrow = ((2 * mh + pi) * 32 + r) * 136 + kt * 16 + 8 * h;
            const bf16x8 ac = *(const LAS bf16x8*)(Cl + mrow), as = *(const LAS bf16x8*)(Cl + 128 * 136 + mrow);
            const bf16x8 ns = as ^ (short)0x8000;
            ar[pi] = MFMA32(ac, zr, ar[pi]); ar[pi] = MFMA32(as, zi, ar[pi]);
            ai[pi] = MFMA32(ac, zi, ai[pi]); ai[pi] = MFMA32(ns, zr, ai[pi]); }
    }
    __syncthreads();
    LAS bf16* OUT = (LAS bf16*)(F.lds + F1_ZT);
#pragma unroll
    for (int pi = 0; pi < 2; ++pi)
#pragma unroll
        for (int q = 0; q < 16; ++q) { const int k1 = (2 * mh + pi) * 32 + (q & 3) + 8 * (q >> 2) + 4 * h; const float c = twc[pi][q], s = tws[pi][q], gr = ar[pi][q], gi = ai[pi][q];
            OUT[(k1 * 2) * 128 + nt * 32 + r] = (bf16)f2bf(c * gr + s * gi); OUT[(k1 * 2 + 1) * 128 + nt * 32 + r] = (bf16)f2bf(c * gi - s * gr); }
    __syncthreads();
#pragma unroll
    for (int i = 0; i < 8; ++i) { const int c = tid + i * 512, row = c >> 4, pc = c & 15, k1 = row >> 1, ri = row & 1;
        *(GAS v4u*)(GP + ((((size_t)b * 128 + k1) * 64 + t2) * 2 + ri) * 256 + ch * 128 + pc * 8) = *(const LAS v4u*)(OUT + row * 128 + pc * 8); }
    __syncthreads();
}
constexpr int F2_GT = 0, F2_M = 69632, F2_END = F2_M + 17408;
__device__ __forceinline__ void f2_unit(Frame& F, int unit) {
    unsigned char* ws = F.ws; const int tid = F.tid, lane = F.lane, w = F.wave, r = lane & 31, h = lane >> 5;
    const int b = unit >> 7, k1 = unit & 127;
    const bf16* GP = (const bf16*)(ws + WS_GP) + ((size_t)b * 128 + k1) * 64 * 2 * 256; bf16* MIX = (bf16*)(ws + WS_MIX); const bf16* M2 = (const bf16*)(ws + SM_M2);
    LAS bf16* GT = (LAS bf16*)(F.lds + F2_GT); LAS bf16* Ml = (LAS bf16*)(F.lds + F2_M);
    {
        const int kb = tid >> 5, pc = tid & 31;
        v4u in[8], out[8], tb[2];
#pragma unroll
        for (int i = 0; i < 8; ++i) in[i] = *(const GAS v4u*)(GP + (size_t)(kb * 8 + i) * 256 + pc * 8);
#pragma unroll
        for (int i = 0; i < 2; ++i) tb[i] = *(const GAS v4u*)(M2 + (size_t)(tid + i * 512) * 8);
        tr8x8(in, out);
#pragma unroll
        for (int j = 0; j < 8; ++j) *(LAS v4u*)(GT + (pc * 8 + j) * 136 + kb * 8) = out[j];
#pragma unroll
        for (int i = 0; i < 2; ++i) { const int c = tid + i * 512; *(LAS v4u*)(Ml + (c >> 4) * 136 + (c & 15) * 8) = tb[i]; }
    }
    __syncthreads();
    f32x16 acc[2]; acc[0] = f32x16{}; acc[1] = f32x16{};
#pragma unroll
    for (int kt = 0; kt < 8; ++kt) { const bf16x8 bf = *(const LAS bf16x8*)(GT + (w * 32 + r) * 136 + kt * 16 + 8 * h);
#pragma unroll
        for (int mt = 0; mt < 2; ++mt) { const bf16x8 af = *(const LAS bf16x8*)(Ml + (mt * 32 + r) * 136 + kt * 16 + 8 * h); acc[mt] = MFMA32(af, bf, acc[mt]); } }
    __syncthreads();
    LAS bf16* OUT = (LAS bf16*)(F.lds + F2_GT);
    const float SC = 1.0f / 724.0773439350246f;
#pragma unroll
    for (int mt = 0; mt < 2; ++mt)
#pragma unroll
        for (int q = 0; q < 16; ++q) { const int k2 = mt * 32 + (q & 3) + 8 * (q >> 2) + 4 * h; OUT[k2 * 256 + w * 32 + r] = (bf16)f2bf(acc[mt][q] * SC); }
    __syncthreads();
#pragma unroll
    for (int i = 0; i < 4; ++i) { const int c = tid + i * 512, k2 = c >> 5, pc = c & 31; const size_t row = (size_t)b * SPB + CTXL + k1 + 128 * k2;
        *(GAS v4u*)(MIX + row * 1024 + 256 + pc * 8) = *(const LAS v4u*)(OUT + k2 * 256 + pc * 8); }
    __syncthreads();
}
__device__ __forceinline__ void fctx_unit(Frame& F, int unit) {
    unsigned char* ws = F.ws; const int tid = F.tid, lane = F.lane, w = F.wave, r = lane & 31, h = lane >> 5;
    const int b = unit >> 3, cb = unit & 7;
    const bf16* P = (const bf16*)(ws + WS_P); bf16* MIX = (bf16*)(ws + WS_MIX); const bf16* M3 = (const bf16*)(ws + SM_M3);
    LAS bf16* ZT = (LAS bf16*)(F.lds + RING_OFF);
    for (int idx = tid; idx < 2048; idx += NWAVES * 64) { const int k = idx >> 2, pc = idx & 3, ri = k >> 8, t = k & 255;
        const size_t row = (size_t)b * SPB + t; const v4u raw = *(const GAS v4u*)(P + row * NIN + 512 + ri * 256 + cb * 32 + pc * 8);
        LAS bf16* d = ZT + (pc * 8) * 520 + k;
        d[0] = (bf16)(raw.x & 0xffff); d[520] = (bf16)(raw.x >> 16); d[2 * 520] = (bf16)(raw.y & 0xffff); d[3 * 520] = (bf16)(raw.y >> 16);
        d[4 * 520] = (bf16)(raw.z & 0xffff); d[5 * 520] = (bf16)(raw.z >> 16); d[6 * 520] = (bf16)(raw.w & 0xffff); d[7 * 520] = (bf16)(raw.w >> 16); }
    __syncthreads();
    f32x16 acc = f32x16{};
#pragma unroll 4
    for (int kt = 0; kt < 32; ++kt) { const bf16x8 bf = *(const LAS bf16x8*)(ZT + r * 520 + kt * 16 + 8 * h);
        const bf16x8 af = *(const bf16x8*)(M3 + (size_t)(w * 32 + r) * 512 + kt * 16 + 8 * h); acc = MFMA32(af, bf, acc); }
#pragma unroll
    for (int q = 0; q < 16; ++q) { const int kq = w * 32 + (q & 3) + 8 * (q >> 2) + 4 * h; const size_t row = (size_t)b * SPB + kq;
        MIX[row * 1024 + 256 + cb * 32 + r] = (bf16)f2bf(acc[q] * (1.0f / 128.0f)); }
    __syncthreads();
}

__device__ __forceinline__ void ctx_fixup(Frame& F, int l, int kind) {
    const int gw = F.vcu * NWAVES + F.wave, NGW = F.G * NWAVES, lane = F.lane;
    unsigned char* ws = F.ws;
    const float* mod = (const float*)(ws + WS_CTL + CTL_MOD) + (size_t)l * 3 * 6144 + 2 * 6144;
    const float* gate = mod + (kind == 0 ? 2048 : 5120);
    const float* gn = kind == 0 ? inptr(F.lds, IN_G2) + l * DM : inptr(F.lds, IN_G1) + (l + 1) * DM;
    const float* sc = kind == 0 ? mod + 4096 : mod + 3 * 6144 + 1024;
    const float* part = (const float*)(ws + WS_PART); float* ctxres = (float*)(ws + WS_CTXRES); bf16* ACT = (bf16*)(ws + WS_ACT);
    float* rowss = (float*)(ws + WS_RPART) + (size_t)(2 * l + 1 + kind) * R * 16;
    const float* ctxin = (kind == 0 && l == 0) ? inptr(F.lds, IN_CTX) : nullptr;
    for (int cr = gw; cr < 512; cr += NGW) {
        const int b = cr >> 8, r = b * SPB + (cr & 255); float ss = 0.f; unsigned long long o[4];
#pragma unroll
        for (int j = 0; j < 4; ++j) { const int c = 4 * lane + 256 * j; const size_t off = (size_t)cr * 1024 + c;
            const f32x4 p0 = *(const f32x4*)(part + off), p1 = *(const f32x4*)(part + 512 * 1024 + off), p2 = *(const f32x4*)(part + 2 * 512 * 1024 + off), p3 = *(const f32x4*)(part + 3 * 512 * 1024 + off);
            const f32x4 xs = ctxin ? *(const f32x4*)(ctxin + off) : *(const f32x4*)(ctxres + off);
            const f32x4 xo = xs + *(const f32x4*)(gate + c) * ((p0 + p1) + (p2 + p3));
            *(f32x4*)(ctxres + off) = xo;
            ss += (xo[0] * xo[0] + xo[1] * xo[1]) + (xo[2] * xo[2] + xo[3] * xo[3]);
            const f32x4 a = xo * (*(const f32x4*)(gn + c) * (*(const f32x4*)(sc + c) + 1.0f));
            o[j] = (unsigned long long)pk2(a[0], a[1]) | ((unsigned long long)pk2(a[2], a[3]) << 32); }
        ss = wave_sum(ss);
#pragma unroll
        for (int j = 0; j < 4; ++j) *(unsigned long long*)(ACT + (size_t)r * DM + 4 * lane + 256 * j) = o[j];
        if (lane < 16) rowss[(size_t)r * 16 + lane] = lane == 0 ? ss : 0.f;
    }
}
#ifndef MK_N_LAUNCHES
#define MK_N_LAUNCHES 1
#endif
constexpr int N_PHASES = 3 + 8 * DEPTH;
struct Args { const float* in[22]; float* out; unsigned char* ws; int ph_lo, ph_hi; };
__global__ void __launch_bounds__(NWAVES * 64, 2) fwd_kernel(Args args) {
    extern __shared__ __attribute__((aligned(16))) unsigned char lds[];
    Frame F;
    F.lds = (LAS unsigned char*)lds;
    F.MISC = (volatile LAS unsigned*)(F.lds + MISC_OFF);
    F.tid = threadIdx.x; F.lane = F.tid & 63; F.wave = __builtin_amdgcn_readfirstlane(F.tid >> 6);
    F.G = gridDim.x; { const int bx = blockIdx.x; F.vcu = (F.G % 8 == 0) ? (bx % 8) * (F.G / 8) + bx / 8 : bx; }
    F.ws = args.ws;
    unsigned char* ws = args.ws;
    for (int u = F.tid; u < (LDS_BYTES - LDSCTL_OFF) / 4; u += NWAVES * 64) ((LAS unsigned*)(F.lds + LDSCTL_OFF))[u] = 0u;
    __syncthreads();
    if (F.tid == 0) { LAS unsigned long long* tab = (LAS unsigned long long*)(F.lds + PTAB_OFF);
#pragma unroll
        for (int i = 0; i < N_IN; ++i) tab[i] = (unsigned long long)args.in[i];
        tab[IN_OUT] = (unsigned long long)args.out; }
    __syncthreads();
    XcdBarrier bar; bar.bar = (unsigned*)(ws + WS_CTL) + CW_BAR; bar.x = 0; bar.st = nullptr;
    if (MK_N_LAUNCHES == 1) bar = xcd_barrier_post((unsigned*)(ws + WS_CTL) + CW_BAR, F.MISC + 8);
    const int lo = args.ph_lo, hi = args.ph_hi;
#define IN(k) (lo <= (k) && (k) < hi)
#define SEAM(k) do { if ((k) + 1 < hi) xcd_barrier(bar); } while (0)
#define ENTER() do { int t_ = threadIdx.x; asm volatile("" : "+v"(t_)); F.tid = t_; F.lane = t_ & 63; F.wave = __builtin_amdgcn_readfirstlane(t_ >> 6); \
        unsigned long long w_ = (unsigned long long)args.ws; asm volatile("" : "+s"(w_)); ws = (unsigned char*)w_; F.ws = ws; } while (0)

    if (IN(0)) { ENTER(); s0_prologue(F); SEAM(0); }
    if (IN(1)) { ENTER(); s0b_modsum(F); SEAM(1); }
    if (IN(2)) { ENTER(); s1_prologue(F); SEAM(2); }
#pragma unroll 1
    for (int l = 0; l < DEPTH; ++l) {
        const int p0 = 3 + 8 * l; const bool last = (l == DEPTH - 1);
        if (IN(p0)) {
            ENTER();
            pg8::Gemm g{(const bf16*)(ws + WS_ACT), (const bf16*)(ws + WS_WIN + l * WIN_STRIDE), R, NIN, DM}; pg8::StaticOrder S; S.init(R, NIN, DM, F.G, (int)blockIdx.x, 0);
            pg8::EpiInProj E{F.lds, ws, l};
            pg8::gemm_phase<pg8::EpiInProj, pg8::StaticOrder, true, true>(F.lds + RING_OFF, g, S, E);
            SEAM(p0);
        }
        if (IN(p0 + 1)) {
            ENTER();
            for (int u = F.vcu; u < 256; u += F.G) f1_unit(F, u);
            ENTER();
            for (int u = F.vcu; u < 256; u += F.G) p2_convpool_unit<8>(F, l, (u >> 7) * SPB + CTXL + (u & 127) * 64);
            if (!last) { ENTER(); for (int u = (F.vcu + 32) % F.G; u < 16; u += F.G) p2_convpool_unit<4>(F, l, (u >> 3) * SPB + (u & 7) * 32); }
            if (!last) { ENTER(); for (int u = F.G - 1 - F.vcu; u < 16; u += F.G) fctx_unit(F, u); }
            SEAM(p0 + 1);
        }
        if (IN(p0 + 2)) {
            ENTER();
            for (int u = F.vcu; u < 256; u += F.G) f2_unit(F, u);
            ENTER();
            const int nun = last ? 256 : 264;
            for (int u = F.vcu; u < nun; u += F.G) {
                int bh, q0, NT; if (u < 256) { bh = u >> 5; q0 = 256 * (1 + (u & 31)); NT = SPB / 64; } else { bh = u - 256; q0 = 0; NT = CTXL / 64; }
                attn_body::attn_unit<8>((long)(bh >> 2) * SPB, bh & 3, q0, NT, (const attn_body::bf16*)(ws + WS_Q), (const attn_body::bf16*)(ws + WS_K), (const attn_body::bf16*)(ws + WS_V),
                                        (attn_body::bf16*)(ws + WS_MIX), (char*)lds + RING_OFF);
            }
            SEAM(p0 + 2);
        }
        if (IN(p0 + 3)) {
            ENTER();
            pg8::Gemm g{(const bf16*)(ws + WS_MIX), (const bf16*)(ws + WS_WO + l * WO_STRIDE), R, DM, DM}; pg8::StaticOrder S; S.init(64 * 256, DM, DM, F.G, (int)blockIdx.x, 1);
            if (F.G == 256) { pg8::EpiRes2 E{F.lds, ws, l, 0}; pg8::gemm_phase<pg8::EpiRes2, pg8::StaticOrder, false, true>(F.lds + RING_OFF, g, S, E); }
            else { pg8::EpiRes E{F.lds, ws, l, 0}; pg8::gemm_phase<pg8::EpiRes, pg8::StaticOrder, true, true>(F.lds + RING_OFF, g, S, E); }
            if (!last) { ENTER(); pg8::Gemm g2{(const bf16*)(ws + WS_MIX), (const bf16*)(ws + WS_WO + l * WO_STRIDE), R, DM, DM}; pg8::StaticOrder S2; S2.init(64 * 256, DM, DM, F.G, (int)blockIdx.x, 2); pg8::EpiPart E2{ws};
                pg8::gemm_phase<pg8::EpiPart, pg8::StaticOrder, true, true>(F.lds + RING_OFF, g2, S2, E2); }
            SEAM(p0 + 3);
        }
        if (IN(p0 + 4) && !last) { ENTER(); ctx_fixup(F, l, 0); SEAM(p0 + 4); }
        if (IN(p0 + 5)) {
            ENTER();
            pg8::Gemm g{(const bf16*)(ws + WS_ACT), (const bf16*)(ws + WS_WFI + l * WFI_STRIDE), R, 2 * DFF, DM}; pg8::StaticOrder S; S.init(last ? 64 * 256 : R, 2 * DFF, DM, F.G, (int)blockIdx.x, last ? 1 : 0);
            pg8::EpiFfnIn E{ws, l};
            pg8::gemm_phase<pg8::EpiFfnIn, pg8::StaticOrder, true, true>(F.lds + RING_OFF, g, S, E);
            SEAM(p0 + 5);
        }
        if (IN(p0 + 6)) {
            ENTER();
            pg8::Gemm g{(const bf16*)(ws + WS_H), (const bf16*)(ws + WS_WFO + l * WFO_STRIDE), R, DM, DFF}; pg8::StaticOrder S; S.init(64 * 256, DM, DFF, F.G, (int)blockIdx.x, 1);
            if (F.G == 256) { pg8::EpiRes2 E{F.lds, ws, l, 1}; pg8::gemm_phase<pg8::EpiRes2, pg8::StaticOrder, false, true>(F.lds + RING_OFF, g, S, E); }
            else { pg8::EpiRes E{F.lds, ws, l, 1}; pg8::gemm_phase<pg8::EpiRes, pg8::StaticOrder, true, true>(F.lds + RING_OFF, g, S, E); }
            if (!last) { ENTER(); pg8::Gemm g2{(const bf16*)(ws + WS_H), (const bf16*)(ws + WS_WFO + l * WFO_STRIDE), R, DM, DFF}; pg8::StaticOrder S2; S2.init(64 * 256, DM, DFF, F.G, (int)blockIdx.x, 2); pg8::EpiPart E2{ws};
                pg8::gemm_phase<pg8::EpiPart, pg8::StaticOrder, true, true>(F.lds + RING_OFF, g2, S2, E2); }
            if (!last) SEAM(p0 + 6);
        }
        if (IN(p0 + 7) && !last) { ENTER(); ctx_fixup(F, l, 1); SEAM(p0 + 7); }
    }
#undef IN
#undef SEAM
}

extern "C" void kernel_launch(void* const* d_in, const int* in_sizes, int n_in, void* d_out, int out_size, void* d_ws, size_t ws_size, hipStream_t stream) {
    static int grid = 0;
    if (grid == 0) {
        if (n_in != 22 || out_size != BATCH * SEQ * DM || ws_size < WS_END) { fprintf(stderr, "kernel_launch: unexpected shapes (n_in %d out %d ws %zu)\n", n_in, out_size, ws_size); grid = -1; return; }
        int dev = 0, cus = 0, per_cu = 0;
        if (hipGetDevice(&dev) != hipSuccess || hipDeviceGetAttribute(&cus, hipDeviceAttributeMultiprocessorCount, dev) != hipSuccess) { grid = -1; return; }
        if (hipFuncSetAttribute((const void*)fwd_kernel, hipFuncAttributeMaxDynamicSharedMemorySize, LDS_BYTES) != hipSuccess) { fprintf(stderr, "kernel_launch: hipFuncSetAttribute failed\n"); grid = -1; return; }
        if (hipOccupancyMaxActiveBlocksPerMultiprocessor(&per_cu, (const void*)fwd_kernel, NWAVES * 64, LDS_BYTES) != hipSuccess || per_cu < 1) { fprintf(stderr, "kernel_launch: occupancy query says %d\n", per_cu); (void)hipGetLastError(); per_cu = 1; }
        grid = cus;
    }
    if (grid < 0) return;
    (void)hipMemsetAsync((char*)d_ws + WS_CTL, 0, CTL_ZERO_BYTES, stream);
    Args a{};
    for (int i = 0; i < 22; ++i) a.in[i] = (const float*)d_in[i];
    a.out = (float*)d_out; a.ws = (unsigned char*)d_ws;
#if MK_N_LAUNCHES == 1
    a.ph_lo = 0; a.ph_hi = N_PHASES;
    void* kargs[] = {&a};
    hipError_t e = hipLaunchCooperativeKernel((const void*)fwd_kernel, dim3(grid), dim3(NWAVES * 64), kargs, LDS_BYTES, stream);
    if (e != hipSuccess) { fprintf(stderr, "kernel_launch: cooperative launch failed: %s\n", hipGetErrorString(e)); }
#else
    for (int p = 0; p < N_PHASES; ++p) { a.ph_lo = p; a.ph_hi = p + 1; hipLaunchKernelGGL(fwd_kernel, dim3(grid), dim3(NWAVES * 64), LDS_BYTES, stream, a); }
#endif
}
```

```cpp
#include <hip/hip_runtime.h>
#include <hip/hip_bf16.h>
#include <cstdio>
#include <cstdint>
#include <cmath>
constexpr int NWAVES = 8;
constexpr int BATCH = 2, SEQ = 8192, CTXL = 256, DM = 1024, DEPTH = 2, DFF = 2816, DIN0 = 1536, NIN = 1792;
constexpr int SPB = SEQ + CTXL;
constexpr int R = BATCH * SPB;
constexpr float EPS = 1e-6f;
constexpr float QSCALE = 0.125f * 1.4426950408889634f;
constexpr size_t MiB = 1u << 20, KiB = 1024;
constexpr size_t WS_CTL = 0, CTL_ZERO_BYTES = 32 * 1024;
constexpr size_t CTL_MOD = 64 * 1024;
constexpr size_t WS_WIN = 1 * MiB, WIN_STRIDE = 3584 * KiB;
constexpr size_t WS_WO = 8 * MiB, WO_STRIDE = 2 * MiB;
constexpr size_t WS_WFI = 12 * MiB, WFI_STRIDE = 11 * MiB;
constexpr size_t WS_WFO = 34 * MiB, WFO_STRIDE = 5632 * KiB;
constexpr size_t WS_SMALL = 45 * MiB;
constexpr size_t SM_BIN = WS_SMALL;
constexpr size_t SM_BFF = SM_BIN + 64 * 1024;
constexpr size_t SM_ROPE = SM_BFF + 192 * 1024;
constexpr size_t SM_TW = SM_ROPE + 16 * 1024;
constexpr size_t SM_M1 = SM_TW + 64 * 1024;
constexpr size_t SM_M2 = SM_M1 + 128 * 1024;
constexpr size_t SM_M3 = SM_M2 + 16 * 1024;
constexpr size_t SM_MODPART = 46 * MiB;
constexpr size_t WS_CTXRES = 48 * MiB + 512 * KiB;
constexpr size_t WS_ACT = 51 * MiB;
constexpr size_t WS_P = 84 * MiB;
constexpr size_t WS_Q = 142 * MiB;
constexpr size_t WS_K = 150 * MiB + 512 * KiB;
constexpr size_t WS_V = 155 * MiB;
constexpr size_t WS_GP = 159 * MiB + 512 * KiB;
constexpr size_t WS_H = 84 * MiB;
constexpr size_t WS_MIX = 176 * MiB;
constexpr size_t WS_RPART = 209 * MiB;
constexpr size_t WS_PART = 213 * MiB + 512 * KiB;
constexpr size_t WS_RES = 222 * MiB;
constexpr size_t WS_END = 254 * MiB;
static_assert(WS_H + (size_t)R * DFF * 2 <= WS_MIX && WS_GP + 16 * MiB <= WS_MIX && WS_P + (size_t)R * NIN * 2 <= WS_Q && WS_Q + (size_t)R * 512 <= WS_K && WS_K + (size_t)R * 256 <= WS_V && WS_V + (size_t)R * 256 <= WS_GP, "d_ws map");
static_assert(WS_WIN + 2 * WIN_STRIDE <= WS_WO && WS_WO + 2 * WO_STRIDE <= WS_WFI && WS_WFI + 2 * WFI_STRIDE <= WS_WFO && WS_WFO + 2 * WFO_STRIDE <= WS_SMALL && SM_M3 + 256 * KiB <= SM_MODPART && SM_MODPART + 2304 * KiB <= WS_CTXRES && WS_CTXRES + 2 * MiB <= WS_ACT, "d_ws map (weights)");
static_assert(WS_ACT + (size_t)R * 2048 <= WS_P && WS_MIX + (size_t)R * 2048 <= WS_RPART && WS_RPART + (size_t)4 * R * 64 <= WS_PART && WS_PART + 8 * MiB <= WS_RES && WS_RES + 32 * MiB <= WS_END && WS_END <= 256 * MiB, "d_ws map (tail)");
constexpr int CW_BAR = 4096;
constexpr int RING_OFF = 0, RING_BYTES = 131072;
constexpr int LDSCTL_OFF = 146432, MISC_OFF = LDSCTL_OFF + 320;
constexpr int LDS_BYTES = 147456;
typedef unsigned u32x2_t __attribute__((ext_vector_type(2)));
constexpr int PTAB_OFF = LDSCTL_OFF + 512;
#define N_IN 22
__device__ __forceinline__ const float* inptr(__attribute__((address_space(3))) unsigned char* lds, int i) {
    const unsigned long long v = *(const __attribute__((address_space(3))) unsigned long long*)(lds + PTAB_OFF + 8 * i);
    const unsigned lo = __builtin_amdgcn_readfirstlane((unsigned)v), hi = __builtin_amdgcn_readfirstlane((unsigned)(v >> 32));
    return (const float*)(((unsigned long long)hi << 32) | lo);
}
#define IN_X 0
#define IN_C 1
#define IN_CTX 2
#define IN_CCTX 3
#define IN_WMOD 4
#define IN_BMOD 5
#define IN_G1 6
#define IN_G2 7
#define IN_WIN 8
#define IN_QG 9
#define IN_KG 10
#define IN_WF 11
#define IN_DWW 12
#define IN_DWB 13
#define IN_LNG 14
#define IN_LNB 15
#define IN_WPW 16
#define IN_WPL 17
#define IN_PLS 18
#define IN_WO 19
#define IN_WFI 20
#define IN_WFO 21
#define IN_OUT 22
__device__ __forceinline__ float row_rstd(const float* rpart, int r) {
    typedef float f4 __attribute__((ext_vector_type(4)));
    const f4* p = (const f4*)(rpart + (size_t)r * 16); const f4 a = p[0], b = p[1], c = p[2], d = p[3];
    const float s = (((a[0] + a[1]) + (a[2] + a[3])) + ((b[0] + b[1]) + (b[2] + b[3]))) + (((c[0] + c[1]) + (c[2] + c[3])) + ((d[0] + d[1]) + (d[2] + d[3])));
    return rsqrtf(s * (1.0f / 1024.0f) + 1e-6f);
}
namespace pg8 {
#define PG8_LAS __attribute__((address_space(3)))
typedef unsigned short bf16_t;
typedef short bf16x8 __attribute__((ext_vector_type(8)));
typedef float f32x4 __attribute__((ext_vector_type(4)));
typedef unsigned u32x4 __attribute__((ext_vector_type(4)));
constexpr int BM = 256, BK = 64, HALF = 128, HTB = HALF * BK * 2  , STAGE_BYTES = 8 * HTB, NXCD = 8, WGM = 8;

__host__ __device__ __forceinline__ int lds_byte(int r, int c) { const int st = (r >> 4) * 2 + (c >> 5), rr = r & 15, cc = c & 31, ob = rr * 64 + cc * 2; return st * 1024 + (ob ^ (((ob >> 9) & 1) << 5)); }
__host__ __device__ __forceinline__ void stage_rc(int b, int& R, int& C) { const int st = b / 1024, sb = b % 1024, swz = sb ^ (((sb >> 9) & 1) << 5); R = (st >> 1) * 16 + swz / 64; C = (st & 1) * 32 + (swz % 64) / 2; }
__host__ __device__ __forceinline__ int perm32(int rho) { const int n = rho >> 4, i = rho & 15; return 8 * (i >> 2) + 4 * n + (i & 3); }

struct Unit { int pm, pn, kx;
    __host__ __device__ __forceinline__ int nt() const { return kx & 255; }
    __host__ __device__ __forceinline__ int kt0() const { return (kx >> 8) & 255; }
    __host__ __device__ __forceinline__ int kc() const { return (kx >> 16) - 1; } };
struct Gemm { const bf16_t* A; const bf16_t* Bt; int M, N, K; };

struct StaticOrder {
    int nM, nN, nwg, G, c, skip, ntk;
    __host__ __device__ void init(int M, int N, int K, int G_, int c_, int skip_) { nM = M / BM; nN = N / BM; nwg = skip_ == 2 ? 0 : nM * nN; G = G_; c = c_; skip = skip_; ntk = K / BK; }
    __host__ __device__ bool next(int i, Unit& u) const {
        const long L = (long)i * G + c;
        u.kx = ntk;
        if (skip == 2 && L >= nwg) { const int idx = (int)(L - nwg); if (idx >= 32) return false; const int tile = idx >> 2, kc = idx & 3, base = (ntk >> 2) & ~1, rem2 = (ntk - 4 * base) >> 1;
            u.pm = (tile >> 2) * 33; u.pn = tile & 3; u.kx = ((kc + 1) << 16) | ((kc * base + 2 * (kc < rem2 ? kc : rem2)) << 8) | (base + (kc < rem2 ? 2 : 0)); return true; }
        if (L >= nwg) return false;
        int wgid = (int)L; { const int q = nwg / NXCD, r = nwg % NXCD, xcd = wgid % NXCD, off = wgid / NXCD; wgid = (xcd < r ? xcd * (q + 1) : r * (q + 1) + (xcd - r) * q) + off; }
        const int nig = WGM * nN, gid = wgid / nig, fm = gid * WGM, gsz = (nM - fm) < WGM ? (nM - fm) : WGM;
        u.pm = fm + ((wgid % nig) % gsz); u.pn = (wgid % nig) / gsz; if (skip) u.pm += 1 + u.pm / 32; return true;
    }
    __device__ __forceinline__ void a_ready(const Unit&) const {}
    __device__ __forceinline__ void done(const Unit&) const {}
};

__device__ __forceinline__ unsigned cvt_pk_bf16(float lo, float hi) { unsigned r; asm volatile("v_cvt_pk_bf16_f32 %0, %1, %2" : "=v"(r) : "v"(lo), "v"(hi)); return r; }
constexpr int RT = 33;
__device__ __forceinline__ int tile_v(int pm) { return (pm % RT == 0) ? 2 : pm / RT; }
typedef unsigned u32x2 __attribute__((ext_vector_type(2)));

struct EpiInProj {
    static constexpr bool PERM = true, AFTER_DRAIN = false;
    PG8_LAS unsigned char* lds; unsigned char* ws; int l;
    __device__ __forceinline__ void operator()(const f32x4 (&acc)[2][2][4][2], const Unit& u, int wr, int wc, int fr, int fq) const {
        if (u.pn < 2) { qkv(acc, u, wr, wc, fr, fq); return; }
        bf16_t* O = (bf16_t*)(ws + WS_P); const float* rowss = (const float*)(ws + WS_RPART) + (size_t)(2 * l) * R * 16; const float* bias = (const float*)(ws + SM_BIN) + (size_t)l * 3 * NIN;
        const int row0 = u.pm * BM + wr * 64 + fr, v = tile_v(u.pm), col0 = u.pn * BM + wc * 32 + 8 * fq;
        const float* bp = bias + v * 1792 + col0;
        f32x4 bv[2][2];
#pragma unroll
        for (int bj = 0; bj < 2; ++bj)
#pragma unroll
            for (int n = 0; n < 2; ++n) bv[bj][n] = *(const f32x4*)(bp + bj * HALF + 4 * n);
        float rsv[8];
        { f32x4 pq[8];
#pragma unroll
          for (int q = 0; q < 8; ++q) pq[q] = *(const f32x4*)(rowss + (size_t)(row0 + (q >> 2) * HALF + (q & 3) * 16) * 16 + 4 * fq);
#pragma unroll
          for (int q = 0; q < 8; ++q) { float s = (pq[q][0] + pq[q][1]) + (pq[q][2] + pq[q][3]); s += __shfl_xor(s, 16); s += __shfl_xor(s, 32); rsv[q] = rsqrtf(s * (1.0f / 1024.0f) + 1e-6f); } }
#pragma unroll
        for (int ai = 0; ai < 2; ++ai)
#pragma unroll
            for (int m = 0; m < 4; ++m) { const int r = row0 + ai * HALF + m * 16; const float rs = rsv[ai * 4 + m];
                bf16_t* rowp = O + (size_t)r * 1792 + col0;
#pragma unroll
                for (int bj = 0; bj < 2; ++bj) { const f32x4 v0 = acc[ai][bj][m][0] * rs + bv[bj][0], v1 = acc[ai][bj][m][1] * rs + bv[bj][1];
                    u32x4 w; w.x = cvt_pk_bf16(v0[0], v0[1]); w.y = cvt_pk_bf16(v0[2], v0[3]); w.z = cvt_pk_bf16(v1[0], v1[1]); w.w = cvt_pk_bf16(v1[2], v1[3]);
                    *(u32x4*)(rowp + bj * HALF) = w; } }
    }
    __device__ __forceinline__ void qkv(const f32x4 (&acc)[2][2][4][2], const Unit& u, int wr, int wc, int fr, int fq) const {
        const float* rowss = (const float*)(ws + WS_RPART) + (size_t)(2 * l) * R * 16; const float* bias = (const float*)(ws + SM_BIN) + (size_t)l * 3 * NIN;
        const float* rope = (const float*)(ws + SM_ROPE);
        const int row0 = u.pm * BM + wr * 64 + fr, v = tile_v(u.pm), col0 = u.pn * BM + wc * 32 + 8 * fq;
        const bool isq = u.pn == 0, norm = isq || wc < 2, lat = (u.pm % RT) != 0;
        const float* bp = bias + v * 1792 + col0;
        f32x4 bv[2][2], gg[2][2];
#pragma unroll
        for (int bj = 0; bj < 2; ++bj)
#pragma unroll
            for (int n = 0; n < 2; ++n) { bv[bj][n] = *(const f32x4*)(bp + bj * HALF + 4 * n);
                gg[bj][n] = (f32x4){1.f, 1.f, 1.f, 1.f};
                if (norm) gg[bj][n] = *(const f32x4*)((isq ? inptr(lds, IN_QG) : inptr(lds, IN_KG)) + l * 64 + 32 * bj + 8 * fq + 4 * n) * (isq ? QSCALE : 1.0f); }
        bf16_t* ob = isq ? (bf16_t*)(ws + WS_Q) + wc * 64 + 8 * fq : (wc < 2 ? (bf16_t*)(ws + WS_K) + wc * 64 + 8 * fq : (bf16_t*)(ws + WS_V) + (wc - 2) * 64 + 8 * fq);
        const int opitch = isq ? 256 : 128;
#pragma unroll
        for (int ai = 0; ai < 2; ++ai) {
            f32x4 cr[2] = {{1.f, 0.f, 1.f, 0.f}, {1.f, 0.f, 1.f, 0.f}};
            if (norm && lat) { const int prow = (u.pm % RT - 1) * 4 + 2 * ai + wr; const float* p = rope + ((size_t)prow * 16 + 4 * fq) * 2; cr[0] = *(const f32x4*)p; cr[1] = *(const f32x4*)(p + 4); }
#pragma unroll
            for (int m = 0; m < 4; ++m) { const int r = row0 + ai * HALF + m * 16;
                float rs; { const f32x4 pq = *(const f32x4*)(rowss + (size_t)r * 16 + 4 * fq); float s = (pq[0] + pq[1]) + (pq[2] + pq[3]); s += __shfl_xor(s, 16); s += __shfl_xor(s, 32); rs = rsqrtf(s * (1.0f / 1024.0f) + 1e-6f); }
                f32x4 x[2][2];
#pragma unroll
                for (int bj = 0; bj < 2; ++bj)
#pragma unroll
                    for (int n = 0; n < 2; ++n) x[bj][n] = acc[ai][bj][m][n] * rs + bv[bj][n];
                if (norm) {
                    float ss = 0.f;
#pragma unroll
                    for (int bj = 0; bj < 2; ++bj)
#pragma unroll
                        for (int n = 0; n < 2; ++n) ss += (x[bj][n][0] * x[bj][n][0] + x[bj][n][1] * x[bj][n][1]) + (x[bj][n][2] * x[bj][n][2] + x[bj][n][3] * x[bj][n][3]);
                    ss += __shfl_xor(ss, 16); ss += __shfl_xor(ss, 32);
                    const float rn = rsqrtf(ss * (1.0f / 64.0f) + 1e-6f);
#pragma unroll
                    for (int bj = 0; bj < 2; ++bj)
#pragma unroll
                        for (int n = 0; n < 2; ++n) x[bj][n] = x[bj][n] * rn * gg[bj][n];
                    if (lat) { const float* p = rope + ((size_t)(16 * m + fr) * 16 + 4 * fq) * 2; const f32x4 cc[2] = {*(const f32x4*)p, *(const f32x4*)(p + 4)};
#pragma unroll
                        for (int n = 0; n < 2; ++n) { f32x4 a = x[0][n], b = x[1][n]; const f32x4 c0 = cr[n], c1 = cc[n];
                            x[0][n] = (f32x4){a[0] * c0[0] - a[1] * c0[1], a[0] * c0[1] + a[1] * c0[0], a[2] * c0[2] - a[3] * c0[3], a[2] * c0[3] + a[3] * c0[2]};
                            x[1][n] = (f32x4){b[0] * c1[0] - b[1] * c1[1], b[0] * c1[1] + b[1] * c1[0], b[2] * c1[2] - b[3] * c1[3], b[2] * c1[3] + b[3] * c1[2]}; } }
                }
#pragma unroll
                for (int bj = 0; bj < 2; ++bj) { u32x4 w; w.x = cvt_pk_bf16(x[bj][0][0], x[bj][0][1]); w.y = cvt_pk_bf16(x[bj][0][2], x[bj][0][3]); w.z = cvt_pk_bf16(x[bj][1][0], x[bj][1][1]); w.w = cvt_pk_bf16(x[bj][1][2], x[bj][1][3]);
                    *(u32x4*)(ob + (size_t)r * opitch + 32 * bj) = w; } } }
    }
};
struct EpiFfnIn {
    static constexpr bool PERM = true, AFTER_DRAIN = false;
    unsigned char* ws; int l;
    __device__ __forceinline__ void operator()(const f32x4 (&acc)[2][2][4][2], const Unit& u, int wr, int wc, int fr, int fq) const {
        bf16_t* H = (bf16_t*)(ws + WS_H); const float* rowss = (const float*)(ws + WS_RPART) + (size_t)(2 * l + 1) * R * 16; const float* bias = (const float*)(ws + SM_BFF) + (size_t)l * 3 * 2 * DFF;
        const int row0 = u.pm * BM + wr * 64 + fr, v = tile_v(u.pm), hc = wc * 32 + 8 * fq;
        const float* bp = bias + v * 5632 + u.pn * BM + hc;
        f32x4 bv[2][2];
#pragma unroll
        for (int bj = 0; bj < 2; ++bj)
#pragma unroll
            for (int n = 0; n < 2; ++n) bv[bj][n] = *(const f32x4*)(bp + bj * HALF + 4 * n);
        float rsv[8];
        { f32x4 pq[8];
#pragma unroll
          for (int q = 0; q < 8; ++q) pq[q] = *(const f32x4*)(rowss + (size_t)(row0 + (q >> 2) * HALF + (q & 3) * 16) * 16 + 4 * fq);
#pragma unroll
          for (int q = 0; q < 8; ++q) { float s = (pq[q][0] + pq[q][1]) + (pq[q][2] + pq[q][3]); s += __shfl_xor(s, 16); s += __shfl_xor(s, 32); rsv[q] = rsqrtf(s * (1.0f / 1024.0f) + 1e-6f); } }
#pragma unroll
        for (int ai = 0; ai < 2; ++ai)
#pragma unroll
            for (int m = 0; m < 4; ++m) { const int r = row0 + ai * HALF + m * 16; const float rs = rsv[ai * 4 + m];
                float o[8];
#pragma unroll
                for (int n = 0; n < 2; ++n) { const f32x4 a = acc[ai][0][m][n] * rs + bv[0][n], g = acc[ai][1][m][n] * rs + bv[1][n];
#pragma unroll
                    for (int i = 0; i < 4; ++i) o[4 * n + i] = a[i] * __builtin_amdgcn_rcpf(1.0f + __expf(-a[i])) * g[i]; }
                u32x4 w; w.x = cvt_pk_bf16(o[0], o[1]); w.y = cvt_pk_bf16(o[2], o[3]); w.z = cvt_pk_bf16(o[4], o[5]); w.w = cvt_pk_bf16(o[6], o[7]);
                *(u32x4*)(H + (size_t)r * 2816 + u.pn * HALF + hc) = w; }
    }
};
struct EpiRes {
    static constexpr bool PERM = false, AFTER_DRAIN = false;
    PG8_LAS unsigned char* lds; unsigned char* ws; int l; int kind;
    __device__ __forceinline__ void operator()(const f32x4 (&acc)[2][2][4][2], const Unit& u, int wr, int wc, int fr, int fq) const {
        const float* mod = (const float*)(ws + WS_CTL + CTL_MOD) + (size_t)l * 3 * 6144;
        const bool lastffn = (kind == 1 && l == DEPTH - 1);
        const float* xin = (kind == 0 && l == 0) ? inptr(lds, IN_X) : nullptr; const float* ctxin = xin ? inptr(lds, IN_CTX) : nullptr;
        float* dout = (float*)inptr(lds, IN_OUT); float* ctxres = (float*)(ws + WS_CTXRES);
        const float* gate = mod + (kind == 0 ? 2048 : 5120);
        const float* gn = lastffn ? nullptr : (kind == 0 ? inptr(lds, IN_G2) + l * DM : inptr(lds, IN_G1) + (l + 1) * DM);
        const float* sc = kind == 0 ? mod + 4096 : mod + 3 * 6144 + 1024;
        bf16_t* A = lastffn ? nullptr : (bf16_t*)(ws + WS_ACT);
        float* rowss = (float*)(ws + WS_RPART) + (size_t)(2 * l + 1 + kind) * R * 16;
        const int v = tile_v(u.pm), rr = u.pm % RT, b = u.pm / RT;
        const float* src; float* dst;
        if (rr == 0) { dst = ctxres + (size_t)b * 256 * 1024; src = xin ? ctxin + (size_t)b * 256 * 1024 : dst; }
        else { const size_t off = ((size_t)b * 8192 + (size_t)(rr - 1) * 256) * 1024; dst = dout + off; src = xin ? xin + off : dst; }
        const int col0 = u.pn * BM + wc * 32 + 4 * fq;
        f32x4 gv[2][2], gs[2][2];
#pragma unroll
        for (int bj = 0; bj < 2; ++bj)
#pragma unroll
            for (int n = 0; n < 2; ++n) { const int c = col0 + bj * HALF + n * 16; gv[bj][n] = *(const f32x4*)(gate + v * 6144 + c);
                if (A) gs[bj][n] = *(const f32x4*)(gn + c) * (*(const f32x4*)(sc + v * 6144 + c) + 1.0f); else gs[bj][n] = (f32x4){0.f, 0.f, 0.f, 0.f}; }
#pragma unroll
        for (int ai = 0; ai < 2; ++ai)
#pragma unroll
            for (int m = 0; m < 4; ++m) { const int lr = ai * HALF + wr * 64 + m * 16 + fr; float ss = 0.f;
#pragma unroll
                for (int bj = 0; bj < 2; ++bj)
#pragma unroll
                    for (int n = 0; n < 2; ++n) { const size_t o = (size_t)lr * 1024 + col0 + bj * HALF + n * 16;
                        const f32x4 xs = *(const f32x4*)(src + o); const f32x4 xo = xs + gv[bj][n] * acc[ai][bj][m][n];
                        *(f32x4*)(dst + o) = xo;
                        if (A) { ss += (xo[0] * xo[0] + xo[1] * xo[1]) + (xo[2] * xo[2] + xo[3] * xo[3]); const f32x4 a = xo * gs[bj][n];
                            u32x2 w; w.x = cvt_pk_bf16(a[0], a[1]); w.y = cvt_pk_bf16(a[2], a[3]); *(u32x2*)(A + (size_t)(u.pm * BM + lr) * 1024 + col0 + bj * HALF + n * 16) = w; } }
                if (A) { ss += __shfl_xor(ss, 16); ss += __shfl_xor(ss, 32);
                    if (fq == 0) rowss[(size_t)(u.pm * BM + lr) * 16 + u.pn * 4 + wc] = ss; }
                asm volatile("" ::: "memory"); }
    }
};
struct EpiPart {
    static constexpr bool PERM = false, AFTER_DRAIN = false;
    unsigned char* ws;
    __device__ __forceinline__ void operator()(const f32x4 (&acc)[2][2][4][2], const Unit& u, int wr, int wc, int fr, int fq) const {
        float* part = (float*)(ws + WS_PART) + ((size_t)(u.kc()) * 512 + (size_t)(u.pm / RT) * 256 + wr * 64 + fr) * 1024 + u.pn * BM + wc * 32 + 4 * fq;
#pragma unroll
        for (int ai = 0; ai < 2; ++ai)
#pragma unroll
            for (int m = 0; m < 4; ++m)
#pragma unroll
                for (int bj = 0; bj < 2; ++bj)
#pragma unroll
                    for (int n = 0; n < 2; ++n) *(f32x4*)(part + (ai * HALF + m * 16) * 1024 + bj * HALF + n * 16) = acc[ai][bj][m][n];
    }
};
struct EpiRes2 {
    static constexpr bool PERM = false, AFTER_DRAIN = true;
    PG8_LAS unsigned char* lds; unsigned char* ws; int l; int kind;
    __device__ __forceinline__ void operator()(const f32x4 (&acc)[2][2][4][2], const Unit& u, int wr, int wc, int fr, int fq) const {}
    __device__ __forceinline__ void fused(f32x4 (&acc)[2][2][4][2], const Unit& u, int wr, int wc, int fr, int fq, PG8_LAS unsigned char* ring, int wid, int lane) const {
        const float* mod = (const float*)(ws + WS_CTL + CTL_MOD) + (size_t)l * 3 * 6144;
        const bool lastffn = (kind == 1 && l == DEPTH - 1);
        const float* xin = (kind == 0 && l == 0) ? inptr(lds, IN_X) : nullptr;
        float* dout = (float*)inptr(lds, IN_OUT);
        const float* gate = mod + (kind == 0 ? 2048 : 5120);
        const float* gn = lastffn ? nullptr : (kind == 0 ? inptr(lds, IN_G2) + l * DM : inptr(lds, IN_G1) + (l + 1) * DM);
        const float* sc = kind == 0 ? mod + 4096 : mod + 3 * 6144 + 1024;
        bf16_t* A = lastffn ? nullptr : (bf16_t*)(ws + WS_ACT);
        float* rowss = (float*)(ws + WS_RPART) + (size_t)(2 * l + 1 + kind) * R * 16;
        const int v = tile_v(u.pm), rr0 = u.pm % RT, b = u.pm / RT;
        const size_t off = ((size_t)b * 8192 + (size_t)(rr0 - 1) * 256) * 1024;
        const float* src32 = xin ? xin + off : nullptr;
        bf16_t* res = (bf16_t*)(ws + WS_RES) + off;
        float* dst32 = lastffn ? dout + off : nullptr;
        PG8_LAS float* T = (PG8_LAS float*)ring;
        const int c = u.pn * BM + 4 * lane;
        const f32x4 gvv = *(const f32x4*)(gate + v * 6144 + c);
        f32x4 gsv = {0.f, 0.f, 0.f, 0.f}; if (A) gsv = *(const f32x4*)(gn + c) * (*(const f32x4*)(sc + v * 6144 + c) + 1.0f);
#pragma unroll
        for (int ai = 0; ai < 2; ++ai) {
#pragma unroll
            for (int m = 0; m < 4; ++m) { const int row = wr * 64 + m * 16 + fr;
#pragma unroll
                for (int bj = 0; bj < 2; ++bj)
#pragma unroll
                    for (int n = 0; n < 2; ++n) { const int g = ((bj * HALF + wc * 32 + n * 16) >> 2) + fq; *(PG8_LAS f32x4*)(T + row * 256 + ((g ^ (row & 15)) << 2)) = acc[ai][bj][m][n]; } }
            asm volatile("s_waitcnt lgkmcnt(0)" ::: "memory"); __builtin_amdgcn_s_barrier(); asm volatile("" ::: "memory");
#pragma unroll
            for (int rq = 0; rq < 4; ++rq) {
                f32x4 xs[4], tv[4];
#pragma unroll
                for (int k = 0; k < 4; ++k) { const int rr = wid * 16 + rq * 4 + k; const size_t o = (size_t)(ai * HALF + rr) * 1024 + c;
                    if (src32) xs[k] = *(const f32x4*)(src32 + o);
                    else { const u32x2 w = *(const u32x2*)(res + o); xs[k] = (f32x4){__builtin_bit_cast(float, w.x << 16), __builtin_bit_cast(float, w.x & 0xffff0000u), __builtin_bit_cast(float, w.y << 16), __builtin_bit_cast(float, w.y & 0xffff0000u)}; }
                    tv[k] = *(const PG8_LAS f32x4*)(T + rr * 256 + ((lane ^ (rr & 15)) << 2)); }
                asm volatile("" ::: "memory");
#pragma unroll
                for (int k = 0; k < 4; ++k) { const int lr = ai * HALF + wid * 16 + rq * 4 + k; const f32x4 xo = xs[k] + gvv * tv[k];
                    if (dst32) *(f32x4*)(dst32 + (size_t)lr * 1024 + c) = xo;
                    else { u32x2 w; w.x = cvt_pk_bf16(xo[0], xo[1]); w.y = cvt_pk_bf16(xo[2], xo[3]); *(u32x2*)(res + (size_t)lr * 1024 + c) = w; }
                    if (A) { const f32x4 a = xo * gsv; u32x2 w; w.x = cvt_pk_bf16(a[0], a[1]); w.y = cvt_pk_bf16(a[2], a[3]); *(u32x2*)(A + (size_t)(u.pm * BM + lr) * 1024 + c) = w;
                        float ss = (xo[0] * xo[0] + xo[1] * xo[1]) + (xo[2] * xo[2] + xo[3] * xo[3]);
                        ss += __builtin_bit_cast(float, __builtin_amdgcn_update_dpp(0, __builtin_bit_cast(int, ss), 0xB1, 0xf, 0xf, false));
                        ss += __builtin_bit_cast(float, __builtin_amdgcn_update_dpp(0, __builtin_bit_cast(int, ss), 0x4E, 0xf, 0xf, false));
                        ss += __builtin_bit_cast(float, __builtin_amdgcn_update_dpp(0, __builtin_bit_cast(int, ss), 0x141, 0xf, 0xf, false));
                        ss += __builtin_bit_cast(float, __builtin_amdgcn_update_dpp(0, __builtin_bit_cast(int, ss), 0x140, 0xf, 0xf, false));
                        ss += __builtin_bit_cast(float, __builtin_amdgcn_update_dpp(0, __builtin_bit_cast(int, ss), 0x142, 0xa, 0xf, false));
                        ss += __builtin_bit_cast(float, __builtin_amdgcn_update_dpp(0, __builtin_bit_cast(int, ss), 0x143, 0xc, 0xf, false));
                        if (lane == 63) *(f32x4*)(rowss + (size_t)(u.pm * BM + lr) * 16 + u.pn * 4) = (f32x4){ss, 0.f, 0.f, 0.f}; } }
                asm volatile("" ::: "memory"); }
            asm volatile("s_waitcnt lgkmcnt(0)" ::: "memory"); __builtin_amdgcn_s_barrier(); asm volatile("" ::: "memory");
        }
    }
};
template <class Epi, class Sched, bool ALIGN_EPI = false, bool SP2 = false>
__device__ __forceinline__ void gemm_phase(PG8_LAS unsigned char* lds, const Gemm g, const Sched& S, const Epi& E) {
    int tid_ = threadIdx.x; asm volatile("" : "+v"(tid_));
    const int tid = tid_, wid = __builtin_amdgcn_readfirstlane(tid >> 6), lane = tid & 63, wr = wid >> 2, wc = wid & 3, fr = lane & 15, fq = lane >> 4;
    const int K = g.K, nt = K / BK;
    unsigned voffA[2], voffB[2];
#pragma unroll
    for (int i = 0; i < 2; ++i) { int R, C; stage_rc(tid * 16 + i * 8192, R, C); const int Rb = Epi::PERM ? ((R & ~31) + perm32(R & 31)) : R;
        voffA[i] = (unsigned)(R * K + C) * 2u; voffB[i] = (unsigned)(Rb * K + C) * 2u; }
    const size_t kstep = (size_t)(BK * 2);
    const size_t hstep = (size_t)HALF * K * 2;
    const size_t tstep = 2 * hstep;
    const unsigned ldsw = (unsigned)wid * 1024u;
    const int aoff = lds_byte(wr * 64 + fr, fq * 8), boff = lds_byte(wc * 32 + fr, fq * 8);
#define PG8_SA(b, h) (((b) * 2 + (h)) * HTB)
#define PG8_SB(b, h) ((4 + (b) * 2 + (h)) * HTB)
#define PG8_STAGE(bufoff, gbase, voff) do { _Pragma("unroll") for (int _i = 0; _i < 2; ++_i) \
        __builtin_amdgcn_global_load_lds((const unsigned*)((const char*)(gbase) + (voff)[_i]), (PG8_LAS unsigned*)(lds + (bufoff) + ldsw + _i * 8192), 16, 0, 0); } while (0)
#define PG8_LDA(dst, b, h) do { _Pragma("unroll") for (int m = 0; m < 4; ++m) _Pragma("unroll") for (int k = 0; k < 2; ++k) dst[m][k] = *(const PG8_LAS bf16x8*)(lds + PG8_SA(b, h) + aoff + m * 2048 + k * 1024); } while (0)
#define PG8_LDB(dst, b, h) do { _Pragma("unroll") for (int n = 0; n < 2; ++n) _Pragma("unroll") for (int k = 0; k < 2; ++k) dst[n][k] = *(const PG8_LAS bf16x8*)(lds + PG8_SB(b, h) + boff + n * 2048 + k * 1024); } while (0)
#define PG8_MMA(ai, bj, At, Bt) do { __builtin_amdgcn_s_setprio(1); _Pragma("unroll") for (int m = 0; m < 4; ++m) _Pragma("unroll") for (int n = 0; n < 2; ++n) _Pragma("unroll") for (int k = 0; k < 2; ++k) \
        acc[ai][bj][m][n] = __builtin_amdgcn_mfma_f32_16x16x32_bf16(Bt[n][k], At[m][k], acc[ai][bj][m][n], 0, 0, 0); __builtin_amdgcn_s_setprio(0); } while (0)
#define PG8_WAIT_V(n) asm volatile("s_waitcnt vmcnt(" #n ")" ::: "memory")
#define PG8_WAIT_L(n) asm volatile("s_waitcnt lgkmcnt(" #n ")" ::: "memory")
#define PG8_BAR __builtin_amdgcn_s_barrier()
#define PG8_SCHED __builtin_amdgcn_sched_barrier(0)
    Unit cur, nxt; int ui = 0;
    if (!S.next(0, cur)) return;
    f32x4 acc[2][2][4][2];
#pragma unroll
    for (int a = 0; a < 2; ++a)
#pragma unroll
        for (int b = 0; b < 2; ++b)
#pragma unroll
            for (int m = 0; m < 4; ++m)
#pragma unroll
                for (int n = 0; n < 2; ++n) acc[a][b][m][n] = (f32x4){0.f, 0.f, 0.f, 0.f};
    bf16x8 At[4][2], B0[2][2], B1[2][2];
    const char* cA = (const char*)g.A + (size_t)cur.pm * tstep + (size_t)cur.kt0() * kstep; const char* cB = (const char*)g.Bt + (size_t)cur.pn * tstep + (size_t)cur.kt0() * kstep;
    S.a_ready(cur);
    if constexpr (SP2) {
        PG8_STAGE(PG8_SB(0, 0), cB, voffB); PG8_STAGE(PG8_SB(0, 1), cB + hstep, voffB); PG8_STAGE(PG8_SA(0, 0), cA, voffA); PG8_STAGE(PG8_SA(0, 1), cA + hstep, voffA);
        if (wr == 1) PG8_BAR;
        PG8_WAIT_V(2); PG8_BAR;
        PG8_STAGE(PG8_SB(1, 0), cB + kstep, voffB); PG8_STAGE(PG8_SA(1, 0), cA + kstep, voffA); PG8_STAGE(PG8_SB(1, 1), cB + hstep + kstep, voffB);
        PG8_WAIT_V(6); PG8_BAR;
    } else {
        PG8_STAGE(PG8_SB(0, 0), cB, voffB); PG8_STAGE(PG8_SA(0, 0), cA, voffA); PG8_STAGE(PG8_SB(0, 1), cB + hstep, voffB); PG8_STAGE(PG8_SA(0, 1), cA + hstep, voffA);
        if (wr == 1) PG8_BAR;
        PG8_WAIT_V(4); PG8_BAR;
        PG8_STAGE(PG8_SB(1, 0), cB + kstep, voffB); PG8_STAGE(PG8_SA(1, 0), cA + kstep, voffA); PG8_STAGE(PG8_SB(1, 1), cB + hstep + kstep, voffB);
        PG8_WAIT_V(6); PG8_BAR;
    }
    for (;;) {
        const bool has_next = S.next(ui + 1, nxt);
        const char* nA = has_next ? (const char*)g.A + (size_t)nxt.pm * tstep + (size_t)nxt.kt0() * kstep : cA; const char* nB = has_next ? (const char*)g.Bt + (size_t)nxt.pn * tstep + (size_t)nxt.kt0() * kstep : cB;
        const int ntc = cur.nt();
        for (int t = 0; t < ntc; t += 2) {
            const bool last = (t == ntc - 2);
            const char* a1 = cA + (size_t)(t + 1) * kstep;
            const char* a2 = last ? nA : cA + (size_t)(t + 2) * kstep; const char* b2 = last ? nB : cB + (size_t)(t + 2) * kstep;
            const char* a3 = a2 + kstep; const char* b3 = b2 + kstep;
            if (last && has_next) S.a_ready(nxt);
            if constexpr (SP2) {
            PG8_LDB(B0, 0, 0); PG8_LDB(B1, 0, 1); PG8_SCHED; PG8_LDA(At, 0, 0); PG8_STAGE(PG8_SA(1, 1), a1 + hstep, voffA);
            PG8_WAIT_V(8); PG8_WAIT_L(0); PG8_BAR; PG8_MMA(0, 0, At, B0); PG8_MMA(0, 1, At, B1); PG8_BAR; PG8_SCHED;
            PG8_LDA(At, 0, 1); PG8_STAGE(PG8_SB(0, 0), b2, voffB); PG8_STAGE(PG8_SB(0, 1), b2 + hstep, voffB); PG8_STAGE(PG8_SA(0, 0), a2, voffA);
            PG8_WAIT_V(8); PG8_WAIT_L(0); PG8_BAR; PG8_MMA(1, 0, At, B0); PG8_MMA(1, 1, At, B1); PG8_BAR; PG8_SCHED;
            PG8_LDB(B0, 1, 0); PG8_LDB(B1, 1, 1); PG8_SCHED; PG8_LDA(At, 1, 0); PG8_STAGE(PG8_SA(0, 1), a2 + hstep, voffA);
            PG8_WAIT_V(8); PG8_WAIT_L(0); PG8_BAR; PG8_MMA(0, 0, At, B0); PG8_MMA(0, 1, At, B1); PG8_BAR; PG8_SCHED;
            PG8_LDA(At, 1, 1); PG8_STAGE(PG8_SB(1, 0), b3, voffB); PG8_STAGE(PG8_SB(1, 1), b3 + hstep, voffB); PG8_STAGE(PG8_SA(1, 0), a3, voffA);
            PG8_WAIT_V(8); PG8_WAIT_L(0); PG8_BAR; PG8_MMA(1, 0, At, B0); PG8_MMA(1, 1, At, B1); PG8_BAR; PG8_SCHED;
            } else {
            PG8_LDB(B0, 0, 0); PG8_SCHED; PG8_LDA(At, 0, 0); PG8_STAGE(PG8_SA(1, 1), a1 + hstep, voffA);
            PG8_WAIT_L(8); PG8_BAR; PG8_WAIT_L(0); PG8_MMA(0, 0, At, B0); PG8_BAR; PG8_SCHED;
            PG8_LDB(B1, 0, 1); PG8_STAGE(PG8_SB(0, 0), b2, voffB);
            PG8_BAR; PG8_WAIT_L(0); PG8_MMA(0, 1, At, B1); PG8_BAR;
            PG8_LDA(At, 0, 1); PG8_STAGE(PG8_SA(0, 0), a2, voffA);
            PG8_BAR; PG8_WAIT_L(0); PG8_MMA(1, 0, At, B0); PG8_BAR; PG8_SCHED;
            PG8_STAGE(PG8_SB(0, 1), b2 + hstep, voffB);
            PG8_WAIT_V(6); PG8_BAR; PG8_MMA(1, 1, At, B1); PG8_BAR;
            PG8_LDB(B0, 1, 0); PG8_SCHED; PG8_LDA(At, 1, 0); PG8_STAGE(PG8_SA(0, 1), a2 + hstep, voffA);
            PG8_WAIT_L(8); PG8_BAR; PG8_WAIT_L(0); PG8_MMA(0, 0, At, B0); PG8_BAR; PG8_SCHED;
            PG8_LDB(B1, 1, 1); PG8_STAGE(PG8_SB(1, 0), b3, voffB);
            PG8_BAR; PG8_WAIT_L(0); PG8_MMA(0, 1, At, B1); PG8_BAR;
            PG8_LDA(At, 1, 1); PG8_STAGE(PG8_SA(1, 0), a3, voffA);
            PG8_BAR; PG8_WAIT_L(0); PG8_MMA(1, 0, At, B0); PG8_BAR; PG8_SCHED;
            PG8_STAGE(PG8_SB(1, 1), b3 + hstep, voffB);
            PG8_WAIT_V(6); PG8_BAR; PG8_MMA(1, 1, At, B1); PG8_BAR;
            }
        }
        if constexpr (ALIGN_EPI) { if (wr == 0) PG8_BAR; }
        if constexpr (!Epi::AFTER_DRAIN) { E(acc, cur, wr, wc, fr, fq); S.done(cur); }
        if (!has_next) break;
#pragma unroll
        for (int a = 0; a < 2; ++a)
#pragma unroll
            for (int b = 0; b < 2; ++b)
#pragma unroll
                for (int m = 0; m < 4; ++m)
#pragma unroll
                    for (int n = 0; n < 2; ++n) acc[a][b][m][n] = (f32x4){0.f, 0.f, 0.f, 0.f};
        cur = nxt; cA = nA; cB = nB; ++ui;
        if constexpr (ALIGN_EPI) { if (wr == 1) PG8_BAR; }
    }
    PG8_WAIT_V(0);
    if constexpr (!ALIGN_EPI) { if (wr == 0) PG8_BAR; }
    PG8_BAR;
    if constexpr (Epi::AFTER_DRAIN) { E.fused(acc, cur, wr, wc, fr, fq, lds, wid, lane); S.done(cur); }
#undef PG8_SA
#undef PG8_SB
#undef PG8_STAGE
#undef PG8_LDA
#undef PG8_LDB
#undef PG8_MMA
#undef PG8_WAIT_V
#undef PG8_WAIT_L
#undef PG8_BAR
#undef PG8_SCHED
}
}

#include <hip/hip_bf16.h>
#include <cmath>
namespace attn_body {
using bf16=__hip_bfloat16;
using bf16x8=__attribute__((ext_vector_type(8)))short;
using s16x4=__attribute__((ext_vector_type(4)))short;
using f32x16=__attribute__((ext_vector_type(16)))float;
using u32x4=__attribute__((ext_vector_type(4)))unsigned;
constexpr int D=64,QP=256,KP=128,VP=128,OP=1024;
constexpr int NW=8,QBLK=32,QB=QBLK*NW,KVBLK=64;
constexpr int ATTN_UNIT_ROWS=QB;
__device__ __forceinline__ int crow(int r,int hi){return (r&3)+8*(r>>2)+4*hi;}
#define SBAR() __builtin_amdgcn_sched_barrier(0)
constexpr int NSLOT=3, SLOTB=8192;
constexpr int LDS_K=0, LDS_V=NSLOT*SLOTB, LDS_WS=2*NSLOT*SLOTB, LDS_OST=LDS_WS+NW*64*4, LDS_BYTES=LDS_OST+NW*4096;
constexpr float C2=0.125f*1.4426950408889634f;
__device__ __forceinline__ void glds16(const void*gsrc,unsigned lds_dst){unsigned keep;
  asm volatile("s_mov_b32 %0, m0\n\ts_mov_b32 m0, %2\n\ts_nop 0\n\tglobal_load_lds_dwordx4 %1, off\n\ts_mov_b32 m0, %0":"=&s"(keep):"v"(gsrc),"s"(lds_dst):"memory");}
__device__ __forceinline__ float max3f(float a,float b,float c){float r;asm("v_max3_f32 %0, %1, %2, %3":"=v"(r):"v"(a),"v"(b),"v"(c));return r;}
__device__ __forceinline__ float max2f(float a,float b){float r;asm("v_max_f32_e32 %0, %1, %2":"=v"(r):"v"(a),"v"(b));return r;}
__device__ __forceinline__ float fadd_s(float a,float b){float r;asm("v_add_f32_e32 %0, %1, %2":"=v"(r):"v"(a),"v"(b));return r;}
__device__ __forceinline__ float fsub_s(float a,float b){float r;asm("v_sub_f32_e32 %0, %1, %2":"=v"(r):"v"(a),"v"(b));return r;}
typedef float f32x2_t __attribute__((ext_vector_type(2))); typedef __bf16 bf16x2_t __attribute__((ext_vector_type(2)));
__device__ __forceinline__ unsigned cvtpk_s(float lo,float hi){f32x2_t v={lo,hi};bf16x2_t b=__builtin_convertvector(v,bf16x2_t);return __builtin_bit_cast(unsigned,b);}
#define WAIT_BAR(N) asm volatile("s_waitcnt vmcnt(" #N ") lgkmcnt(0)\n\ts_barrier":::"memory")

__device__ __forceinline__ void qkt(f32x16&p0,f32x16&p1,const char*Kslot,const bf16x8*qr,const f32x16&negm,int r32,int hi){
  const char*kb=Kslot+hi*1024+r32*16;
  #pragma unroll
  for(int d0=0;d0<4;++d0){
    const bf16x8 b0=*reinterpret_cast<const bf16x8*>(kb+d0*2048);
    const bf16x8 b1=*reinterpret_cast<const bf16x8*>(kb+d0*2048+512);
    if(d0==0){p0=__builtin_amdgcn_mfma_f32_32x32x16_bf16(b0,qr[0],negm,0,0,0);p1=__builtin_amdgcn_mfma_f32_32x32x16_bf16(b1,qr[0],negm,0,0,0);}
    else{p0=__builtin_amdgcn_mfma_f32_32x32x16_bf16(b0,qr[d0],p0,0,0,0);p1=__builtin_amdgcn_mfma_f32_32x32x16_bf16(b1,qr[d0],p1,0,0,0);}}
}
typedef __attribute__((address_space(3))) const char* lds_cptr;
typedef short v4i16_t __attribute__((ext_vector_type(4)));
__device__ __forceinline__ void kload8(bf16x8*kf,lds_cptr kp){
  kf[0]=*(const __attribute__((address_space(3))) bf16x8*)(kp);      kf[1]=*(const __attribute__((address_space(3))) bf16x8*)(kp+512);
  kf[2]=*(const __attribute__((address_space(3))) bf16x8*)(kp+2048); kf[3]=*(const __attribute__((address_space(3))) bf16x8*)(kp+2560);
  kf[4]=*(const __attribute__((address_space(3))) bf16x8*)(kp+4096); kf[5]=*(const __attribute__((address_space(3))) bf16x8*)(kp+4608);
  kf[6]=*(const __attribute__((address_space(3))) bf16x8*)(kp+6144); kf[7]=*(const __attribute__((address_space(3))) bf16x8*)(kp+6656);
}
__device__ __forceinline__ void kload2(bf16x8*kf,lds_cptr kp,int j){ kf[2*j]=*(const __attribute__((address_space(3))) bf16x8*)(kp+j*2048); kf[2*j+1]=*(const __attribute__((address_space(3))) bf16x8*)(kp+j*2048+512); }
__device__ __forceinline__ s16x4 vtr(lds_cptr p){ return __builtin_bit_cast(s16x4,__builtin_amdgcn_ds_read_tr16_b64_v4i16((__attribute__((address_space(3))) v4i16_t*)p)); }
__device__ __forceinline__ float rowmax(const f32x16&p0,const f32x16&p1){
  float a=max3f(p0[0],p0[1],p1[0]),b=max3f(p0[2],p0[3],p1[1]);a=max3f(a,p1[2],p1[3]);
  #pragma unroll
  for(int r=4;r<16;r+=4){a=max3f(a,p0[r],p0[r+1]);b=max3f(b,p0[r+2],p0[r+3]);a=max3f(a,p1[r],p1[r+1]);b=max3f(b,p1[r+2],p1[r+3]);}
  const float m=max2f(a,b);
  auto rr=__builtin_amdgcn_permlane32_swap(__float_as_uint(m),__float_as_uint(m),false,false);
  return max2f(__uint_as_float(rr[0]),__uint_as_float(rr[1]));
}
__device__ __forceinline__ void pv(f32x16*o,int vb,bf16x8 pa0,bf16x8 pa1,bf16x8 pa2,bf16x8 pa3){
  #pragma unroll
  for(int d0=0;d0<2;++d0){s16x4 lo[4],hi[4];
    #pragma unroll
    for(int ks=0;ks<4;++ks){
      asm volatile("ds_read_b64_tr_b16 %0,%1 offset:%c2":"=&v"(lo[ks]):"v"(vb),"i"(d0*4096+ks*1024):"memory");
      asm volatile("ds_read_b64_tr_b16 %0,%1 offset:%c2":"=&v"(hi[ks]):"v"(vb),"i"(d0*4096+ks*1024+512):"memory");}
    asm volatile("s_waitcnt lgkmcnt(0)":::"memory");SBAR();
    #define PK(k) (bf16x8){lo[k][0],lo[k][1],lo[k][2],lo[k][3],hi[k][0],hi[k][1],hi[k][2],hi[k][3]}
    o[d0]=__builtin_amdgcn_mfma_f32_32x32x16_bf16(pa0,PK(0),o[d0],0,0,0);
    o[d0]=__builtin_amdgcn_mfma_f32_32x32x16_bf16(pa1,PK(1),o[d0],0,0,0);
    o[d0]=__builtin_amdgcn_mfma_f32_32x32x16_bf16(pa2,PK(2),o[d0],0,0,0);
    o[d0]=__builtin_amdgcn_mfma_f32_32x32x16_bf16(pa3,PK(3),o[d0],0,0,0);
    #undef PK
  }
}

#ifndef ATTN_STORE16
#define ATTN_STORE16(p,v) (*(u32x4*)(p)=(v))
#endif
template<int THRL> __device__ __forceinline__ void attn_unit(const long rowbase,const int h,const int q0,const int NT,const bf16*Q,const bf16*__restrict__ K,const bf16*__restrict__ V,bf16*O,char*shm){
  int tid_=threadIdx.x; asm volatile("":"+v"(tid_)); const int tid=tid_,lane=tid&63,r32=lane&31,hi=lane>>5; const int wid=__builtin_amdgcn_readfirstlane(tid>>6);
  const bf16*Qw=Q+(rowbase+q0+wid*QBLK)*QP+h*D;
  const bf16*Kh=K+rowbase*KP+(h>>1)*D,*Vh=V+rowbase*VP+(h>>1)*D;
  const unsigned lds0=(unsigned)(uintptr_t)shm;
  float*wsf=(float*)(shm+LDS_WS)+wid*64;
  const bf16*ksrc=Kh+(long)lane*KP+wid*8;
  const bf16*vsrc=Vh+(long)(16*(wid&3)+(lane>>2))*VP+(wid>>2)*32+(lane&3)*8;
  const unsigned kdst=lds0+LDS_K+wid*1024, vdst=lds0+LDS_V+wid*1024;
  #define DMA_K(t,slot) glds16(ksrc+(long)(t)*KVBLK*KP,(unsigned)__builtin_amdgcn_readfirstlane(kdst+(slot)))
  #define DMA_V(t,slot) glds16(vsrc+(long)(t)*KVBLK*VP,(unsigned)__builtin_amdgcn_readfirstlane(vdst+(slot)))
  const int vb0=(int)(lds0+LDS_V)+((lane>>4)&1)*32+(lane&3)*8+(4*hi+((lane&15)>>2))*64;
  const char*Kbase=shm+LDS_K; bf16x8 kf[8];
  const lds_cptr shm3=(lds_cptr)shm; const lds_cptr kp0=shm3+LDS_K+hi*1024+r32*16; const lds_cptr vp0=shm3+LDS_V+((lane>>4)&1)*32+(lane&3)*8+(4*hi+((lane&15)>>2))*64;
  DMA_K(0,0);DMA_V(0,0);DMA_K(1,SLOTB);
  bf16x8 qr[4];
  #pragma unroll
  for(int d0=0;d0<4;++d0)qr[d0]=*reinterpret_cast<const bf16x8*>(&Qw[(long)r32*QP+d0*16+hi*8]);
  float mhat=0.f,l_reg=0.f;f32x16 o[2];o[0]=f32x16{};o[1]=f32x16{};f32x16 negm=f32x16{};asm volatile("":"+v"(negm));
  #define CMASK(P0,P1,t) do{}while(0)
  bool resc=false;
  #define START(P0,P1) do{ const float rm=rowmax(P0,P1); resc=false; \
    { const float dl=rm; mhat=fadd_s(mhat,dl); \
      _Pragma("unroll") for(int r=0;r<16;++r){P0[r]=fsub_s(P0[r],dl);P1[r]=fsub_s(P1[r],dl);} \
      _Pragma("unroll") for(int r=0;r<16;++r)negm[r]=-mhat; asm volatile("":"+v"(negm)); } \
    _Pragma("unroll") for(int r=0;r<16;++r)P0[r]=__builtin_amdgcn_exp2f(P0[r]); }while(0)
  #define RESC() do{ if(resc){ asm volatile("s_waitcnt lgkmcnt(0)":::"memory"); \
      _Pragma("unroll") for(int d_=0;d_<2;++d_) _Pragma("unroll") for(int r=0;r<16;++r)o[d_][r]*=wsf[crow(r,hi)]; } }while(0)
  f32x16 pA0,pA1,pB0,pB1;
  int sl_prev=0,sl_cur=0,sl_next=SLOTB;
  #define ROT() do{sl_prev=sl_cur;sl_cur=sl_next;sl_next=(sl_next==(NSLOT-1)*SLOTB)?0:sl_next+SLOTB;}while(0)
  DMA_K(2,2*SLOTB);
  WAIT_BAR(3);
  qkt(pA0,pA1,Kbase,qr,negm,r32,hi);asm volatile("s_nop 15\n\ts_nop 7":"+v"(pA0),"+v"(pA1));CMASK(pA0,pA1,0);
  START(pA0,pA1);
  _Pragma("unroll") for(int r=0;r<16;++r)pA1[r]=__builtin_amdgcn_exp2f(pA1[r]);
  WAIT_BAR(0);
  DMA_K(3,0);DMA_V(1,SLOTB);
  ROT();
  kload8(kf,kp0+sl_cur);
  WAIT_BAR(2);
  s16x4 vlo[8],vhi[8]; u32x4 pw0,pw1,pw2,pw3;
  #define PKW(P,B) cvtpk_s(P[B],P[B+1])
  #define PAF(k) __builtin_bit_cast(bf16x8,pw##k)
  #define VFR(i) (bf16x8){vlo[i][0],vlo[i][1],vlo[i][2],vlo[i][3],vhi[i][0],vhi[i][1],vhi[i][2],vhi[i][3]}
  #define PIN(x) asm volatile("":"+v"(x))
  #define MX3(a,b,c) __builtin_fmaxf(__builtin_fmaxf((a),(b)),(c))
  #define GAPA(MF,A0,A1,A2,A3,W0,W1,PW) do{ MF; sacc+=A0; sacc+=A1; sacc+=A2; sacc+=A3; PIN(sacc); W0; W1; PIN(PW); SBAR(); }while(0)
  #define EX(v) __builtin_amdgcn_exp2f(v)
  #define GAPB(MF,X,B) do{ MF; X[B]=EX(X[B]); X[B+1]=EX(X[B+1]); X[B+2]=EX(X[B+2]); X[B+3]=EX(X[B+3]); PIN(X); SBAR(); }while(0)
  #define VRD(i) do{ vlo[i]=vtr(vp_+(((i)>>2)*4096+((i)&3)*1024)); vhi[i]=vtr(vp_+(((i)>>2)*4096+((i)&3)*1024+512)); }while(0)
  #define KRD(G,j) do{ if(G){ kload2(kf,kp0+sl_next,j); SBAR(); } }while(0)
  #define STEP(C0,C1,P0,P1,t,GK,GV,GL) do{ SBAR(); \
    const lds_cptr vp_=vp0+sl_prev; \
    VRD(0); SBAR(); float sacc=(P0[0]+P0[1]); \
    GAPA(C0=__builtin_amdgcn_mfma_f32_32x32x16_bf16(kf[0],qr[0],negm,0,0,0), P0[2],P0[3],P0[4],P0[5],     pw0[0]=PKW(P0,0), pw0[1]=PKW(P0,2), pw0); \
    VRD(4); SBAR(); GAPA(C1=__builtin_amdgcn_mfma_f32_32x32x16_bf16(kf[1],qr[0],negm,0,0,0), P0[6],P0[7],P0[8],P0[9],     pw0[2]=PKW(P0,4), pw0[3]=PKW(P0,6), pw0); \
    VRD(1); SBAR(); GAPA(C0=__builtin_amdgcn_mfma_f32_32x32x16_bf16(kf[2],qr[1],C0,0,0,0),   P0[10],P0[11],P0[12],P0[13], pw1[0]=PKW(P0,8), pw1[1]=PKW(P0,10), pw1); \
    VRD(5); SBAR(); GAPA(C1=__builtin_amdgcn_mfma_f32_32x32x16_bf16(kf[3],qr[1],C1,0,0,0),   P0[14],P0[15],P1[0],P1[1],   pw1[2]=PKW(P0,12),pw1[3]=PKW(P0,14), pw1); \
    VRD(2); SBAR(); GAPA(C0=__builtin_amdgcn_mfma_f32_32x32x16_bf16(kf[4],qr[2],C0,0,0,0),   P1[2],P1[3],P1[4],P1[5],     pw2[0]=PKW(P1,0), pw2[1]=PKW(P1,2), pw2); \
    VRD(6); SBAR(); GAPA(C1=__builtin_amdgcn_mfma_f32_32x32x16_bf16(kf[5],qr[2],C1,0,0,0),   P1[6],P1[7],P1[8],P1[9],     pw2[2]=PKW(P1,4), pw2[3]=PKW(P1,6), pw2); \
    VRD(3); SBAR(); GAPA(C0=__builtin_amdgcn_mfma_f32_32x32x16_bf16(kf[6],qr[3],C0,0,0,0),   P1[10],P1[11],P1[12],P1[13], pw3[0]=PKW(P1,8), pw3[1]=PKW(P1,10), pw3); \
    VRD(7); SBAR(); GAPA(C1=__builtin_amdgcn_mfma_f32_32x32x16_bf16(kf[7],qr[3],C1,0,0,0),   P1[14],P1[15],0.f,0.f,       pw3[2]=PKW(P1,12),pw3[3]=PKW(P1,14), pw3); \
    l_reg+=sacc; \
    if(GK){DMA_K((t)+3,sl_cur);} if(GV){DMA_V((t)+1,sl_next);} \
    CMASK(C0,C1,t); \
    { float a=MX3(C0[0],C0[1],C1[0]),b=MX3(C0[2],C0[3],C1[1]); a=MX3(a,C1[2],C1[3]); \
      _Pragma("unroll") for(int r=4;r<16;r+=4){a=MX3(a,C0[r],C0[r+1]);b=MX3(b,C0[r+2],C0[r+3]);a=MX3(a,C1[r],C1[r+1]);b=MX3(b,C1[r+2],C1[r+3]);} \
      float rm=__builtin_fmaxf(a,b); { auto rr=__builtin_amdgcn_permlane32_swap(__float_as_uint(rm),__float_as_uint(rm),false,false); rm=__builtin_fmaxf(__uint_as_float(rr[0]),__uint_as_float(rr[1])); } \
      resc=false; \
      if(__builtin_expect(__any(rm>(float)THRL),0)){ const float dl=__builtin_fmaxf(rm,0.f); mhat+=dl; \
        _Pragma("unroll") for(int r=0;r<16;++r){C0[r]-=dl;C1[r]-=dl;} \
        _Pragma("unroll") for(int r=0;r<16;++r)negm[r]=-mhat; asm volatile("":"+v"(negm)); \
        const float f=__builtin_amdgcn_exp2f(-dl); l_reg*=f; if(hi==0)wsf[r32]=f; resc=true; } } \
    SBAR(); \
    GAPB(o[0]=__builtin_amdgcn_mfma_f32_32x32x16_bf16(PAF(0),VFR(0),o[0],0,0,0), C0,0); \
    GAPB(o[1]=__builtin_amdgcn_mfma_f32_32x32x16_bf16(PAF(0),VFR(4),o[1],0,0,0), C0,4); \
    KRD(GL,0); GAPB(o[0]=__builtin_amdgcn_mfma_f32_32x32x16_bf16(PAF(1),VFR(1),o[0],0,0,0), C0,8); \
    KRD(GL,1); GAPB(o[1]=__builtin_amdgcn_mfma_f32_32x32x16_bf16(PAF(1),VFR(5),o[1],0,0,0), C0,12); \
    KRD(GL,2); GAPB(o[0]=__builtin_amdgcn_mfma_f32_32x32x16_bf16(PAF(2),VFR(2),o[0],0,0,0), C1,0); \
    KRD(GL,3); GAPB(o[1]=__builtin_amdgcn_mfma_f32_32x32x16_bf16(PAF(2),VFR(6),o[1],0,0,0), C1,4); \
    GAPB(o[0]=__builtin_amdgcn_mfma_f32_32x32x16_bf16(PAF(3),VFR(3),o[0],0,0,0), C1,8); \
    GAPB(o[1]=__builtin_amdgcn_mfma_f32_32x32x16_bf16(PAF(3),VFR(7),o[1],0,0,0), C1,12); \
    }while(0)
  int t=1;
  #undef CMASK
  #define CMASK(P0,P1,t) do{}while(0)
  for(;t+5<NT;t+=2){
    STEP(pB0,pB1,pA0,pA1,t,true,true,true);     WAIT_BAR(2); RESC(); ROT();
    STEP(pA0,pA1,pB0,pB1,t+1,true,true,true);   WAIT_BAR(2); RESC(); ROT();
  }
  #undef CMASK
  #define CMASK(P0,P1,t) do{}while(0)
  #define ENDW(tt) do{ if((tt)+3<NT){WAIT_BAR(2);} else if((tt)+2<NT){WAIT_BAR(1);} else {WAIT_BAR(0);} }while(0)
  for(;t+1<NT;t+=2){
    STEP(pB0,pB1,pA0,pA1,t,(t+3<NT),(t+1<NT),(t+1<NT));       ENDW(t);   RESC(); ROT();
    STEP(pA0,pA1,pB0,pB1,t+1,(t+4<NT),(t+2<NT),(t+2<NT));     ENDW(t+1); RESC(); ROT();
  }
  STEP(pB0,pB1,pA0,pA1,NT-1,false,false,false); RESC();
  { float sacc=pB0[0]+pB0[1]; _Pragma("unroll") for(int r=2;r<16;++r)sacc+=pB0[r]; _Pragma("unroll") for(int r=0;r<16;++r)sacc+=pB1[r]; l_reg+=sacc;
    pw0=(u32x4){PKW(pB0,0),PKW(pB0,2),PKW(pB0,4),PKW(pB0,6)};pw1=(u32x4){PKW(pB0,8),PKW(pB0,10),PKW(pB0,12),PKW(pB0,14)};pw2=(u32x4){PKW(pB1,0),PKW(pB1,2),PKW(pB1,4),PKW(pB1,6)};pw3=(u32x4){PKW(pB1,8),PKW(pB1,10),PKW(pB1,12),PKW(pB1,14)};
    SBAR(); pv(o,vb0+sl_cur,PAF(0),PAF(1),PAF(2),PAF(3)); }
  #undef PKW
  #undef PAF
  #undef VFR
  #undef PIN
  #undef MX3
  #undef GAPA
  #undef GAPB
  #undef EX
  #undef VRD
  #undef KRD
  #undef STEP
  #undef ENDW
  {auto rr=__builtin_amdgcn_permlane32_swap(__float_as_uint(l_reg),__float_as_uint(l_reg),false,false);l_reg=__uint_as_float(rr[0])+__uint_as_float(rr[1]);}
  if(hi==0)wsf[32+r32]=l_reg;asm volatile("s_waitcnt lgkmcnt(0)":::"memory");
  float rli[16];
  #pragma unroll
  for(int r=0;r<16;++r)rli[r]=__builtin_amdgcn_rcpf(wsf[32+crow(r,hi)]);
  bf16*Ow=O+(rowbase+q0+wid*QBLK)*OP+h*D;
  { bf16*stg=(bf16*)(shm+LDS_OST)+wid*2048;
    #pragma unroll
    for(int r=0;r<16;++r){const int orow=crow(r,hi);
      #pragma unroll
      for(int d0=0;d0<2;++d0)stg[orow*64+d0*32+r32]=__float2bfloat16(o[d0][r]*rli[r]);}
    asm volatile("s_waitcnt lgkmcnt(0)":::"memory");
    #pragma unroll
    for(int i=0;i<4;++i){const int row=i*8+(lane>>3),ch=lane&7; const u32x4 v=*(const u32x4*)(stg+row*64+ch*8); ATTN_STORE16(Ow+(long)row*OP+ch*8,v);} }
  asm volatile("s_waitcnt lgkmcnt(0)\n\ts_barrier":::"memory");
  #undef DMA_K
  #undef DMA_V
  #undef CMASK
  #undef START
  #undef RESC
  #undef ROT
}
constexpr int ATTN_LDS_BYTES=LDS_BYTES;
#undef SBAR
#undef WAIT_BAR
}

#define GAS __attribute__((address_space(1)))
#define LAS __attribute__((address_space(3)))
typedef unsigned short bf16;
typedef unsigned v4u __attribute__((ext_vector_type(4)));
typedef float f32x4 __attribute__((ext_vector_type(4)));
typedef short bf16x8 __attribute__((ext_vector_type(8)));
typedef GAS unsigned gu32;
typedef GAS unsigned long long gu64;
#define RLX_AGENT __ATOMIC_RELAXED, __HIP_MEMORY_SCOPE_AGENT
#define LDS_WAIT() asm volatile("s_waitcnt lgkmcnt(0)" ::: "memory")
#define VM_WAIT() asm volatile("s_waitcnt vmcnt(0)" ::: "memory")
__device__ __forceinline__ unsigned long long rt() { return __builtin_amdgcn_s_memrealtime(); }
__device__ __forceinline__ unsigned f2bf(float f) { unsigned u = __builtin_bit_cast(unsigned, f); return (u + 0x7fffu + ((u >> 16) & 1u)) >> 16; }
__device__ __forceinline__ unsigned pk2(float lo, float hi) { return f2bf(lo) | (f2bf(hi) << 16); }

#define XB_TMO      128
#define XB_XCNT(j)  (256  + 64 * (j))
#define XB_XSUB(j)  (1280 + 64 * (j))
#define XB_XGEN(j)  (2304 + 64 * (j))
#define XB_TOP      3328
#define XB_TOPGEN   3392
#define XCD_BAR_WORDS 3456
#define XB_SPIN_CAP (1u << 18)

__device__ __forceinline__ unsigned xb_ld(unsigned* p)              { return __hip_atomic_load(p, __ATOMIC_RELAXED, __HIP_MEMORY_SCOPE_AGENT); }
__device__ __forceinline__ unsigned xb_add(unsigned* p, unsigned v) { return __hip_atomic_fetch_add(p, v, __ATOMIC_RELAXED, __HIP_MEMORY_SCOPE_AGENT); }
__device__ __forceinline__ unsigned xb_xcc_id() { return (unsigned)__builtin_amdgcn_s_getreg((3 << 11) | 20) & 0xFu; }
#define XB_SPIN(cond, bar) do { unsigned _sp = 0; while (cond) { __builtin_amdgcn_s_sleep(1); \
    if ((++_sp & 255u) == 0u) { if (xb_ld(&(bar)[XB_TMO])) break; if (_sp > XB_SPIN_CAP) { atomicAdd(&(bar)[XB_TMO], 1u); break; } } } } while (0)

struct XcdBarrier {
    unsigned* bar; unsigned x;
    volatile LAS unsigned* st;
};

__device__ __forceinline__ XcdBarrier xcd_barrier_post(unsigned* bar, volatile LAS unsigned* st) {
    XcdBarrier b; b.bar = bar; b.x = xb_xcc_id(); b.st = st;
    if (threadIdx.x == 0) (void)xb_add(&bar[XB_XCNT(b.x)], 1u);
    return b;
}
__device__ __forceinline__ void xcd_barrier_complete(unsigned* bar, unsigned x, unsigned& nloc, unsigned& nx) {
    const unsigned G = gridDim.x * gridDim.y * gridDim.z;
    unsigned sum, cnt, mine, sp = 0u;
    for (;;) {
        sum = 0u; cnt = 0u; mine = 0u;
#pragma unroll
        for (unsigned j = 0; j < 16; ++j) { const unsigned c = xb_ld(&bar[XB_XCNT(j)]); sum += c; cnt += (c > 0u) ? 1u : 0u; mine = (j == x) ? c : mine; }
        if (sum == G) break;
        __builtin_amdgcn_s_sleep(1);
        if ((++sp & 255u) == 0u) { if (xb_ld(&bar[XB_TMO])) break; if (sp > XB_SPIN_CAP) { atomicAdd(&bar[XB_TMO], 1u); break; } }
    }
    nloc = mine > 0u ? mine : 1u; nx = cnt > 0u ? cnt : 1u;
}

__device__ __forceinline__ void xcd_barrier(const XcdBarrier& b) {
    asm volatile("s_waitcnt vmcnt(0)" ::: "memory");
    __syncthreads();
    if (threadIdx.x == 0) {
        unsigned* bar = b.bar;
        __builtin_amdgcn_s_waitcnt(0);
        unsigned nloc = b.st[0], nx = b.st[1];
        if (nloc == 0u) { xcd_barrier_complete(bar, b.x, nloc, nx); b.st[0] = nloc; b.st[1] = nx; }
        const unsigned old = xb_add(&bar[XB_XSUB(b.x)], 1u);
        const unsigned gen = old / nloc;
        if (old + 1u == (gen + 1u) * nloc) {
            __builtin_amdgcn_fence(__ATOMIC_RELEASE, "agent");
            asm volatile("s_waitcnt vmcnt(0)" ::: "memory");
            const unsigned og = xb_add(&bar[XB_TOP], 1u);
            const unsigned tg = og / nx;
            if (og + 1u == (tg + 1u) * nx) xb_add(&bar[XB_TOPGEN], 1u);
            else XB_SPIN(xb_ld(&bar[XB_TOPGEN]) == tg, bar);
            __builtin_amdgcn_fence(__ATOMIC_ACQUIRE, "agent");
            xb_add(&bar[XB_XGEN(b.x)], 1u);
            asm volatile("s_waitcnt vmcnt(0)" ::: "memory");
        } else {
            XB_SPIN(xb_ld(&bar[XB_XGEN(b.x)]) == gen, bar);
            __builtin_amdgcn_fence(__ATOMIC_ACQUIRE, "agent");
            asm volatile("s_waitcnt vmcnt(0)" ::: "memory");
        }
    }
    __syncthreads();
}

__device__ __forceinline__ float bf2f(unsigned short h) { return __builtin_bit_cast(float, (unsigned)h << 16); }
__device__ __forceinline__ float bflo(unsigned w) { return __builtin_bit_cast(float, w << 16); }
__device__ __forceinline__ float bfhi(unsigned w) { return __builtin_bit_cast(float, w & 0xffff0000u); }
__device__ __forceinline__ float wave_sum(float v) {
    v += __builtin_bit_cast(float, __builtin_amdgcn_update_dpp(0, __builtin_bit_cast(int, v), 0xB1, 0xf, 0xf, false));
    v += __builtin_bit_cast(float, __builtin_amdgcn_update_dpp(0, __builtin_bit_cast(int, v), 0x4E, 0xf, 0xf, false));
    v += __builtin_bit_cast(float, __builtin_amdgcn_update_dpp(0, __builtin_bit_cast(int, v), 0x141, 0xf, 0xf, false));
    v += __builtin_bit_cast(float, __builtin_amdgcn_update_dpp(0, __builtin_bit_cast(int, v), 0x140, 0xf, 0xf, false));
    v += __builtin_bit_cast(float, __builtin_amdgcn_update_dpp(0, __builtin_bit_cast(int, v), 0x142, 0xa, 0xf, false));
    v += __builtin_bit_cast(float, __builtin_amdgcn_update_dpp(0, __builtin_bit_cast(int, v), 0x143, 0xc, 0xf, false));
    return __builtin_bit_cast(float, __builtin_amdgcn_readlane(__builtin_bit_cast(int, v), 63));
}
__device__ __forceinline__ float sigmoidf_(float x) { return __builtin_amdgcn_rcpf(1.0f + __expf(-x)); }
typedef float f32x16 __attribute__((ext_vector_type(16)));

struct Frame {
    LAS unsigned char* lds;
    volatile LAS unsigned* MISC;
    unsigned char* ws;
    int tid, lane, wave, vcu, G;
};
struct TrItem { const float* W; bf16* WT; int ldw, k0, sc0, ldt, dr0; };
__device__ __forceinline__ void p0_tr_load(const TrItem& q, int lane, f32x4 (&t)[8]) {
#pragma unroll
    for (int i = 0; i < 8; ++i) t[i] = *(const f32x4*)(q.W + (size_t)(q.k0 + 8 * (lane >> 3) + i) * q.ldw + q.sc0 + 4 * (lane & 7));
}
__device__ __forceinline__ void p0_tr_finish(const TrItem& q, const f32x4 (&t)[8], LAS float* scr, int lane) {
#pragma unroll
    for (int e = 0; e < 4; ++e) { v4u o; o.x = pk2(t[0][e], t[1][e]); o.y = pk2(t[2][e], t[3][e]); o.z = pk2(t[4][e], t[5][e]); o.w = pk2(t[6][e], t[7][e]);
        *(GAS v4u*)(q.WT + (size_t)(q.dr0 + 4 * (lane & 7) + e) * q.ldt + q.k0 + 8 * (lane >> 3)) = o; }
}
__device__ __forceinline__ void s0_prologue(Frame& F) {
    LAS float* scr = (LAS float*)(F.lds + RING_OFF + F.wave * 16384);
    const int gw = F.vcu * NWAVES + F.wave, NGW = F.G * NWAVES, lane = F.lane;
    unsigned char* ws = F.ws;
    {
        float* modpart = (float*)(ws + SM_MODPART);
        for (int it = gw; it < DEPTH * 16 * 24; it += NGW) {
            const int l = it / (16 * 24), kc = (it / 24) % 16, jb = it % 24, j0 = jb * 256 + 4 * lane, k0 = kc * 64;
            const float c0 = inptr(F.lds, IN_C)[k0 + lane], c1 = inptr(F.lds, IN_C)[1024 + k0 + lane], c2 = inptr(F.lds, IN_CCTX)[k0 + lane];
            const float s0 = c0 * sigmoidf_(c0), s1 = c1 * sigmoidf_(c1), s2 = c2 * sigmoidf_(c2);
            f32x4 a0 = {0.f, 0.f, 0.f, 0.f}, a1 = a0, a2 = a0;
            const float* wp = inptr(F.lds, IN_WMOD) + ((size_t)l * 1024 + k0) * 6144 + j0;
#pragma unroll 16
            for (int kk = 0; kk < 64; ++kk) { const f32x4 w = *(const f32x4*)(wp + (size_t)kk * 6144);
                a0 += w * __shfl(s0, kk); a1 += w * __shfl(s1, kk); a2 += w * __shfl(s2, kk); }
            float* mp = modpart + ((size_t)(l * 16 + kc) * 3) * 6144 + j0;
            *(f32x4*)mp = a0; *(f32x4*)(mp + 6144) = a1; *(f32x4*)(mp + 2 * 6144) = a2;
        }
    }
    {
        constexpr int I_WINA = 16 * 16, I_WINB = 24 * 16, I_WFI = 176 * 16, I_WFO = 32 * 44, I_WO = 32 * 4, I_L = I_WINA + I_WINB + I_WFI + I_WFO + I_WO;
        auto decode = [&](int it) { TrItem q;
            const int l = it / I_L; int r = it % I_L;
            bf16* WinT = (bf16*)(ws + WS_WIN + l * WIN_STRIDE); bf16* WoT = (bf16*)(ws + WS_WO + l * WO_STRIDE);
            bf16* WfiT = (bf16*)(ws + WS_WFI + l * WFI_STRIDE); bf16* WfoT = (bf16*)(ws + WS_WFO + l * WFO_STRIDE);
            const float* w_in = inptr(F.lds, IN_WIN) + (size_t)l * 1024 * DIN0;
            if (r < I_WINA) { const int kb = r / 16, nb = r % 16; q = TrItem{w_in, WinT, DIN0, 64 * kb, 32 * nb, 1024, (nb >> 3) * 256 + (nb & 1) * 128 + ((nb >> 1) & 3) * 32}; return q; } r -= I_WINA;
            if (r < I_WINB) { const int kb = r / 24, nb = r % 24; q = TrItem{w_in, WinT, DIN0, 64 * kb, 768 + 32 * nb, 1024, 1024 + 32 * nb}; return q; } r -= I_WINB;
            if (r < I_WFI) { const int kb = r / 176, nb = r % 176, d0 = 32 * nb, pn = d0 >> 8, hb = (d0 >> 7) & 1, i0 = d0 & 127;
                q = TrItem{inptr(F.lds, IN_WFI) + (size_t)l * 1024 * 2 * DFF, WfiT, 2 * DFF, 64 * kb, hb * DFF + 128 * pn + i0, 1024, d0}; return q; } r -= I_WFI;
            if (r < I_WFO) { const int kb = r / 32, nb = r % 32; q = TrItem{inptr(F.lds, IN_WFO) + (size_t)l * DFF * 1024, WfoT, 1024, 64 * kb, 32 * nb, DFF, 32 * nb}; return q; } r -= I_WFO;
            { const int kb = r / 32, nb = r % 32; q = TrItem{inptr(F.lds, IN_WO) + (size_t)l * 1024 * 1024, WoT, 1024, 64 * kb, 32 * nb, 1024, 32 * nb}; return q; } };
        const int gA = (3 * NGW) / 8, gB = (5 * NGW) / 8, NIT = DEPTH * I_L, cut = (NIT * 10) / 13;
        const int t_lo = gw < gA ? gw : (gw < gB ? cut + (gw - gA) : NIT), t_hi = gw < gA ? cut : NIT, t_st = gw < gA ? gA : gB - gA;
        for (int it = t_lo; it < t_hi; it += 2 * t_st) {
            const bool two = it + t_st < t_hi;
            const TrItem qa = decode(it), qb = decode(two ? it + t_st : it);
            f32x4 ta[8], tb[8];
            p0_tr_load(qa, lane, ta); if (two) p0_tr_load(qb, lane, tb);
            p0_tr_finish(qa, ta, scr, lane);
            if (two) p0_tr_finish(qb, tb, scr, lane);
        }
    }
    {
        LAS float* tab = scr;
        { float sn, cs; sincospif((float)lane * (1.0f / 32.0f), &sn, &cs); tab[lane] = cs; tab[64 + lane] = sn; }
        LDS_WAIT(); asm volatile("" ::: "memory");
        if (gw >= (3 * NGW) / 8 && gw < (5 * NGW) / 8) for (int it = gw - (3 * NGW) / 8; it < DEPTH * 256; it += (5 * NGW) / 8 - (3 * NGW) / 8) {
            const int l = it / 256, kb = (it / 16) % 16, h = (it / 4) % 4, cq = it % 4, k = kb * 64 + lane;
            const float* src = inptr(F.lds, IN_WIN) + ((size_t)l * 1024 + k) * DIN0 + 512 + h * 64;
            float u[64];
#pragma unroll
            for (int c = 0; c < 16; ++c) { const f32x4 t = *(const f32x4*)(src + 4 * c); u[4 * c] = t[0]; u[4 * c + 1] = t[1]; u[4 * c + 2] = t[2]; u[4 * c + 3] = t[3]; }
            bf16* WinT = (bf16*)(ws + WS_WIN + l * WIN_STRIDE);
            for (int cp = 16 * cq; cp < 16 * cq + 16; ++cp) { float ar = 0.f, ai = 0.f;
#pragma unroll
                for (int c = 0; c < 64; ++c) { const int j = (c * cp) & 63; ar += u[c] * tab[j]; ai -= u[c] * tab[64 + j]; }
                WinT[(size_t)(512 + h * 64 + cp) * 1024 + k] = (bf16)f2bf(ar); WinT[(size_t)(768 + h * 64 + cp) * 1024 + k] = (bf16)f2bf(ai); }
        }
        LDS_WAIT(); asm volatile("" ::: "memory");
    }
    if (gw >= (5 * NGW) / 8) for (int it = gw - (5 * NGW) / 8; it < DEPTH * 96 * 4; it += NGW - (5 * NGW) / 8) {
        const int l = it / (96 * 4), ib = (it / 4) % 96, nb = it % 4, i0 = ib * 8, n0 = nb * 256 + 4 * lane;
        const int br = i0 >> 8;
        const float* wo = inptr(F.lds, IN_WO) + (size_t)l * 1024 * 1024;
        f32x4 acc[8];
#pragma unroll
        for (int q = 0; q < 8; ++q) acc[q] = (f32x4){0.f, 0.f, 0.f, 0.f};
        if (br < 2) { const float* wx = (br == 0 ? inptr(F.lds, IN_WF) : inptr(F.lds, IN_WPW)) + (size_t)l * 65536 + (size_t)(i0 & 255) * 256;
#pragma unroll
            for (int q = 0; q < 8; ++q) *(LAS f32x4*)(scr + q * 256 + 4 * lane) = *(const f32x4*)(wx + q * 256 + 4 * lane);
            LDS_WAIT(); asm volatile("" ::: "memory");
            const float* wrow = wo + (size_t)(256 + br * 256) * 1024 + n0;
#pragma unroll 2
            for (int j = 0; j < 256; j += 4) { f32x4 w[4];
#pragma unroll
                for (int e = 0; e < 4; ++e) w[e] = *(const f32x4*)(wrow + (size_t)(j + e) * 1024);
#pragma unroll
                for (int q = 0; q < 8; ++q) { const f32x4 x = *(const LAS f32x4*)(scr + q * 256 + j); acc[q] += w[0] * x[0]; acc[q] += w[1] * x[1]; acc[q] += w[2] * x[2]; acc[q] += w[3] * x[3]; } }
        } else { const int g = (i0 - 512) >> 6, c0 = (i0 - 512) & 63;
            const float* wx = inptr(F.lds, IN_WPL) + (size_t)l * 4 * 4096 + (size_t)g * 4096 + (size_t)c0 * 64; const float* ps = inptr(F.lds, IN_PLS) + l * 256 + g * 64;
            { const float sv = ps[lane];
#pragma unroll
              for (int q = 0; q < 8; ++q) scr[q * 64 + lane] = wx[q * 64 + lane] * sv; }
            LDS_WAIT(); asm volatile("" ::: "memory");
            const float* wrow = wo + (size_t)(768 + g * 64) * 1024 + n0;
#pragma unroll 2
            for (int j = 0; j < 64; j += 4) { f32x4 w[4];
#pragma unroll
                for (int e = 0; e < 4; ++e) w[e] = *(const f32x4*)(wrow + (size_t)(j + e) * 1024);
#pragma unroll
                for (int q = 0; q < 8; ++q) { const f32x4 x = *(const LAS f32x4*)(scr + q * 64 + j); acc[q] += w[0] * x[0]; acc[q] += w[1] * x[1]; acc[q] += w[2] * x[2]; acc[q] += w[3] * x[3]; } }
        }
        LDS_WAIT(); asm volatile("" ::: "memory");
        bf16* WoT = (bf16*)(ws + WS_WO + l * WO_STRIDE);
#pragma unroll
        for (int e = 0; e < 4; ++e) { v4u o; o.x = pk2(acc[0][e], acc[1][e]); o.y = pk2(acc[2][e], acc[3][e]); o.z = pk2(acc[4][e], acc[5][e]); o.w = pk2(acc[6][e], acc[7][e]);
            *(GAS v4u*)(WoT + (size_t)(n0 + e) * 1024 + 256 + i0) = o; }
    }
    {
        const int gt = (F.vcu * NWAVES + F.wave) * 64 + lane, NGT = NGW * 64;
        float* rope = (float*)(ws + SM_ROPE); float* tw = (float*)(ws + SM_TW);
        bf16* M1 = (bf16*)(ws + SM_M1); bf16* M2 = (bf16*)(ws + SM_M2); bf16* M3 = (bf16*)(ws + SM_M3);
        for (int i = gt; i < 128 * 16; i += NGT) { const int p = i >> 4, f = i & 15; const float inv = powf(10000.0f, -(float)f * (1.0f / 16.0f)); const float a = (float)p * inv;
            rope[2 * i] = cosf(a); rope[2 * i + 1] = sinf(a); }
        for (int i = gt; i < 8192; i += NGT) { float sn, cs; sincospif((float)i * (1.0f / 4096.0f), &sn, &cs); tw[2 * i] = cs; tw[2 * i + 1] = sn; }
        for (int i = gt; i < 2 * 128 * 128; i += NGT) { const int sel = i >> 14, k1 = (i >> 7) & 127, t1 = i & 127;
            float sn, cs; sincospif((float)((k1 * t1) & 127) * (1.0f / 64.0f), &sn, &cs); M1[i] = (bf16)f2bf(sel ? sn : cs); }
        for (int i = gt; i < 64 * 128; i += NGT) { const int k2 = i >> 7, k = i & 127, t2 = k >> 1, ri = k & 1;
            float sn, cs; sincospif((float)((k2 * t2) & 63) * (1.0f / 32.0f), &sn, &cs); M2[i] = (bf16)f2bf(ri ? sn : cs); }
        for (int i = gt; i < 256 * 512; i += NGT) { const int kq = i >> 9, k = i & 511, ri = k >> 8, t = k & 255;
            float sn, cs; sincospif((float)((kq * t) & 255) * (1.0f / 128.0f), &sn, &cs); M3[i] = (bf16)f2bf(ri ? sn : cs); }
    }
}
__device__ __forceinline__ void s0b_modsum(Frame& F) {
    const int gt = (F.vcu * NWAVES + F.wave) * 64 + F.lane, NGT = F.G * NWAVES * 64;
    const float* modpart = (const float*)(F.ws + SM_MODPART); float* mod = (float*)(F.ws + WS_CTL + CTL_MOD); const float* bm = inptr(F.lds, IN_BMOD);
    for (int i = gt; i < DEPTH * 3 * 6144; i += NGT) { const int l = i / (3 * 6144), v = (i / 6144) % 3, j = i % 6144; float s = bm[l * 6144 + j];
#pragma unroll
        for (int kc = 0; kc < 16; ++kc) s += modpart[((size_t)(l * 16 + kc) * 3 + v) * 6144 + j];
        mod[i] = s; }
}
__device__ __forceinline__ void s1_prologue(Frame& F) {
    const int gw = F.vcu * NWAVES + F.wave, NGW = F.G * NWAVES, lane = F.lane;
    unsigned char* ws = F.ws;
    const float* mod = (const float*)(ws + WS_CTL + CTL_MOD);
    {
        bf16* ACT = (bf16*)(ws + WS_ACT); float* rss = (float*)(ws + WS_RPART);
        auto xptr = [&](int r) { const int b = r / SPB, rr = r % SPB; return rr < CTXL ? inptr(F.lds, IN_CTX) + ((size_t)b * CTXL + rr) * DM : inptr(F.lds, IN_X) + ((size_t)b * SEQ + rr - CTXL) * DM; };
        f32x4 xv[4], xn[4];
#pragma unroll
        for (int j = 0; j < 4; ++j) xv[j] = (f32x4){0.f, 0.f, 0.f, 0.f};
        if (gw < R) { const float* xrow = xptr(gw);
#pragma unroll
            for (int j = 0; j < 4; ++j) xv[j] = *(const f32x4*)(xrow + 4 * lane + 256 * j); }
        const float* g1p = inptr(F.lds, IN_G1);
        for (int r = gw; r < R; r += NGW) {
            const int b = r / SPB, rr = r % SPB, v = rr < CTXL ? 2 : b;
#pragma unroll
            for (int j = 0; j < 4; ++j) xn[j] = xv[j];
            if (r + NGW < R) { const float* xrow = xptr(r + NGW);
#pragma unroll
                for (int j = 0; j < 4; ++j) xn[j] = *(const f32x4*)(xrow + 4 * lane + 256 * j); }
            float s = 0.f; unsigned long long o[4];
#pragma unroll
            for (int j = 0; j < 4; ++j) { const int c = 4 * lane + 256 * j; const f32x4 x = xv[j];
                const f32x4 g = *(const f32x4*)(g1p + c) * (*(const f32x4*)(mod + v * 6144 + 1024 + c) + 1.0f);
                s += (x[0] * x[0] + x[1] * x[1]) + (x[2] * x[2] + x[3] * x[3]); const f32x4 a = x * g;
                o[j] = (unsigned long long)pk2(a[0], a[1]) | ((unsigned long long)pk2(a[2], a[3]) << 32); }
            s = wave_sum(s);
#pragma unroll
            for (int j = 0; j < 4; ++j) *(unsigned long long*)(ACT + (size_t)r * DM + 4 * lane + 256 * j) = o[j];
            if (lane < 16) rss[(size_t)r * 16 + lane] = lane == 0 ? s : 0.f;
#pragma unroll
            for (int j = 0; j < 4; ++j) xv[j] = xn[j];
        }
    }
#pragma unroll 1
    for (int grp = 0; grp < 2 * DEPTH; ++grp) {
        const int l = grp >> 1; const bool isin = (grp & 1) == 0; const int ncol = isin ? NIN : 2 * DFF;
        const float* sh = mod + (size_t)l * 3 * 6144 + (isin ? 0 : 3072);
        f32x4 sv[3][4];
#pragma unroll
        for (int v = 0; v < 3; ++v)
#pragma unroll
            for (int j = 0; j < 2; ++j) { sv[v][2 * j] = *(const f32x4*)(sh + v * 6144 + 8 * lane + 512 * j); sv[v][2 * j + 1] = *(const f32x4*)(sh + v * 6144 + 8 * lane + 512 * j + 4); }
        const bf16* wbase = isin ? (const bf16*)(ws + WS_WIN + l * WIN_STRIDE) : (const bf16*)(ws + WS_WFI + l * WFI_STRIDE);
        float* dst = isin ? (float*)(ws + SM_BIN) + (size_t)l * 3 * NIN : (float*)(ws + SM_BFF) + (size_t)l * 3 * 2 * DFF;
        for (int n0 = gw; n0 < ncol; n0 += 4 * NGW) {
            v4u w[4][2];
#pragma unroll
            for (int u = 0; u < 4; ++u) { const int n = n0 + u * NGW;
#pragma unroll
                for (int j = 0; j < 2; ++j) { w[u][j] = (v4u){0u, 0u, 0u, 0u}; if (n < ncol) w[u][j] = *(const GAS v4u*)(wbase + (size_t)n * 1024 + 8 * lane + 512 * j); } }
#pragma unroll
            for (int u = 0; u < 4; ++u) { const int n = n0 + u * NGW;
                if (n < ncol) { float a[3] = {0.f, 0.f, 0.f};
#pragma unroll
                    for (int j = 0; j < 2; ++j) { const v4u ww = w[u][j];
                        const f32x4 lo = {bflo(ww.x), bfhi(ww.x), bflo(ww.y), bfhi(ww.y)}, hi = {bflo(ww.z), bfhi(ww.z), bflo(ww.w), bfhi(ww.w)};
#pragma unroll
                        for (int v = 0; v < 3; ++v) { const f32x4 p = lo * sv[v][2 * j] + hi * sv[v][2 * j + 1]; a[v] += (p[0] + p[1]) + (p[2] + p[3]); } }
                    const float r0 = wave_sum(a[0]), r1 = wave_sum(a[1]), r2 = wave_sum(a[2]);
                    if (lane == 0) { dst[n] = r0; dst[ncol + n] = r1; dst[2 * ncol + n] = r2; } } }
        }
    }
}
__device__ __forceinline__ void unpack8(const v4u w, float (&x)[8]) { x[0] = bflo(w.x); x[1] = bfhi(w.x); x[2] = bflo(w.y); x[3] = bfhi(w.y); x[4] = bflo(w.z); x[5] = bfhi(w.z); x[6] = bflo(w.w); x[7] = bfhi(w.w); }
__device__ __forceinline__ void p2_qkv(Frame& F, int l) {
    const int gw = F.vcu * NWAVES + F.wave, NGW = F.G * NWAVES, lane = F.lane;
    unsigned char* ws = F.ws;
    const bf16* P = (const bf16*)(ws + WS_P); bf16* Q = (bf16*)(ws + WS_Q); bf16* K = (bf16*)(ws + WS_K); bf16* V = (bf16*)(ws + WS_V);
    const float* rope = (const float*)(ws + SM_ROPE);
    const int head = lane >> 3, sub = lane & 7;
    float g[8];
#pragma unroll
    for (int j = 0; j < 8; ++j) g[j] = head < 4 ? inptr(F.lds, IN_QG)[l * 64 + sub * 8 + j] * QSCALE : (head < 6 ? inptr(F.lds, IN_KG)[l * 64 + sub * 8 + j] : 1.0f);
    auto fetch = [&](int rr_, v4u& w, f32x4& c0, f32x4& c1) {
        w = *(const GAS v4u*)(P + (size_t)rr_ * NIN + lane * 8);
        const int rr = rr_ % SPB; const int t = rr >= CTXL ? rr - CTXL : 0; const int pos = sub < 4 ? (t >> 6) : (t & 63);
        const float* cs = rope + ((size_t)pos * 16 + (sub & 3) * 4) * 2; c0 = *(const f32x4*)cs; c1 = *(const f32x4*)(cs + 4); };
    auto process = [&](int r, const v4u raw, const f32x4 cs0, const f32x4 cs1) {
        const int rr = r % SPB;
        float x[8]; unpack8(raw, x);
        if (head < 6) {
            float ss = 0.f;
#pragma unroll
            for (int j = 0; j < 8; ++j) ss += x[j] * x[j];
            ss += __shfl_xor(ss, 1); ss += __shfl_xor(ss, 2); ss += __shfl_xor(ss, 4);
            const float rs = rsqrtf(ss * (1.0f / 64.0f) + EPS);
#pragma unroll
            for (int j = 0; j < 8; ++j) x[j] = x[j] * rs * g[j];
            if (rr >= CTXL) { const float cc[4] = {cs0[0], cs0[2], cs1[0], cs1[2]}, sn[4] = {cs0[1], cs0[3], cs1[1], cs1[3]};
#pragma unroll
                for (int p = 0; p < 4; ++p) { const float x0 = x[2 * p], x1 = x[2 * p + 1]; x[2 * p] = x0 * cc[p] - x1 * sn[p]; x[2 * p + 1] = x0 * sn[p] + x1 * cc[p]; } }
        }
        v4u o; o.x = pk2(x[0], x[1]); o.y = pk2(x[2], x[3]); o.z = pk2(x[4], x[5]); o.w = pk2(x[6], x[7]);
        bf16* dst = head < 4 ? Q + (size_t)r * 256 + lane * 8 : (head < 6 ? K + (size_t)r * 128 + (lane - 32) * 8 : V + (size_t)r * 128 + (lane - 48) * 8);
        *(GAS v4u*)dst = o; };
    v4u raw[4], rawn[4]; f32x4 c0[4], c1[4], c0n[4], c1n[4];
#pragma unroll
    for (int q = 0; q < 4; ++q) { raw[q] = (v4u){0u, 0u, 0u, 0u}; c0[q] = (f32x4){1.f, 0.f, 1.f, 0.f}; c1[q] = c0[q]; const int r = gw + q * NGW; if (r < R) fetch(r, raw[q], c0[q], c1[q]); }
    for (int rb = gw; rb < R; rb += 4 * NGW) {
#pragma unroll
        for (int q = 0; q < 4; ++q) { rawn[q] = raw[q]; c0n[q] = c0[q]; c1n[q] = c1[q]; const int r = rb + (4 + q) * NGW; if (r < R) fetch(r, rawn[q], c0n[q], c1n[q]); }
#pragma unroll
        for (int q = 0; q < 4; ++q) { const int r = rb + q * NGW; if (r < R) process(r, raw[q], c0[q], c1[q]); }
#pragma unroll
        for (int q = 0; q < 4; ++q) { raw[q] = rawn[q]; c0[q] = c0n[q]; c1[q] = c1n[q]; }
    }
}
template <int TPW  > __device__ __forceinline__ void p2_convpool_unit(Frame& F, int l, const int r0) {
    constexpr int NT = 8 * TPW, CR = NT + 30, PR = NT + 16, CI = (CR * 32 + 511) / 512, PI = (PR * 32) / 512; static_assert((PR * 32) % 512 == 0, "pool fill");
    unsigned char* ws = F.ws; const int tid = F.tid, lane = F.lane, w = F.wave;
    const bf16* P = (const bf16*)(ws + WS_P); bf16* MIX = (bf16*)(ws + WS_MIX);
    LAS float* buf = (LAS float*)(F.lds + RING_OFF);
    LAS float* pbuf = buf + CR * 256;
    const int b = r0 / SPB, rr0 = r0 % SPB;
    const int seq_lo = rr0 < CTXL ? b * SPB : b * SPB + CTXL, seq_hi = rr0 < CTXL ? b * SPB + CTXL : (b + 1) * SPB;
    v4u a8[CI], g8[CI], p8[PI];
#pragma unroll
    for (int it = 0; it < CI; ++it) { const int idx = tid + it * 512, ri = idx >> 5, cg = idx & 31, r = r0 - 15 + ri;
        a8[it] = (v4u){0u, 0u, 0u, 0u}; g8[it] = a8[it];
        if (idx < CR * 32 && r >= seq_lo && r < seq_hi) { a8[it] = *(const GAS v4u*)(P + (size_t)r * NIN + 1024 + cg * 8); g8[it] = *(const GAS v4u*)(P + (size_t)r * NIN + 1280 + cg * 8); } }
#pragma unroll
    for (int it = 0; it < PI; ++it) { const int idx = tid + it * 512, ri = idx >> 5, cg = idx & 31, r = r0 - 8 + ri;
        p8[it] = (v4u){0u, 0u, 0u, 0u};
        if (r >= seq_lo && r < seq_hi) p8[it] = *(const GAS v4u*)(P + (size_t)r * NIN + 1536 + cg * 8); }
#pragma unroll
    for (int it = 0; it < CI; ++it) { const int idx = tid + it * 512, ri = idx >> 5, cg = idx & 31;
        if (idx < CR * 32) { float a[8], g[8]; unpack8(a8[it], a); unpack8(g8[it], g);
            *(LAS f32x4*)(buf + ri * 256 + cg * 8) = (f32x4){a[0] * sigmoidf_(g[0]), a[1] * sigmoidf_(g[1]), a[2] * sigmoidf_(g[2]), a[3] * sigmoidf_(g[3])};
            *(LAS f32x4*)(buf + ri * 256 + cg * 8 + 4) = (f32x4){a[4] * sigmoidf_(g[4]), a[5] * sigmoidf_(g[5]), a[6] * sigmoidf_(g[6]), a[7] * sigmoidf_(g[7])}; } }
#pragma unroll
    for (int it = 0; it < PI; ++it) { const int idx = tid + it * 512, ri = idx >> 5, cg = idx & 31; *(LAS v4u*)((LAS unsigned char*)pbuf + (ri * 256 + cg * 8) * 2) = p8[it]; }
    const float* dww = inptr(F.lds, IN_DWW) + (size_t)l * 31 * 256 + 4 * lane;
    f32x4 wt[31];
#pragma unroll
    for (int j = 0; j < 31; ++j) wt[j] = *(const f32x4*)(dww + j * 256);
    const f32x4 bias = *(const f32x4*)(inptr(F.lds, IN_DWB) + l * 256 + 4 * lane);
    const f32x4 lng = *(const f32x4*)(inptr(F.lds, IN_LNG) + l * 256 + 4 * lane), lnb = *(const f32x4*)(inptr(F.lds, IN_LNB) + l * 256 + 4 * lane);
    __syncthreads();
    {
        f32x4 acc[TPW];
#pragma unroll
        for (int o = 0; o < TPW; ++o) acc[o] = bias;
#pragma unroll
        for (int i = 0; i < TPW + 30; ++i) { const f32x4 v = *(const LAS f32x4*)(buf + (w * TPW + i) * 256 + 4 * lane);
#pragma unroll
            for (int o = 0; o < TPW; ++o) { const int j = i - o; if (j >= 0 && j < 31) acc[o] += v * wt[j]; } }
#pragma unroll
        for (int o = 0; o < TPW; ++o) { const f32x4 a = acc[o];
            const float mean = wave_sum((a[0] + a[1]) + (a[2] + a[3])) * (1.0f / 256.0f); const f32x4 d = a - mean;
            const float var = wave_sum((d[0] * d[0] + d[1] * d[1]) + (d[2] * d[2] + d[3] * d[3])) * (1.0f / 256.0f);
            f32x4 y = d * rsqrtf(var + EPS) * lng + lnb;
#pragma unroll
            for (int q = 0; q < 4; ++q) y[q] = y[q] * sigmoidf_(y[q]);
            *(unsigned long long*)(MIX + (size_t)(r0 + w * TPW + o) * 1024 + 512 + 4 * lane) = (unsigned long long)pk2(y[0], y[1]) | ((unsigned long long)pk2(y[2], y[3]) << 32); }
    }
    {
        const LAS unsigned char* pb = (const LAS unsigned char*)pbuf;
        const int win = 2 << (lane >> 4), half = win >> 1;
#pragma unroll
        for (int o = 0; o < TPW; ++o) { const int t = r0 + w * TPW + o;
            int lo = t - half, hi = t - half + win; lo = lo < seq_lo ? seq_lo : lo; hi = hi > seq_hi ? seq_hi : hi;
            f32x4 s = {0.f, 0.f, 0.f, 0.f};
#pragma unroll
            for (int j = 0; j < 16; ++j) { if (j < win) { const u32x2_t q = *(const LAS u32x2_t*)(pb + ((t - half + j - r0 + 8) * 256 + 4 * lane) * 2); s += (f32x4){bflo(q.x), bfhi(q.x), bflo(q.y), bfhi(q.y)}; } }
            const u32x2_t q = *(const LAS u32x2_t*)(pb + ((t - r0 + 8) * 256 + 4 * lane) * 2); const f32x4 self = {bflo(q.x), bfhi(q.x), bflo(q.y), bfhi(q.y)};
            const f32x4 y = s * (1.0f / (float)(hi - lo)) - self;
            *(unsigned long long*)(MIX + (size_t)t * 1024 + 768 + 4 * lane) = (unsigned long long)pk2(y[0], y[1]) | ((unsigned long long)pk2(y[2], y[3]) << 32); }
    }
    __syncthreads();
}
#define MFMA32(a, b, c) __builtin_amdgcn_mfma_f32_32x32x16_bf16(a, b, c, 0, 0, 0)
__device__ __forceinline__ void tr8x8(const v4u (&in)[8], v4u (&out)[8]) {
#pragma unroll
    for (int j = 0; j < 8; ++j) {
        unsigned d[4];
#pragma unroll
        for (int m = 0; m < 4; ++m) { const unsigned a = in[2 * m][j >> 1], b = in[2 * m + 1][j >> 1]; d[m] = (j & 1) ? ((a >> 16) | (b & 0xffff0000u)) : ((a & 0xffffu) | (b << 16)); }
        out[j] = (v4u){d[0], d[1], d[2], d[3]}; }
}
constexpr int F1_ZT = 0, F1_C = 67584, F1_S = F1_C + 34816, F1_END = F1_S + 34816;
static_assert(F1_END <= LDSCTL_OFF, "f1 LDS");
__device__ __forceinline__ void f1_unit(Frame& F, int unit) {
    unsigned char* ws = F.ws; const int tid = F.tid, lane = F.lane, w = F.wave, r = lane & 31, h = lane >> 5;
    const int b = unit >> 7, t2 = (unit >> 1) & 63, ch = unit & 1;
    const bf16* P = (const bf16*)(ws + WS_P); bf16* GP = (bf16*)(ws + WS_GP); const bf16* CS = (const bf16*)(ws + SM_M1); const float* tw = (const float*)(ws + SM_TW);
    LAS bf16* ZT = (LAS bf16*)(F.lds + F1_ZT); LAS bf16* Cl = (LAS bf16*)(F.lds + F1_C);
    const int nt = w & 3, mh = w >> 2;
    {
        const int kb = tid >> 4, pc = tid & 15, ri = kb >> 4;
        v4u in[8], out[8], tb[8];
#pragma unroll
        for (int i = 0; i < 8; ++i) { const int t1 = (kb * 8 + i) & 127; const size_t row = (size_t)b * SPB + CTXL + t1 * 64 + t2;
            in[i] = *(const GAS v4u*)(P + row * NIN + 512 + ri * 256 + ch * 128 + pc * 8); }
#pragma unroll
        for (int i = 0; i < 8; ++i) tb[i] = *(const GAS v4u*)(CS + (size_t)(tid + i * 512) * 8);
        tr8x8(in, out);
#pragma unroll
        for (int j = 0; j < 8; ++j) *(LAS v4u*)(ZT + (pc * 8 + j) * 264 + kb * 8) = out[j];
#pragma unroll
        for (int i = 0; i < 8; ++i) { const int c = tid + i * 512; *(LAS v4u*)(Cl + (c >> 4) * 136 + (c & 15) * 8) = tb[i]; }
    }
    float twc[2][16], tws[2][16];
#pragma unroll
    for (int pi = 0; pi < 2; ++pi)
#pragma unroll
        for (int q = 0; q < 16; ++q) { const int k1 = (2 * mh + pi) * 32 + (q & 3) + 8 * (q >> 2) + 4 * h; const float* p = tw + 2 * (t2 * k1); twc[pi][q] = p[0]; tws[pi][q] = p[1]; }
    __syncthreads();
    f32x16 ar[2], ai[2];
#pragma unroll
    for (int a = 0; a < 2; ++a) { ar[a] = f32x16{}; ai[a] = f32x16{}; }
#pragma unroll 2
    for (int kt = 0; kt < 8; ++kt) {
        const bf16x8 zr = *(const LAS bf16x8*)(ZT + (nt * 32 + r) * 264 + kt * 16 + 8 * h), zi = *(const LAS bf16x8*)(ZT + (nt * 32 + r) * 264 + 128 + kt * 16 + 8 * h);
#pragma unroll
        for (int pi = 0; pi < 2; ++pi) { const int mrow = ((2 * mh + pi) * 32 + r) * 136 + kt * 16 + 8 * h;
            const bf16x8 ac = *(const LAS bf16x8*)(Cl + mrow), as = *(const LAS bf16x8*)(Cl + 128 * 136 + mrow);
            const bf16x8 ns = as ^ (short)0x8000;
            ar[pi] = MFMA32(ac, zr, ar[pi]); ar[pi] = MFMA32(as, zi, ar[pi]);
            ai[pi] = MFMA32(ac, zi, ai[pi]); ai[pi] = MFMA32(ns, zr, ai[pi]); }
    }
    __syncthreads();
    LAS bf16* OUT = (LAS bf16*)(F.lds + F1_ZT);
#pragma unroll
    for (int pi = 0; pi < 2; ++pi)
#pragma unroll
        for (int q = 0; q < 16; ++q) { const int k1 = (2 * mh + pi) * 32 + (q & 3) + 8 * (q >> 2) + 4 * h; const float c = twc[pi][q], s = tws[pi][q], gr = ar[pi][q], gi = ai[pi][q];
            OUT[(k1 * 2) * 128 + nt * 32 + r] = (bf16)f2bf(c * gr + s * gi); OUT[(k1 * 2 + 1) * 128 + nt * 32 + r] = (bf16)f2bf(c * gi - s * gr); }
    __syncthreads();
#pragma unroll
    for (int i = 0; i < 8; ++i) { const int c = tid + i * 512, row = c >> 4, pc = c & 15, k1 = row >> 1, ri = row & 1;
        *(GAS v4u*)(GP + ((((size_t)b * 128 + k1) * 64 + t2) * 2 + ri) * 256 + ch * 128 + pc * 8) = *(const LAS v4u*)(OUT + row * 128 + pc * 8); }
    __syncthreads();
}
constexpr int F2_GT = 0, F2_M = 69632, F2_END = F2_M + 17408;
__device__ __forceinline__ void f2_unit(Frame& F, int unit) {
    unsigned char* ws = F.ws; const int tid = F.tid, lane = F.lane, w = F.wave, r = lane & 31, h = lane >> 5;
    const int b = unit >> 7, k1 = unit & 127;
    const bf16* GP = (const bf16*)(ws + WS_GP) + ((size_t)b * 128 + k1) * 64 * 2 * 256; bf16* MIX = (bf16*)(ws + WS_MIX); const bf16* M2 = (const bf16*)(ws + SM_M2);
    LAS bf16* GT = (LAS bf16*)(F.lds + F2_GT); LAS bf16* Ml = (LAS bf16*)(F.lds + F2_M);
    {
        const int kb = tid >> 5, pc = tid & 31;
        v4u in[8], out[8], tb[2];
#pragma unroll
        for (int i = 0; i < 8; ++i) in[i] = *(const GAS v4u*)(GP + (size_t)(kb * 8 + i) * 256 + pc * 8);
#pragma unroll
        for (int i = 0; i < 2; ++i) tb[i] = *(const GAS v4u*)(M2 + (size_t)(tid + i * 512) * 8);
        tr8x8(in, out);
#pragma unroll
        for (int j = 0; j < 8; ++j) *(LAS v4u*)(GT + (pc * 8 + j) * 136 + kb * 8) = out[j];
#pragma unroll
        for (int i = 0; i < 2; ++i) { const int c = tid + i * 512; *(LAS v4u*)(Ml + (c >> 4) * 136 + (c & 15) * 8) = tb[i]; }
    }
    __syncthreads();
    f32x16 acc[2]; acc[0] = f32x16{}; acc[1] = f32x16{};
#pragma unroll
    for (int kt = 0; kt < 8; ++kt) { const bf16x8 bf = *(const LAS bf16x8*)(GT + (w * 32 + r) * 136 + kt * 16 + 8 * h);
#pragma unroll
        for (int mt = 0; mt < 2; ++mt) { const bf16x8 af = *(const LAS bf16x8*)(Ml + (mt * 32 + r) * 136 + kt * 16 + 8 * h); acc[mt] = MFMA32(af, bf, acc[mt]); } }
    __syncthreads();
    LAS bf16* OUT = (LAS bf16*)(F.lds + F2_GT);
    const float SC = 1.0f / 724.0773439350246f;
#pragma unroll
    for (int mt = 0; mt < 2; ++mt)
#pragma unroll
        for (int q = 0; q < 16; ++q) { const int k2 = mt * 32 + (q & 3) + 8 * (q >> 2) + 4 * h; OUT[k2 * 256 + w * 32 + r] = (bf16)f2bf(acc[mt][q] * SC); }
    __syncthreads();
#pragma unroll
    for (int i = 0; i < 4; ++i) { const int c = tid + i * 512, k2 = c >> 5, pc = c & 31; const size_t row = (size_t)b * SPB + CTXL + k1 + 128 * k2;
        *(GAS v4u*)(MIX + row * 1024 + 256 + pc * 8) = *(const LAS v4u*)(OUT + k2 * 256 + pc * 8); }
    __syncthreads();
}
__device__ __forceinline__ void fctx_unit(Frame& F, int unit) {
    unsigned char* ws = F.ws; const int tid = F.tid, lane = F.lane, w = F.wave, r = lane & 31, h = lane >> 5;
    const int b = unit >> 3, cb = unit & 7;
    const bf16* P = (const bf16*)(ws + WS_P); bf16* MIX = (bf16*)(ws + WS_MIX); const bf16* M3 = (const bf16*)(ws + SM_M3);
    LAS bf16* ZT = (LAS bf16*)(F.lds + RING_OFF);
    for (int idx = tid; idx < 2048; idx += NWAVES * 64) { const int k = idx >> 2, pc = idx & 3, ri = k >> 8, t = k & 255;
        const size_t row = (size_t)b * SPB + t; const v4u raw = *(const GAS v4u*)(P + row * NIN + 512 + ri * 256 + cb * 32 + pc * 8);
        LAS bf16* d = ZT + (pc * 8) * 520 + k;
        d[0] = (bf16)(raw.x & 0xffff); d[520] = (bf16)(raw.x >> 16); d[2 * 520] = (bf16)(raw.y & 0xffff); d[3 * 520] = (bf16)(raw.y >> 16);
        d[4 * 520] = (bf16)(raw.z & 0xffff); d[5 * 520] = (bf16)(raw.z >> 16); d[6 * 520] = (bf16)(raw.w & 0xffff); d[7 * 520] = (bf16)(raw.w >> 16); }
    __syncthreads();
    f32x16 acc = f32x16{};
#pragma unroll 4
    for (int kt = 0; kt < 32; ++kt) { const bf16x8 bf = *(const LAS bf16x8*)(ZT + r * 520 + kt * 16 + 8 * h);
        const bf16x8 af = *(const bf16x8*)(M3 + (size_t)(w * 32 + r) * 512 + kt * 16 + 8 * h); acc = MFMA32(af, bf, acc); }
#pragma unroll
    for (int q = 0; q < 16; ++q) { const int kq = w * 32 + (q & 3) + 8 * (q >> 2) + 4 * h; const size_t row = (size_t)b * SPB + kq;
        MIX[row * 1024 + 256 + cb * 32 + r] = (bf16)f2bf(acc[q] * (1.0f / 128.0f)); }
    __syncthreads();
}

__device__ __forceinline__ void ctx_fixup(Frame& F, int l, int kind) {
    const int gw = F.vcu * NWAVES + F.wave, NGW = F.G * NWAVES, lane = F.lane;
    unsigned char* ws = F.ws;
    const float* mod = (const float*)(ws + WS_CTL + CTL_MOD) + (size_t)l * 3 * 6144 + 2 * 6144;
    const float* gate = mod + (kind == 0 ? 2048 : 5120);
    const float* gn = kind == 0 ? inptr(F.lds, IN_G2) + l * DM : inptr(F.lds, IN_G1) + (l + 1) * DM;
    const float* sc = kind == 0 ? mod + 4096 : mod + 3 * 6144 + 1024;
    const float* part = (const float*)(ws + WS_PART); float* ctxres = (float*)(ws + WS_CTXRES); bf16* ACT = (bf16*)(ws + WS_ACT);
    float* rowss = (float*)(ws + WS_RPART) + (size_t)(2 * l + 1 + kind) * R * 16;
    const float* ctxin = (kind == 0 && l == 0) ? inptr(F.lds, IN_CTX) : nullptr;
    for (int cr = gw; cr < 512; cr += NGW) {
        const int b = cr >> 8, r = b * SPB + (cr & 255); float ss = 0.f; unsigned long long o[4];
#pragma unroll
        for (int j = 0; j < 4; ++j) { const int c = 4 * lane + 256 * j; const size_t off = (size_t)cr * 1024 + c;
            const f32x4 p0 = *(const f32x4*)(part + off), p1 = *(const f32x4*)(part + 512 * 1024 + off), p2 = *(const f32x4*)(part + 2 * 512 * 1024 + off), p3 = *(const f32x4*)(part + 3 * 512 * 1024 + off);
            const f32x4 xs = ctxin ? *(const f32x4*)(ctxin + off) : *(const f32x4*)(ctxres + off);
            const f32x4 xo = xs + *(const f32x4*)(gate + c) * ((p0 + p1) + (p2 + p3));
            *(f32x4*)(ctxres + off) = xo;
            ss += (xo[0] * xo[0] + xo[1] * xo[1]) + (xo[2] * xo[2] + xo[3] * xo[3]);
            const f32x4 a = xo * (*(const f32x4*)(gn + c) * (*(const f32x4*)(sc + c) + 1.0f));
            o[j] = (unsigned long long)pk2(a[0], a[1]) | ((unsigned long long)pk2(a[2], a[3]) << 32); }
        ss = wave_sum(ss);
#pragma unroll
        for (int j = 0; j < 4; ++j) *(unsigned long long*)(ACT + (size_t)r * DM + 4 * lane + 256 * j) = o[j];
        if (lane < 16) rowss[(size_t)r * 16 + lane] = lane == 0 ? ss : 0.f;
    }
}
#ifndef MK_N_LAUNCHES
#define MK_N_LAUNCHES 1
#endif
constexpr int N_PHASES = 3 + 8 * DEPTH;
struct Args { const float* in[22]; float* out; unsigned char* ws; int ph_lo, ph_hi; };
__global__ void __launch_bounds__(NWAVES * 64, 2) fwd_kernel(Args args) {
    extern __shared__ __attribute__((aligned(16))) unsigned char lds[];
    Frame F;
    F.lds = (LAS unsigned char*)lds;
    F.MISC = (volatile LAS unsigned*)(F.lds + MISC_OFF);
    F.tid = threadIdx.x; F.lane = F.tid & 63; F.wave = __builtin_amdgcn_readfirstlane(F.tid >> 6);
    F.G = gridDim.x; { const int bx = blockIdx.x; F.vcu = (F.G % 8 == 0) ? (bx % 8) * (F.G / 8) + bx / 8 : bx; }
    F.ws = args.ws;
    unsigned char* ws = args.ws;
    for (int u = F.tid; u < (LDS_BYTES - LDSCTL_OFF) / 4; u += NWAVES * 64) ((LAS unsigned*)(F.lds + LDSCTL_OFF))[u] = 0u;
    __syncthreads();
    if (F.tid == 0) { LAS unsigned long long* tab = (LAS unsigned long long*)(F.lds + PTAB_OFF);
#pragma unroll
        for (int i = 0; i < N_IN; ++i) tab[i] = (unsigned long long)args.in[i];
        tab[IN_OUT] = (unsigned long long)args.out; }
    __syncthreads();
    XcdBarrier bar; bar.bar = (unsigned*)(ws + WS_CTL) + CW_BAR; bar.x = 0; bar.st = nullptr;
    if (MK_N_LAUNCHES == 1) bar = xcd_barrier_post((unsigned*)(ws + WS_CTL) + CW_BAR, F.MISC + 8);
    const int lo = args.ph_lo, hi = args.ph_hi;
#define IN(k) (lo <= (k) && (k) < hi)
#define SEAM(k) do { if ((k) + 1 < hi) xcd_barrier(bar); } while (0)
#define ENTER() do { int t_ = threadIdx.x; asm volatile("" : "+v"(t_)); F.tid = t_; F.lane = t_ & 63; F.wave = __builtin_amdgcn_readfirstlane(t_ >> 6); \
        unsigned long long w_ = (unsigned long long)args.ws; asm volatile("" : "+s"(w_)); ws = (unsigned char*)w_; F.ws = ws; } while (0)

    if (IN(0)) { ENTER(); s0_prologue(F); SEAM(0); }
    if (IN(1)) { ENTER(); s0b_modsum(F); SEAM(1); }
    if (IN(2)) { ENTER(); s1_prologue(F); SEAM(2); }
#pragma unroll 1
    for (int l = 0; l < DEPTH; ++l) {
        const int p0 = 3 + 8 * l; const bool last = (l == DEPTH - 1);
        if (IN(p0)) {
            ENTER();
            pg8::Gemm g{(const bf16*)(ws + WS_ACT), (const bf16*)(ws + WS_WIN + l * WIN_STRIDE), R, NIN, DM}; pg8::StaticOrder S; S.init(R, NIN, DM, F.G, (int)blockIdx.x, 0);
            pg8::EpiInProj E{F.lds, ws, l};
            pg8::gemm_phase<pg8::EpiInProj, pg8::StaticOrder, true, true>(F.lds + RING_OFF, g, S, E);
            SEAM(p0);
        }
        if (IN(p0 + 1)) {
            ENTER();
            for (int u = F.vcu; u < 256; u += F.G) f1_unit(F, u);
            ENTER();
            for (int u = F.vcu; u < 256; u += F.G) p2_convpool_unit<8>(F, l, (u >> 7) * SPB + CTXL + (u & 127) * 64);
            if (!last) { ENTER(); for (int u = (F.vcu + 32) % F.G; u < 16; u += F.G) p2_convpool_unit<4>(F, l, (u >> 3) * SPB + (u & 7) * 32); }
            if (!last) { ENTER(); for (int u = F.G - 1 - F.vcu; u < 16; u += F.G) fctx_unit(F, u); }
            SEAM(p0 + 1);
        }
        if (IN(p0 + 2)) {
            ENTER();
            for (int u = F.vcu; u < 256; u += F.G) f2_unit(F, u);
            ENTER();
            const int nun = last ? 256 : 264;
            for (int u = F.vcu; u < nun; u += F.G) {
                int bh, q0, NT; if (u < 256) { bh = u >> 5; q0 = 256 * (1 + (u & 31)); NT = SPB / 64; } else { bh = u - 256; q0 = 0; NT = CTXL / 64; }
                attn_body::attn_unit<8>((long)(bh >> 2) * SPB, bh & 3, q0, NT, (const attn_body::bf16*)(ws + WS_Q), (const attn_body::bf16*)(ws + WS_K), (const attn_body::bf16*)(ws + WS_V),
                                        (attn_body::bf16*)(ws + WS_MIX), (char*)lds + RING_OFF);
            }
            SEAM(p0 + 2);
        }
        if (IN(p0 + 3)) {
            ENTER();
            pg8::Gemm g{(const bf16*)(ws + WS_MIX), (const bf16*)(ws + WS_WO + l * WO_STRIDE), R, DM, DM}; pg8::StaticOrder S; S.init(64 * 256, DM, DM, F.G, (int)blockIdx.x, 1);
            if (F.G == 256) { pg8::EpiRes2 E{F.lds, ws, l, 0}; pg8::gemm_phase<pg8::EpiRes2, pg8::StaticOrder, false, true>(F.lds + RING_OFF, g, S, E); }
            else { pg8::EpiRes E{F.lds, ws, l, 0}; pg8::gemm_phase<pg8::EpiRes, pg8::StaticOrder, true, true>(F.lds + RING_OFF, g, S, E); }
            if (!last) { ENTER(); pg8::Gemm g2{(const bf16*)(ws + WS_MIX), (const bf16*)(ws + WS_WO + l * WO_STRIDE), R, DM, DM}; pg8::StaticOrder S2; S2.init(64 * 256, DM, DM, F.G, (int)blockIdx.x, 2); pg8::EpiPart E2{ws};
                pg8::gemm_phase<pg8::EpiPart, pg8::StaticOrder, true, true>(F.lds + RING_OFF, g2, S2, E2); }
            SEAM(p0 + 3);
        }
        if (IN(p0 + 4) && !last) { ENTER(); ctx_fixup(F, l, 0); SEAM(p0 + 4); }
        if (IN(p0 + 5)) {
            ENTER();
            pg8::Gemm g{(const bf16*)(ws + WS_ACT), (const bf16*)(ws + WS_WFI + l * WFI_STRIDE), R, 2 * DFF, DM}; pg8::StaticOrder S; S.init(last ? 64 * 256 : R, 2 * DFF, DM, F.G, (int)blockIdx.x, last ? 1 : 0);
            pg8::EpiFfnIn E{ws, l};
            pg8::gemm_phase<pg8::EpiFfnIn, pg8::StaticOrder, true, true>(F.lds + RING_OFF, g, S, E);
            SEAM(p0 + 5);
        }
        if (IN(p0 + 6)) {
            ENTER();
            pg8::Gemm g{(const bf16*)(ws + WS_H), (const bf16*)(ws + WS_WFO + l * WFO_STRIDE), R, DM, DFF}; pg8::StaticOrder S; S.init(64 * 256, DM, DFF, F.G, (int)blockIdx.x, 1);
            if (F.G == 256) { pg8::EpiRes2 E{F.lds, ws, l, 1}; pg8::gemm_phase<pg8::EpiRes2, pg8::StaticOrder, false, true>(F.lds + RING_OFF, g, S, E); }
            else { pg8::EpiRes E{F.lds, ws, l, 1}; pg8::gemm_phase<pg8::EpiRes, pg8::StaticOrder, true, true>(F.lds + RING_OFF, g, S, E); }
            if (!last) { ENTER(); pg8::Gemm g2{(const bf16*)(ws + WS_H), (const bf16*)(ws + WS_WFO + l * WFO_STRIDE), R, DM, DFF}; pg8::StaticOrder S2; S2.init(64 * 256, DM, DFF, F.G, (int)blockIdx.x, 2); pg8::EpiPart E2{ws};
                pg8::gemm_phase<pg8::EpiPart, pg8::StaticOrder, true, true>(F.lds + RING_OFF, g2, S2, E2); }
            if (!last) SEAM(p0 + 6);
        }
        if (IN(p0 + 7) && !last) { ENTER(); ctx_fixup(F, l, 1); SEAM(p0 + 7); }
    }
#undef IN
#undef SEAM
}

extern "C" void kernel_launch(void* const* d_in, const int* in_sizes, int n_in, void* d_out, int out_size, void* d_ws, size_t ws_size, hipStream_t stream) {
    static int grid = 0;
    if (grid == 0) {
        if (n_in != 22 || out_size != BATCH * SEQ * DM || ws_size < WS_END) { fprintf(stderr, "kernel_launch: unexpected shapes (n_in %d out %d ws %zu)\n", n_in, out_size, ws_size); grid = -1; return; }
        int dev = 0, cus = 0, per_cu = 0;
        if (hipGetDevice(&dev) != hipSuccess || hipDeviceGetAttribute(&cus, hipDeviceAttributeMultiprocessorCount, dev) != hipSuccess) { grid = -1; return; }
        if (hipFuncSetAttribute((const void*)fwd_kernel, hipFuncAttributeMaxDynamicSharedMemorySize, LDS_BYTES) != hipSuccess) { fprintf(stderr, "kernel_launch: hipFuncSetAttribute failed\n"); grid = -1; return; }
        if (hipOccupancyMaxActiveBlocksPerMultiprocessor(&per_cu, (const void*)fwd_kernel, NWAVES * 64, LDS_BYTES) != hipSuccess || per_cu < 1) { fprintf(stderr, "kernel_launch: occupancy query says %d\n", per_cu); (void)hipGetLastError(); per_cu = 1; }
        grid = cus;
    }
    if (grid < 0) return;
    (void)hipMemsetAsync((char*)d_ws + WS_CTL, 0, CTL_ZERO_BYTES, stream);
    Args a{};
    for (int i = 0; i < 22; ++i) a.in[i] = (const float*)d_in[i];
    a.out = (float*)d_out; a.ws = (unsigned char*)d_ws;
#if MK_N_LAUNCHES == 1
    a.ph_lo = 0; a.ph_hi = N_PHASES;
    void* kargs[] = {&a};
    hipError_t e = hipLaunchCooperativeKernel((const void*)fwd_kernel, dim3(grid), dim3(NWAVES * 64), kargs, LDS_BYTES, stream);
    if (e != hipSuccess) { fprintf(stderr, "kernel_launch: cooperative launch failed: %s\n", hipGetErrorString(e)); }
#else
    for (int p = 0; p < N_PHASES; ++p) { a.ph_lo = p; a.ph_hi = p + 1; hipLaunchKernelGGL(fwd_kernel, dim3(grid), dim3(NWAVES * 64), LDS_BYTES, stream, a); }
#endif
}
```

```cpp
#include <hip/hip_runtime.h>
#include <hip/hip_bf16.h>
#include <cstdio>
#include <cstdint>
#include <cmath>
constexpr int NWAVES = 8;
constexpr int BATCH = 2, SEQ = 8192, CTXL = 256, DM = 1024, DEPTH = 2, DFF = 2816, DIN0 = 1536, NIN = 1792;
constexpr int SPB = SEQ + CTXL;
constexpr int R = BATCH * SPB;
constexpr float EPS = 1e-6f;
constexpr float QSCALE = 0.125f * 1.4426950408889634f;
constexpr size_t MiB = 1u << 20, KiB = 1024;
constexpr size_t WS_CTL = 0, CTL_ZERO_BYTES = 32 * 1024;
constexpr size_t CTL_MOD = 64 * 1024;
constexpr size_t WS_WIN = 1 * MiB, WIN_STRIDE = 3584 * KiB;
constexpr size_t WS_WO = 8 * MiB, WO_STRIDE = 2 * MiB;
constexpr size_t WS_WFI = 12 * MiB, WFI_STRIDE = 11 * MiB;
constexpr size_t WS_WFO = 34 * MiB, WFO_STRIDE = 5632 * KiB;
constexpr size_t WS_SMALL = 45 * MiB;
constexpr size_t SM_BIN = WS_SMALL;
constexpr size_t SM_BFF = SM_BIN + 64 * 1024;
constexpr size_t SM_ROPE = SM_BFF + 192 * 1024;
constexpr size_t SM_TW = SM_ROPE + 16 * 1024;
constexpr size_t SM_M1 = SM_TW + 64 * 1024;
constexpr size_t SM_M2 = SM_M1 + 128 * 1024;
constexpr size_t SM_M3 = SM_M2 + 16 * 1024;
constexpr size_t SM_MODPART = 46 * MiB;
constexpr size_t WS_CTXRES = 48 * MiB + 512 * KiB;
constexpr size_t WS_ACT = 51 * MiB;
constexpr size_t WS_P = 84 * MiB;
constexpr size_t WS_Q = 142 * MiB;
constexpr size_t WS_K = 150 * MiB + 512 * KiB;
constexpr size_t WS_V = 155 * MiB;
constexpr size_t WS_GP = 159 * MiB + 512 * KiB;
constexpr size_t WS_H = 84 * MiB;
constexpr size_t WS_MIX = 176 * MiB;
constexpr size_t WS_RPART = 209 * MiB;
constexpr size_t WS_PART = 213 * MiB + 512 * KiB;
constexpr size_t WS_RES = 222 * MiB;
constexpr size_t WS_END = 254 * MiB;
static_assert(WS_H + (size_t)R * DFF * 2 <= WS_MIX && WS_GP + 16 * MiB <= WS_MIX && WS_P + (size_t)R * NIN * 2 <= WS_Q && WS_Q + (size_t)R * 512 <= WS_K && WS_K + (size_t)R * 256 <= WS_V && WS_V + (size_t)R * 256 <= WS_GP, "d_ws map");
static_assert(WS_WIN + 2 * WIN_STRIDE <= WS_WO && WS_WO + 2 * WO_STRIDE <= WS_WFI && WS_WFI + 2 * WFI_STRIDE <= WS_WFO && WS_WFO + 2 * WFO_STRIDE <= WS_SMALL && SM_M3 + 256 * KiB <= SM_MODPART && SM_MODPART + 2304 * KiB <= WS_CTXRES && WS_CTXRES + 2 * MiB <= WS_ACT, "d_ws map (weights)");
static_assert(WS_ACT + (size_t)R * 2048 <= WS_P && WS_MIX + (size_t)R * 2048 <= WS_RPART && WS_RPART + (size_t)4 * R * 64 <= WS_PART && WS_PART + 8 * MiB <= WS_RES && WS_RES + 32 * MiB <= WS_END && WS_END <= 256 * MiB, "d_ws map (tail)");
constexpr int CW_BAR = 4096;
constexpr int RING_OFF = 0, RING_BYTES = 131072;
constexpr int LDSCTL_OFF = 146432, MISC_OFF = LDSCTL_OFF + 320;
constexpr int LDS_BYTES = 147456;
typedef unsigned u32x2_t __attribute__((ext_vector_type(2)));
constexpr int PTAB_OFF = LDSCTL_OFF + 512;
#define N_IN 22
__device__ __forceinline__ const float* inptr(__attribute__((address_space(3))) unsigned char* lds, int i) {
    const unsigned long long v = *(const __attribute__((address_space(3))) unsigned long long*)(lds + PTAB_OFF + 8 * i);
    const unsigned lo = __builtin_amdgcn_readfirstlane((unsigned)v), hi = __builtin_amdgcn_readfirstlane((unsigned)(v >> 32));
    return (const float*)(((unsigned long long)hi << 32) | lo);
}
#define IN_X 0
#define IN_C 1
#define IN_CTX 2
#define IN_CCTX 3
#define IN_WMOD 4
#define IN_BMOD 5
#define IN_G1 6
#define IN_G2 7
#define IN_WIN 8
#define IN_QG 9
#define IN_KG 10
#define IN_WF 11
#define IN_DWW 12
#define IN_DWB 13
#define IN_LNG 14
#define IN_LNB 15
#define IN_WPW 16
#define IN_WPL 17
#define IN_PLS 18
#define IN_WO 19
#define IN_WFI 20
#define IN_WFO 21
#define IN_OUT 22
__device__ __forceinline__ float row_rstd(const float* rpart, int r) {
    typedef float f4 __attribute__((ext_vector_type(4)));
    const f4* p = (const f4*)(rpart + (size_t)r * 16); const f4 a = p[0], b = p[1], c = p[2], d = p[3];
    const float s = (((a[0] + a[1]) + (a[2] + a[3])) + ((b[0] + b[1]) + (b[2] + b[3]))) + (((c[0] + c[1]) + (c[2] + c[3])) + ((d[0] + d[1]) + (d[2] + d[3])));
    return rsqrtf(s * (1.0f / 1024.0f) + 1e-6f);
}
namespace pg8 {
#define PG8_LAS __attribute__((address_space(3)))
typedef unsigned short bf16_t;
typedef short bf16x8 __attribute__((ext_vector_type(8)));
typedef float f32x4 __attribute__((ext_vector_type(4)));
typedef unsigned u32x4 __attribute__((ext_vector_type(4)));
constexpr int BM = 256, BK = 64, HALF = 128, HTB = HALF * BK * 2  , STAGE_BYTES = 8 * HTB, NXCD = 8, WGM = 8;

__host__ __device__ __forceinline__ int lds_byte(int r, int c) { const int st = (r >> 4) * 2 + (c >> 5), rr = r & 15, cc = c & 31, ob = rr * 64 + cc * 2; return st * 1024 + (ob ^ (((ob >> 9) & 1) << 5)); }
__host__ __device__ __forceinline__ void stage_rc(int b, int& R, int& C) { const int st = b / 1024, sb = b % 1024, swz = sb ^ (((sb >> 9) & 1) << 5); R = (st >> 1) * 16 + swz / 64; C = (st & 1) * 32 + (swz % 64) / 2; }
__host__ __device__ __forceinline__ int perm32(int rho) { const int n = rho >> 4, i = rho & 15; return 8 * (i >> 2) + 4 * n + (i & 3); }

struct Unit { int pm, pn, kx;
    __host__ __device__ __forceinline__ int nt() const { return kx & 255; }
    __host__ __device__ __forceinline__ int kt0() const { return (kx >> 8) & 255; }
    __host__ __device__ __forceinline__ int kc() const { return (kx >> 16) - 1; } };
struct Gemm { const bf16_t* A; const bf16_t* Bt; int M, N, K; };

struct StaticOrder {
    int nM, nN, nwg, G, c, skip, ntk;
    __host__ __device__ void init(int M, int N, int K, int G_, int c_, int skip_) { nM = M / BM; nN = N / BM; nwg = skip_ == 2 ? 0 : nM * nN; G = G_; c = c_; skip = skip_; ntk = K / BK; }
    __host__ __device__ bool next(int i, Unit& u) const {
        const long L = (long)i * G + c;
        u.kx = ntk;
        if (skip == 2 && L >= nwg) { const int idx = (int)(L - nwg); if (idx >= 32) return false; const int tile = idx >> 2, kc = idx & 3, base = (ntk >> 2) & ~1, rem2 = (ntk - 4 * base) >> 1;
            u.pm = (tile >> 2) * 33; u.pn = tile & 3; u.kx = ((kc + 1) << 16) | ((kc * base + 2 * (kc < rem2 ? kc : rem2)) << 8) | (base + (kc < rem2 ? 2 : 0)); return true; }
        if (L >= nwg) return false;
        int wgid = (int)L; { const int q = nwg / NXCD, r = nwg % NXCD, xcd = wgid % NXCD, off = wgid / NXCD; wgid = (xcd < r ? xcd * (q + 1) : r * (q + 1) + (xcd - r) * q) + off; }
        const int nig = WGM * nN, gid = wgid / nig, fm = gid * WGM, gsz = (nM - fm) < WGM ? (nM - fm) : WGM;
        u.pm = fm + ((wgid % nig) % gsz); u.pn = (wgid % nig) / gsz; if (skip) u.pm += 1 + u.pm / 32; return true;
    }
    __device__ __forceinline__ void a_ready(const Unit&) const {}
    __device__ __forceinline__ void done(const Unit&) const {}
};

__device__ __forceinline__ unsigned cvt_pk_bf16(float lo, float hi) { unsigned r; asm volatile("v_cvt_pk_bf16_f32 %0, %1, %2" : "=v"(r) : "v"(lo), "v"(hi)); return r; }
constexpr int RT = 33;
__device__ __forceinline__ int tile_v(int pm) { return (pm % RT == 0) ? 2 : pm / RT; }
typedef unsigned u32x2 __attribute__((ext_vector_type(2)));

struct EpiInProj {
    static constexpr bool PERM = true, AFTER_DRAIN = false;
    PG8_LAS unsigned char* lds; unsigned char* ws; int l;
    __device__ __forceinline__ void operator()(const f32x4 (&acc)[2][2][4][2], const Unit& u, int wr, int wc, int fr, int fq) const {
        if (u.pn < 2) { qkv(acc, u, wr, wc, fr, fq); return; }
        bf16_t* O = (bf16_t*)(ws + WS_P); const float* rowss = (const float*)(ws + WS_RPART) + (size_t)(2 * l) * R * 16; const float* bias = (const float*)(ws + SM_BIN) + (size_t)l * 3 * NIN;
        const int row0 = u.pm * BM + wr * 64 + fr, v = tile_v(u.pm), col0 = u.pn * BM + wc * 32 + 8 * fq;
        const float* bp = bias + v * 1792 + col0;
        f32x4 bv[2][2];
#pragma unroll
        for (int bj = 0; bj < 2; ++bj)
#pragma unroll
            for (int n = 0; n < 2; ++n) bv[bj][n] = *(const f32x4*)(bp + bj * HALF + 4 * n);
        float rsv[8];
        { f32x4 pq[8];
#pragma unroll
          for (int q = 0; q < 8; ++q) pq[q] = *(const f32x4*)(rowss + (size_t)(row0 + (q >> 2) * HALF + (q & 3) * 16) * 16 + 4 * fq);
#pragma unroll
          for (int q = 0; q < 8; ++q) { float s = (pq[q][0] + pq[q][1]) + (pq[q][2] + pq[q][3]); s += __shfl_xor(s, 16); s += __shfl_xor(s, 32); rsv[q] = rsqrtf(s * (1.0f / 1024.0f) + 1e-6f); } }
#pragma unroll
        for (int ai = 0; ai < 2; ++ai)
#pragma unroll
            for (int m = 0; m < 4; ++m) { const int r = row0 + ai * HALF + m * 16; const float rs = rsv[ai * 4 + m];
                bf16_t* rowp = O + (size_t)r * 1792 + col0;
#pragma unroll
                for (int bj = 0; bj < 2; ++bj) { const f32x4 v0 = acc[ai][bj][m][0] * rs + bv[bj][0], v1 = acc[ai][bj][m][1] * rs + bv[bj][1];
                    u32x4 w; w.x = cvt_pk_bf16(v0[0], v0[1]); w.y = cvt_pk_bf16(v0[2], v0[3]); w.z = cvt_pk_bf16(v1[0], v1[1]); w.w = cvt_pk_bf16(v1[2], v1[3]);
                    *(u32x4*)(rowp + bj * HALF) = w; } }
    }
    __device__ __forceinline__ void qkv(const f32x4 (&acc)[2][2][4][2], const Unit& u, int wr, int wc, int fr, int fq) const {
        const float* rowss = (const float*)(ws + WS_RPART) + (size_t)(2 * l) * R * 16; const float* bias = (const float*)(ws + SM_BIN) + (size_t)l * 3 * NIN;
        const float* rope = (const float*)(ws + SM_ROPE);
        const int row0 = u.pm * BM + wr * 64 + fr, v = tile_v(u.pm), col0 = u.pn * BM + wc * 32 + 8 * fq;
        const bool isq = u.pn == 0, norm = isq || wc < 2, lat = (u.pm % RT) != 0;
        const float* bp = bias + v * 1792 + col0;
        f32x4 bv[2][2], gg[2][2];
#pragma unroll
        for (int bj = 0; bj < 2; ++bj)
#pragma unroll
            for (int n = 0; n < 2; ++n) { bv[bj][n] = *(const f32x4*)(bp + bj * HALF + 4 * n);
                gg[bj][n] = (f32x4){1.f, 1.f, 1.f, 1.f};
                if (norm) gg[bj][n] = *(const f32x4*)((isq ? inptr(lds, IN_QG) : inptr(lds, IN_KG)) + l * 64 + 32 * bj + 8 * fq + 4 * n) * (isq ? QSCALE : 1.0f); }
        bf16_t* ob = isq ? (bf16_t*)(ws + WS_Q) + wc * 64 + 8 * fq : (wc < 2 ? (bf16_t*)(ws + WS_K) + wc * 64 + 8 * fq : (bf16_t*)(ws + WS_V) + (wc - 2) * 64 + 8 * fq);
        const int opitch = isq ? 256 : 128;
#pragma unroll
        for (int ai = 0; ai < 2; ++ai) {
            f32x4 cr[2] = {{1.f, 0.f, 1.f, 0.f}, {1.f, 0.f, 1.f, 0.f}};
            if (norm && lat) { const int prow = (u.pm % RT - 1) * 4 + 2 * ai + wr; const float* p = rope + ((size_t)prow * 16 + 4 * fq) * 2; cr[0] = *(const f32x4*)p; cr[1] = *(const f32x4*)(p + 4); }
#pragma unroll
            for (int m = 0; m < 4; ++m) { const int r = row0 + ai * HALF + m * 16;
                float rs; { const f32x4 pq = *(const f32x4*)(rowss + (size_t)r * 16 + 4 * fq); float s = (pq[0] + pq[1]) + (pq[2] + pq[3]); s += __shfl_xor(s, 16); s += __shfl_xor(s, 32); rs = rsqrtf(s * (1.0f / 1024.0f) + 1e-6f); }
                f32x4 x[2][2];
#pragma unroll
                for (int bj = 0; bj < 2; ++bj)
#pragma unroll
                    for (int n = 0; n < 2; ++n) x[bj][n] = acc[ai][bj][m][n] * rs + bv[bj][n];
                if (norm) {
                    float ss = 0.f;
#pragma unroll
                    for (int bj = 0; bj < 2; ++bj)
#pragma unroll
                        for (int n = 0; n < 2; ++n) ss += (x[bj][n][0] * x[bj][n][0] + x[bj][n][1] * x[bj][n][1]) + (x[bj][n][2] * x[bj][n][2] + x[bj][n][3] * x[bj][n][3]);
                    ss += __shfl_xor(ss, 16); ss += __shfl_xor(ss, 32);
                    const float rn = rsqrtf(ss * (1.0f / 64.0f) + 1e-6f);
#pragma unroll
                    for (int bj = 0; bj < 2; ++bj)
#pragma unroll
                        for (int n = 0; n < 2; ++n) x[bj][n] = x[bj][n] * rn * gg[bj][n];
                    if (lat) { const float* p = rope + ((size_t)(16 * m + fr) * 16 + 4 * fq) * 2; const f32x4 cc[2] = {*(const f32x4*)p, *(const f32x4*)(p + 4)};
#pragma unroll
                        for (int n = 0; n < 2; ++n) { f32x4 a = x[0][n], b = x[1][n]; const f32x4 c0 = cr[n], c1 = cc[n];
                            x[0][n] = (f32x4){a[0] * c0[0] - a[1] * c0[1], a[0] * c0[1] + a[1] * c0[0], a[2] * c0[2] - a[3] * c0[3], a[2] * c0[3] + a[3] * c0[2]};
                            x[1][n] = (f32x4){b[0] * c1[0] - b[1] * c1[1], b[0] * c1[1] + b[1] * c1[0], b[2] * c1[2] - b[3] * c1[3], b[2] * c1[3] + b[3] * c1[2]}; } }
                }
#pragma unroll
                for (int bj = 0; bj < 2; ++bj) { u32x4 w; w.x = cvt_pk_bf16(x[bj][0][0], x[bj][0][1]); w.y = cvt_pk_bf16(x[bj][0][2], x[bj][0][3]); w.z = cvt_pk_bf16(x[bj][1][0], x[bj][1][1]); w.w = cvt_pk_bf16(x[bj][1][2], x[bj][1][3]);
                    *(u32x4*)(ob + (size_t)r * opitch + 32 * bj) = w; } } }
    }
};
struct EpiFfnIn {
    static constexpr bool PERM = true, AFTER_DRAIN = false;
    unsigned char* ws; int l;
    __device__ __forceinline__ void operator()(const f32x4 (&acc)[2][2][4][2], const Unit& u, int wr, int wc, int fr, int fq) const {
        bf16_t* H = (bf16_t*)(ws + WS_H); const float* rowss = (const float*)(ws + WS_RPART) + (size_t)(2 * l + 1) * R * 16; const float* bias = (const float*)(ws + SM_BFF) + (size_t)l * 3 * 2 * DFF;
        const int row0 = u.pm * BM + wr * 64 + fr, v = tile_v(u.pm), hc = wc * 32 + 8 * fq;
        const float* bp = bias + v * 5632 + u.pn * BM + hc;
        f32x4 bv[2][2];
#pragma unroll
        for (int bj = 0; bj < 2; ++bj)
#pragma unroll
            for (int n = 0; n < 2; ++n) bv[bj][n] = *(const f32x4*)(bp + bj * HALF + 4 * n);
        float rsv[8];
        { f32x4 pq[8];
#pragma unroll
          for (int q = 0; q < 8; ++q) pq[q] = *(const f32x4*)(rowss + (size_t)(row0 + (q >> 2) * HALF + (q & 3) * 16) * 16 + 4 * fq);
#pragma unroll
          for (int q = 0; q < 8; ++q) { float s = (pq[q][0] + pq[q][1]) + (pq[q][2] + pq[q][3]); s += __shfl_xor(s, 16); s += __shfl_xor(s, 32); rsv[q] = rsqrtf(s * (1.0f / 1024.0f) + 1e-6f); } }
#pragma unroll
        for (int ai = 0; ai < 2; ++ai)
#pragma unroll
            for (int m = 0; m < 4; ++m) { const int r = row0 + ai * HALF + m * 16; const float rs = rsv[ai * 4 + m];
                float o[8];
#pragma unroll
                for (int n = 0; n < 2; ++n) { const f32x4 a = acc[ai][0][m][n] * rs + bv[0][n], g = acc[ai][1][m][n] * rs + bv[1][n];
#pragma unroll
                    for (int i = 0; i < 4; ++i) o[4 * n + i] = a[i] * __builtin_amdgcn_rcpf(1.0f + __expf(-a[i])) * g[i]; }
                u32x4 w; w.x = cvt_pk_bf16(o[0], o[1]); w.y = cvt_pk_bf16(o[2], o[3]); w.z = cvt_pk_bf16(o[4], o[5]); w.w = cvt_pk_bf16(o[6], o[7]);
                *(u32x4*)(H + (size_t)r * 2816 + u.pn * HALF + hc) = w; }
    }
};
struct EpiRes {
    static constexpr bool PERM = false, AFTER_DRAIN = false;
    PG8_LAS unsigned char* lds; unsigned char* ws; int l; int kind;
    __device__ __forceinline__ void operator()(const f32x4 (&acc)[2][2][4][2], const Unit& u, int wr, int wc, int fr, int fq) const {
        const float* mod = (const float*)(ws + WS_CTL + CTL_MOD) + (size_t)l * 3 * 6144;
        const bool lastffn = (kind == 1 && l == DEPTH - 1);
        const float* xin = (kind == 0 && l == 0) ? inptr(lds, IN_X) : nullptr; const float* ctxin = xin ? inptr(lds, IN_CTX) : nullptr;
        float* dout = (float*)inptr(lds, IN_OUT); float* ctxres = (float*)(ws + WS_CTXRES);
        const float* gate = mod + (kind == 0 ? 2048 : 5120);
        const float* gn = lastffn ? nullptr : (kind == 0 ? inptr(lds, IN_G2) + l * DM : inptr(lds, IN_G1) + (l + 1) * DM);
        const float* sc = kind == 0 ? mod + 4096 : mod + 3 * 6144 + 1024;
        bf16_t* A = lastffn ? nullptr : (bf16_t*)(ws + WS_ACT);
        float* rowss = (float*)(ws + WS_RPART) + (size_t)(2 * l + 1 + kind) * R * 16;
        const int v = tile_v(u.pm), rr = u.pm % RT, b = u.pm / RT;
        const float* src; float* dst;
        if (rr == 0) { dst = ctxres + (size_t)b * 256 * 1024; src = xin ? ctxin + (size_t)b * 256 * 1024 : dst; }
        else { const size_t off = ((size_t)b * 8192 + (size_t)(rr - 1) * 256) * 1024; dst = dout + off; src = xin ? xin + off : dst; }
        const int col0 = u.pn * BM + wc * 32 + 4 * fq;
        f32x4 gv[2][2], gs[2][2];
#pragma unroll
        for (int bj = 0; bj < 2; ++bj)
#pragma unroll
            for (int n = 0; n < 2; ++n) { const int c = col0 + bj * HALF + n * 16; gv[bj][n] = *(const f32x4*)(gate + v * 6144 + c);
                if (A) gs[bj][n] = *(const f32x4*)(gn + c) * (*(const f32x4*)(sc + v * 6144 + c) + 1.0f); else gs[bj][n] = (f32x4){0.f, 0.f, 0.f, 0.f}; }
#pragma unroll
        for (int ai = 0; ai < 2; ++ai)
#pragma unroll
            for (int m = 0; m < 4; ++m) { const int lr = ai * HALF + wr * 64 + m * 16 + fr; float ss = 0.f;
#pragma unroll
                for (int bj = 0; bj < 2; ++bj)
#pragma unroll
                    for (int n = 0; n < 2; ++n) { const size_t o = (size_t)lr * 1024 + col0 + bj * HALF + n * 16;
                        const f32x4 xs = *(const f32x4*)(src + o); const f32x4 xo = xs + gv[bj][n] * acc[ai][bj][m][n];
                        *(f32x4*)(dst + o) = xo;
                        if (A) { ss += (xo[0] * xo[0] + xo[1] * xo[1]) + (xo[2] * xo[2] + xo[3] * xo[3]); const f32x4 a = xo * gs[bj][n];
                            u32x2 w; w.x = cvt_pk_bf16(a[0], a[1]); w.y = cvt_pk_bf16(a[2], a[3]); *(u32x2*)(A + (size_t)(u.pm * BM + lr) * 1024 + col0 + bj * HALF + n * 16) = w; } }
                if (A) { ss += __shfl_xor(ss, 16); ss += __shfl_xor(ss, 32);
                    if (fq == 0) rowss[(size_t)(u.pm * BM + lr) * 16 + u.pn * 4 + wc] = ss; }
                asm volatile("" ::: "memory"); }
    }
};
struct EpiPart {
    static constexpr bool PERM = false, AFTER_DRAIN = false;
    unsigned char* ws;
    __device__ __forceinline__ void operator()(const f32x4 (&acc)[2][2][4][2], const Unit& u, int wr, int wc, int fr, int fq) const {
        float* part = (float*)(ws + WS_PART) + ((size_t)(u.kc()) * 512 + (size_t)(u.pm / RT) * 256 + wr * 64 + fr) * 1024 + u.pn * BM + wc * 32 + 4 * fq;
#pragma unroll
        for (int ai = 0; ai < 2; ++ai)
#pragma unroll
            for (int m = 0; m < 4; ++m)
#pragma unroll
                for (int bj = 0; bj < 2; ++bj)
#pragma unroll
                    for (int n = 0; n < 2; ++n) *(f32x4*)(part + (ai * HALF + m * 16) * 1024 + bj * HALF + n * 16) = acc[ai][bj][m][n];
    }
};
struct EpiRes2 {
    static constexpr bool PERM = false, AFTER_DRAIN = true;
    PG8_LAS unsigned char* lds; unsigned char* ws; int l; int kind;
    __device__ __forceinline__ void operator()(const f32x4 (&acc)[2][2][4][2], const Unit& u, int wr, int wc, int fr, int fq) const {}
    __device__ __forceinline__ void fused(f32x4 (&acc)[2][2][4][2], const Unit& u, int wr, int wc, int fr, int fq, PG8_LAS unsigned char* ring, int wid, int lane) const {
        const float* mod = (const float*)(ws + WS_CTL + CTL_MOD) + (size_t)l * 3 * 6144;
        const bool lastffn = (kind == 1 && l == DEPTH - 1);
        const float* xin = (kind == 0 && l == 0) ? inptr(lds, IN_X) : nullptr;
        float* dout = (float*)inptr(lds, IN_OUT);
        const float* gate = mod + (kind == 0 ? 2048 : 5120);
        const float* gn = lastffn ? nullptr : (kind == 0 ? inptr(lds, IN_G2) + l * DM : inptr(lds, IN_G1) + (l + 1) * DM);
        const float* sc = kind == 0 ? mod + 4096 : mod + 3 * 6144 + 1024;
        bf16_t* A = lastffn ? nullptr : (bf16_t*)(ws + WS_ACT);
        float* rowss = (float*)(ws + WS_RPART) + (size_t)(2 * l + 1 + kind) * R * 16;
        const int v = tile_v(u.pm), rr0 = u.pm % RT, b = u.pm / RT;
        const size_t off = ((size_t)b * 8192 + (size_t)(rr0 - 1) * 256) * 1024;
        const float* src32 = xin ? xin + off : nullptr;
        bf16_t* res = (bf16_t*)(ws + WS_RES) + off;
        float* dst32 = lastffn ? dout + off : nullptr;
        PG8_LAS float* T = (PG8_LAS float*)ring;
        const int c = u.pn * BM + 4 * lane;
        const f32x4 gvv = *(const f32x4*)(gate + v * 6144 + c);
        f32x4 gsv = {0.f, 0.f, 0.f, 0.f}; if (A) gsv = *(const f32x4*)(gn + c) * (*(const f32x4*)(sc + v * 6144 + c) + 1.0f);
#pragma unroll
        for (int ai = 0; ai < 2; ++ai) {
#pragma unroll
            for (int m = 0; m < 4; ++m) { const int row = wr * 64 + m * 16 + fr;
#pragma unroll
                for (int bj = 0; bj < 2; ++bj)
#pragma unroll
                    for (int n = 0; n < 2; ++n) { const int g = ((bj * HALF + wc * 32 + n * 16) >> 2) + fq; *(PG8_LAS f32x4*)(T + row * 256 + ((g ^ (row & 15)) << 2)) = acc[ai][bj][m][n]; } }
            asm volatile("s_waitcnt lgkmcnt(0)" ::: "memory"); __builtin_amdgcn_s_barrier(); asm volatile("" ::: "memory");
#pragma unroll
            for (int rq = 0; rq < 4; ++rq) {
                f32x4 xs[4], tv[4];
#pragma unroll
                for (int k = 0; k < 4; ++k) { const int rr = wid * 16 + rq * 4 + k; const size_t o = (size_t)(ai * HALF + rr) * 1024 + c;
                    if (src32) xs[k] = *(const f32x4*)(src32 + o);
                    else { const u32x2 w = *(const u32x2*)(res + o); xs[k] = (f32x4){__builtin_bit_cast(float, w.x << 16), __builtin_bit_cast(float, w.x & 0xffff0000u), __builtin_bit_cast(float, w.y << 16), __builtin_bit_cast(float, w.y & 0xffff0000u)}; }
                    tv[k] = *(const PG8_LAS f32x4*)(T + rr * 256 + ((lane ^ (rr & 15)) << 2)); }
                asm volatile("" ::: "memory");
#pragma unroll
                for (int k = 0; k < 4; ++k) { const int lr = ai * HALF + wid * 16 + rq * 4 + k; const f32x4 xo = xs[k] + gvv * tv[k];
                    if (dst32) *(f32x4*)(dst32 + (size_t)lr * 1024 + c) = xo;
                    else { u32x2 w; w.x = cvt_pk_bf16(xo[0], xo[1]); w.y = cvt_pk_bf16(xo[2], xo[3]); *(u32x2*)(res + (size_t)lr * 1024 + c) = w; }
                    if (A) { const f32x4 a = xo * gsv; u32x2 w; w.x = cvt_pk_bf16(a[0], a[1]); w.y = cvt_pk_bf16(a[2], a[3]); *(u32x2*)(A + (size_t)(u.pm * BM + lr) * 1024 + c) = w;
                        float ss = (xo[0] * xo[0] + xo[1] * xo[1]) + (xo[2] * xo[2] + xo[3] * xo[3]);
                        ss += __builtin_bit_cast(float, __builtin_amdgcn_update_dpp(0, __builtin_bit_cast(int, ss), 0xB1, 0xf, 0xf, false));
                        ss += __builtin_bit_cast(float, __builtin_amdgcn_update_dpp(0, __builtin_bit_cast(int, ss), 0x4E, 0xf, 0xf, false));
                        ss += __builtin_bit_cast(float, __builtin_amdgcn_update_dpp(0, __builtin_bit_cast(int, ss), 0x141, 0xf, 0xf, false));
                        ss += __builtin_bit_cast(float, __builtin_amdgcn_update_dpp(0, __builtin_bit_cast(int, ss), 0x140, 0xf, 0xf, false));
                        ss += __builtin_bit_cast(float, __builtin_amdgcn_update_dpp(0, __builtin_bit_cast(int, ss), 0x142, 0xa, 0xf, false));
                        ss += __builtin_bit_cast(float, __builtin_amdgcn_update_dpp(0, __builtin_bit_cast(int, ss), 0x143, 0xc, 0xf, false));
                        if (lane == 63) *(f32x4*)(rowss + (size_t)(u.pm * BM + lr) * 16 + u.pn * 4) = (f32x4){ss, 0.f, 0.f, 0.f}; } }
                asm volatile("" ::: "memory"); }
            asm volatile("s_waitcnt lgkmcnt(0)" ::: "memory"); __builtin_amdgcn_s_barrier(); asm volatile("" ::: "memory");
        }
    }
};
template <class Epi, class Sched, bool ALIGN_EPI = false, bool SP2 = false>
__device__ __forceinline__ void gemm_phase(PG8_LAS unsigned char* lds, const Gemm g, const Sched& S, const Epi& E) {
    int tid_ = threadIdx.x; asm volatile("" : "+v"(tid_));
    const int tid = tid_, wid = __builtin_amdgcn_readfirstlane(tid >> 6), lane = tid & 63, wr = wid >> 2, wc = wid & 3, fr = lane & 15, fq = lane >> 4;
    const int K = g.K, nt = K / BK;
    unsigned voffA[2], voffB[2];
#pragma unroll
    for (int i = 0; i < 2; ++i) { int R, C; stage_rc(tid * 16 + i * 8192, R, C); const int Rb = Epi::PERM ? ((R & ~31) + perm32(R & 31)) : R;
        voffA[i] = (unsigned)(R * K + C) * 2u; voffB[i] = (unsigned)(Rb * K + C) * 2u; }
    const size_t kstep = (size_t)(BK * 2);
    const size_t hstep = (size_t)HALF * K * 2;
    const size_t tstep = 2 * hstep;
    const unsigned ldsw = (unsigned)wid * 1024u;
    const int aoff = lds_byte(wr * 64 + fr, fq * 8), boff = lds_byte(wc * 32 + fr, fq * 8);
#define PG8_SA(b, h) (((b) * 2 + (h)) * HTB)
#define PG8_SB(b, h) ((4 + (b) * 2 + (h)) * HTB)
#define PG8_STAGE(bufoff, gbase, voff) do { _Pragma("unroll") for (int _i = 0; _i < 2; ++_i) \
        __builtin_amdgcn_global_load_lds((const unsigned*)((const char*)(gbase) + (voff)[_i]), (PG8_LAS unsigned*)(lds + (bufoff) + ldsw + _i * 8192), 16, 0, 0); } while (0)
#define PG8_LDA(dst, b, h) do { _Pragma("unroll") for (int m = 0; m < 4; ++m) _Pragma("unroll") for (int k = 0; k < 2; ++k) dst[m][k] = *(const PG8_LAS bf16x8*)(lds + PG8_SA(b, h) + aoff + m * 2048 + k * 1024); } while (0)
#define PG8_LDB(dst, b, h) do { _Pragma("unroll") for (int n = 0; n < 2; ++n) _Pragma("unroll") for (int k = 0; k < 2; ++k) dst[n][k] = *(const PG8_LAS bf16x8*)(lds + PG8_SB(b, h) + boff + n * 2048 + k * 1024); } while (0)
#define PG8_MMA(ai, bj, At, Bt) do { __builtin_amdgcn_s_setprio(1); _Pragma("unroll") for (int m = 0; m < 4; ++m) _Pragma("unroll") for (int n = 0; n < 2; ++n) _Pragma("unroll") for (int k = 0; k < 2; ++k) \
        acc[ai][bj][m][n] = __builtin_amdgcn_mfma_f32_16x16x32_bf16(Bt[n][k], At[m][k], acc[ai][bj][m][n], 0, 0, 0); __builtin_amdgcn_s_setprio(0); } while (0)
#define PG8_WAIT_V(n) asm volatile("s_waitcnt vmcnt(" #n ")" ::: "memory")
#define PG8_WAIT_L(n) asm volatile("s_waitcnt lgkmcnt(" #n ")" ::: "memory")
#define PG8_BAR __builtin_amdgcn_s_barrier()
#define PG8_SCHED __builtin_amdgcn_sched_barrier(0)
    Unit cur, nxt; int ui = 0;
    if (!S.next(0, cur)) return;
    f32x4 acc[2][2][4][2];
#pragma unroll
    for (int a = 0; a < 2; ++a)
#pragma unroll
        for (int b = 0; b < 2; ++b)
#pragma unroll
            for (int m = 0; m < 4; ++m)
#pragma unroll
                for (int n = 0; n < 2; ++n) acc[a][b][m][n] = (f32x4){0.f, 0.f, 0.f, 0.f};
    bf16x8 At[4][2], B0[2][2], B1[2][2];
    const char* cA = (const char*)g.A + (size_t)cur.pm * tstep + (size_t)cur.kt0() * kstep; const char* cB = (const char*)g.Bt + (size_t)cur.pn * tstep + (size_t)cur.kt0() * kstep;
    S.a_ready(cur);
    if constexpr (SP2) {
        PG8_STAGE(PG8_SB(0, 0), cB, voffB); PG8_STAGE(PG8_SB(0, 1), cB + hstep, voffB); PG8_STAGE(PG8_SA(0, 0), cA, voffA); PG8_STAGE(PG8_SA(0, 1), cA + hstep, voffA);
        if (wr == 1) PG8_BAR;
        PG8_WAIT_V(2); PG8_BAR;
        PG8_STAGE(PG8_SB(1, 0), cB + kstep, voffB); PG8_STAGE(PG8_SA(1, 0), cA + kstep, voffA); PG8_STAGE(PG8_SB(1, 1), cB + hstep + kstep, voffB);
        PG8_WAIT_V(6); PG8_BAR;
    } else {
        PG8_STAGE(PG8_SB(0, 0), cB, voffB); PG8_STAGE(PG8_SA(0, 0), cA, voffA); PG8_STAGE(PG8_SB(0, 1), cB + hstep, voffB); PG8_STAGE(PG8_SA(0, 1), cA + hstep, voffA);
        if (wr == 1) PG8_BAR;
        PG8_WAIT_V(4); PG8_BAR;
        PG8_STAGE(PG8_SB(1, 0), cB + kstep, voffB); PG8_STAGE(PG8_SA(1, 0), cA + kstep, voffA); PG8_STAGE(PG8_SB(1, 1), cB + hstep + kstep, voffB);
        PG8_WAIT_V(6); PG8_BAR;
    }
    for (;;) {
        const bool has_next = S.next(ui + 1, nxt);
        const char* nA = has_next ? (const char*)g.A + (size_t)nxt.pm * tstep + (size_t)nxt.kt0() * kstep : cA; const char* nB = has_next ? (const char*)g.Bt + (size_t)nxt.pn * tstep + (size_t)nxt.kt0() * kstep : cB;
        const int ntc = cur.nt();
        for (int t = 0; t < ntc; t += 2) {
            const bool last = (t == ntc - 2);
            const char* a1 = cA + (size_t)(t + 1) * kstep;
            const char* a2 = last ? nA : cA + (size_t)(t + 2) * kstep; const char* b2 = last ? nB : cB + (size_t)(t + 2) * kstep;
            const char* a3 = a2 + kstep; const char* b3 = b2 + kstep;
            if (last && has_next) S.a_ready(nxt);
            if constexpr (SP2) {
            PG8_LDB(B0, 0, 0); PG8_LDB(B1, 0, 1); PG8_SCHED; PG8_LDA(At, 0, 0); PG8_STAGE(PG8_SA(1, 1), a1 + hstep, voffA);
            PG8_WAIT_V(8); PG8_WAIT_L(0); PG8_BAR; PG8_MMA(0, 0, At, B0); PG8_MMA(0, 1, At, B1); PG8_BAR; PG8_SCHED;
            PG8_LDA(At, 0, 1); PG8_STAGE(PG8_SB(0, 0), b2, voffB); PG8_STAGE(PG8_SB(0, 1), b2 + hstep, voffB); PG8_STAGE(PG8_SA(0, 0), a2, voffA);
            PG8_WAIT_V(8); PG8_WAIT_L(0); PG8_BAR; PG8_MMA(1, 0, At, B0); PG8_MMA(1, 1, At, B1); PG8_BAR; PG8_SCHED;
            PG8_LDB(B0, 1, 0); PG8_LDB(B1, 1, 1); PG8_SCHED; PG8_LDA(At, 1, 0); PG8_STAGE(PG8_SA(0, 1), a2 + hstep, voffA);
            PG8_WAIT_V(8); PG8_WAIT_L(0); PG8_BAR; PG8_MMA(0, 0, At, B0); PG8_MMA(0, 1, At, B1); PG8_BAR; PG8_SCHED;
            PG8_LDA(At, 1, 1); PG8_STAGE(PG8_SB(1, 0), b3, voffB); PG8_STAGE(PG8_SB(1, 1), b3 + hstep, voffB); PG8_STAGE(PG8_SA(1, 0), a3, voffA);
            PG8_WAIT_V(8); PG8_WAIT_L(0); PG8_BAR; PG8_MMA(1, 0, At, B0); PG8_MMA(1, 1, At, B1); PG8_BAR; PG8_SCHED;
            } else {
            PG8_LDB(B0, 0, 0); PG8_SCHED; PG8_LDA(At, 0, 0); PG8_STAGE(PG8_SA(1, 1), a1 + hstep, voffA);
            PG8_WAIT_L(8); PG8_BAR; PG8_WAIT_L(0); PG8_MMA(0, 0, At, B0); PG8_BAR; PG8_SCHED;
            PG8_LDB(B1, 0, 1); PG8_STAGE(PG8_SB(0, 0), b2, voffB);
            PG8_BAR; PG8_WAIT_L(0); PG8_MMA(0, 1, At, B1); PG8_BAR;
            PG8_LDA(At, 0, 1); PG8_STAGE(PG8_SA(0, 0), a2, voffA);
            PG8_BAR; PG8_WAIT_L(0); PG8_MMA(1, 0, At, B0); PG8_BAR; PG8_SCHED;
            PG8_STAGE(PG8_SB(0, 1), b2 + hstep, voffB);
            PG8_WAIT_V(6); PG8_BAR; PG8_MMA(1, 1, At, B1); PG8_BAR;
            PG8_LDB(B0, 1, 0); PG8_SCHED; PG8_LDA(At, 1, 0); PG8_STAGE(PG8_SA(0, 1), a2 + hstep, voffA);
            PG8_WAIT_L(8); PG8_BAR; PG8_WAIT_L(0); PG8_MMA(0, 0, At, B0); PG8_BAR; PG8_SCHED;
            PG8_LDB(B1, 1, 1); PG8_STAGE(PG8_SB(1, 0), b3, voffB);
            PG8_BAR; PG8_WAIT_L(0); PG8_MMA(0, 1, At, B1); PG8_BAR;
            PG8_LDA(At, 1, 1); PG8_STAGE(PG8_SA(1, 0), a3, voffA);
            PG8_BAR; PG8_WAIT_L(0); PG8_MMA(1, 0, At, B0); PG8_BAR; PG8_SCHED;
            PG8_STAGE(PG8_SB(1, 1), b3 + hstep, voffB);
            PG8_WAIT_V(6); PG8_BAR; PG8_MMA(1, 1, At, B1); PG8_BAR;
            }
        }
        if constexpr (ALIGN_EPI) { if (wr == 0) PG8_BAR; }
        if constexpr (!Epi::AFTER_DRAIN) { E(acc, cur, wr, wc, fr, fq); S.done(cur); }
        if (!has_next) break;
#pragma unroll
        for (int a = 0; a < 2; ++a)
#pragma unroll
            for (int b = 0; b < 2; ++b)
#pragma unroll
                for (int m = 0; m < 4; ++m)
#pragma unroll
                    for (int n = 0; n < 2; ++n) acc[a][b][m][n] = (f32x4){0.f, 0.f, 0.f, 0.f};
        cur = nxt; cA = nA; cB = nB; ++ui;
        if constexpr (ALIGN_EPI) { if (wr == 1) PG8_BAR; }
    }
    PG8_WAIT_V(0);
    if constexpr (!ALIGN_EPI) { if (wr == 0) PG8_BAR; }
    PG8_BAR;
    if constexpr (Epi::AFTER_DRAIN) { E.fused(acc, cur, wr, wc, fr, fq, lds, wid, lane); S.done(cur); }
#undef PG8_SA
#undef PG8_SB
#undef PG8_STAGE
#undef PG8_LDA
#undef PG8_LDB
#undef PG8_MMA
#undef PG8_WAIT_V
#undef PG8_WAIT_L
#undef PG8_BAR
#undef PG8_SCHED
}
}

#include <hip/hip_bf16.h>
#include <cmath>
namespace attn_body {
using bf16=__hip_bfloat16;
using bf16x8=__attribute__((ext_vector_type(8)))short;
using s16x4=__attribute__((ext_vector_type(4)))short;
using f32x16=__attribute__((ext_vector_type(16)))float;
using u32x4=__attribute__((ext_vector_type(4)))unsigned;
constexpr int D=64,QP=256,KP=128,VP=128,OP=1024;
constexpr int NW=8,QBLK=32,QB=QBLK*NW,KVBLK=64;
constexpr int ATTN_UNIT_ROWS=QB;
__device__ __forceinline__ int crow(int r,int hi){return (r&3)+8*(r>>2)+4*hi;}
#define SBAR() __builtin_amdgcn_sched_barrier(0)
constexpr int NSLOT=3, SLOTB=8192;
constexpr int LDS_K=0, LDS_V=NSLOT*SLOTB, LDS_WS=2*NSLOT*SLOTB, LDS_OST=LDS_WS+NW*64*4, LDS_BYTES=LDS_OST+NW*4096;
constexpr float C2=0.125f*1.4426950408889634f;
__device__ __forceinline__ void glds16(const void*gsrc,unsigned lds_dst){unsigned keep;
  asm volatile("s_mov_b32 %0, m0\n\ts_mov_b32 m0, %2\n\ts_nop 0\n\tglobal_load_lds_dwordx4 %1, off\n\ts_mov_b32 m0, %0":"=&s"(keep):"v"(gsrc),"s"(lds_dst):"memory");}
__device__ __forceinline__ float max3f(float a,float b,float c){float r;asm("v_max3_f32 %0, %1, %2, %3":"=v"(r):"v"(a),"v"(b),"v"(c));return r;}
__device__ __forceinline__ float max2f(float a,float b){float r;asm("v_max_f32_e32 %0, %1, %2":"=v"(r):"v"(a),"v"(b));return r;}
__device__ __forceinline__ float fadd_s(float a,float b){float r;asm("v_add_f32_e32 %0, %1, %2":"=v"(r):"v"(a),"v"(b));return r;}
__device__ __forceinline__ float fsub_s(float a,float b){float r;asm("v_sub_f32_e32 %0, %1, %2":"=v"(r):"v"(a),"v"(b));return r;}
typedef float f32x2_t __attribute__((ext_vector_type(2))); typedef __bf16 bf16x2_t __attribute__((ext_vector_type(2)));
__device__ __forceinline__ unsigned cvtpk_s(float lo,float hi){f32x2_t v={lo,hi};bf16x2_t b=__builtin_convertvector(v,bf16x2_t);return __builtin_bit_cast(unsigned,b);}
#define WAIT_BAR(N) asm volatile("s_waitcnt vmcnt(" #N ") lgkmcnt(0)\n\ts_barrier":::"memory")

__device__ __forceinline__ void qkt(f32x16&p0,f32x16&p1,const char*Kslot,const bf16x8*qr,const f32x16&negm,int r32,int hi){
  const char*kb=Kslot+hi*1024+r32*16;
  #pragma unroll
  for(int d0=0;d0<4;++d0){
    const bf16x8 b0=*reinterpret_cast<const bf16x8*>(kb+d0*2048);
    const bf16x8 b1=*reinterpret_cast<const bf16x8*>(kb+d0*2048+512);
    if(d0==0){p0=__builtin_amdgcn_mfma_f32_32x32x16_bf16(b0,qr[0],negm,0,0,0);p1=__builtin_amdgcn_mfma_f32_32x32x16_bf16(b1,qr[0],negm,0,0,0);}
    else{p0=__builtin_amdgcn_mfma_f32_32x32x16_bf16(b0,qr[d0],p0,0,0,0);p1=__builtin_amdgcn_mfma_f32_32x32x16_bf16(b1,qr[d0],p1,0,0,0);}}
}
typedef __attribute__((address_space(3))) const char* lds_cptr;
typedef short v4i16_t __attribute__((ext_vector_type(4)));
__device__ __forceinline__ void kload8(bf16x8*kf,lds_cptr kp){
  kf[0]=*(const __attribute__((address_space(3))) bf16x8*)(kp);      kf[1]=*(const __attribute__((address_space(3))) bf16x8*)(kp+512);
  kf[2]=*(const __attribute__((address_space(3))) bf16x8*)(kp+2048); kf[3]=*(const __attribute__((address_space(3))) bf16x8*)(kp+2560);
  kf[4]=*(const __attribute__((address_space(3))) bf16x8*)(kp+4096); kf[5]=*(const __attribute__((address_space(3))) bf16x8*)(kp+4608);
  kf[6]=*(const __attribute__((address_space(3))) bf16x8*)(kp+6144); kf[7]=*(const __attribute__((address_space(3))) bf16x8*)(kp+6656);
}
__device__ __forceinline__ void kload2(bf16x8*kf,lds_cptr kp,int j){ kf[2*j]=*(const __attribute__((address_space(3))) bf16x8*)(kp+j*2048); kf[2*j+1]=*(const __attribute__((address_space(3))) bf16x8*)(kp+j*2048+512); }
__device__ __forceinline__ s16x4 vtr(lds_cptr p){ return __builtin_bit_cast(s16x4,__builtin_amdgcn_ds_read_tr16_b64_v4i16((__attribute__((address_space(3))) v4i16_t*)p)); }
__device__ __forceinline__ float rowmax(const f32x16&p0,const f32x16&p1){
  float a=max3f(p0[0],p0[1],p1[0]),b=max3f(p0[2],p0[3],p1[1]);a=max3f(a,p1[2],p1[3]);
  #pragma unroll
  for(int r=4;r<16;r+=4){a=max3f(a,p0[r],p0[r+1]);b=max3f(b,p0[r+2],p0[r+3]);a=max3f(a,p1[r],p1[r+1]);b=max3f(b,p1[r+2],p1[r+3]);}
  const float m=max2f(a,b);
  auto rr=__builtin_amdgcn_permlane32_swap(__float_as_uint(m),__float_as_uint(m),false,false);
  return max2f(__uint_as_float(rr[0]),__uint_as_float(rr[1]));
}
__device__ __forceinline__ void pv(f32x16*o,int vb,bf16x8 pa0,bf16x8 pa1,bf16x8 pa2,bf16x8 pa3){
  #pragma unroll
  for(int d0=0;d0<2;++d0){s16x4 lo[4],hi[4];
    #pragma unroll
    for(int ks=0;ks<4;++ks){
      asm volatile("ds_read_b64_tr_b16 %0,%1 offset:%c2":"=&v"(lo[ks]):"v"(vb),"i"(d0*4096+ks*1024):"memory");
      asm volatile("ds_read_b64_tr_b16 %0,%1 offset:%c2":"=&v"(hi[ks]):"v"(vb),"i"(d0*4096+ks*1024+512):"memory");}
    asm volatile("s_waitcnt lgkmcnt(0)":::"memory");SBAR();
    #define PK(k) (bf16x8){lo[k][0],lo[k][1],lo[k][2],lo[k][3],hi[k][0],hi[k][1],hi[k][2],hi[k][3]}
    o[d0]=__builtin_amdgcn_mfma_f32_32x32x16_bf16(pa0,PK(0),o[d0],0,0,0);
    o[d0]=__builtin_amdgcn_mfma_f32_32x32x16_bf16(pa1,PK(1),o[d0],0,0,0);
    o[d0]=__builtin_amdgcn_mfma_f32_32x32x16_bf16(pa2,PK(2),o[d0],0,0,0);
    o[d0]=__builtin_amdgcn_mfma_f32_32x32x16_bf16(pa3,PK(3),o[d0],0,0,0);
    #undef PK
  }
}

#ifndef ATTN_STORE16
#define ATTN_STORE16(p,v) (*(u32x4*)(p)=(v))
#endif
template<int THRL> __device__ __forceinline__ void attn_unit(const long rowbase,const int h,const int q0,const int NT,const bf16*Q,const bf16*__restrict__ K,const bf16*__restrict__ V,bf16*O,char*shm){
  int tid_=threadIdx.x; asm volatile("":"+v"(tid_)); const int tid=tid_,lane=tid&63,r32=lane&31,hi=lane>>5; const int wid=__builtin_amdgcn_readfirstlane(tid>>6);
  const bf16*Qw=Q+(rowbase+q0+wid*QBLK)*QP+h*D;
  const bf16*Kh=K+rowbase*KP+(h>>1)*D,*Vh=V+rowbase*VP+(h>>1)*D;
  const unsigned lds0=(unsigned)(uintptr_t)shm;
  float*wsf=(float*)(shm+LDS_WS)+wid*64;
  const bf16*ksrc=Kh+(long)lane*KP+wid*8;
  const bf16*vsrc=Vh+(long)(16*(wid&3)+(lane>>2))*VP+(wid>>2)*32+(lane&3)*8;
  const unsigned kdst=lds0+LDS_K+wid*1024, vdst=lds0+LDS_V+wid*1024;
  #define DMA_K(t,slot) glds16(ksrc+(long)(t)*KVBLK*KP,(unsigned)__builtin_amdgcn_readfirstlane(kdst+(slot)))
  #define DMA_V(t,slot) glds16(vsrc+(long)(t)*KVBLK*VP,(unsigned)__builtin_amdgcn_readfirstlane(vdst+(slot)))
  const int vb0=(int)(lds0+LDS_V)+((lane>>4)&1)*32+(lane&3)*8+(4*hi+((lane&15)>>2))*64;
  const char*Kbase=shm+LDS_K; bf16x8 kf[8];
  const lds_cptr shm3=(lds_cptr)shm; const lds_cptr kp0=shm3+LDS_K+hi*1024+r32*16; const lds_cptr vp0=shm3+LDS_V+((lane>>4)&1)*32+(lane&3)*8+(4*hi+((lane&15)>>2))*64;
  DMA_K(0,0);DMA_V(0,0);DMA_K(1,SLOTB);
  bf16x8 qr[4];
  #pragma unroll
  for(int d0=0;d0<4;++d0)qr[d0]=*reinterpret_cast<const bf16x8*>(&Qw[(long)r32*QP+d0*16+hi*8]);
  float mhat=0.f,l_reg=0.f;f32x16 o[2];o[0]=f32x16{};o[1]=f32x16{};f32x16 negm=f32x16{};asm volatile("":"+v"(negm));
  #define CMASK(P0,P1,t) do{}while(0)
  bool resc=false;
  #define START(P0,P1) do{ const float rm=rowmax(P0,P1); resc=false; \
    { const float dl=rm; mhat=fadd_s(mhat,dl); \
      _Pragma("unroll") for(int r=0;r<16;++r){P0[r]=fsub_s(P0[r],dl);P1[r]=fsub_s(P1[r],dl);} \
      _Pragma("unroll") for(int r=0;r<16;++r)negm[r]=-mhat; asm volatile("":"+v"(negm)); } \
    _Pragma("unroll") for(int r=0;r<16;++r)P0[r]=__builtin_amdgcn_exp2f(P0[r]); }while(0)
  #define RESC() do{ if(resc){ asm volatile("s_waitcnt lgkmcnt(0)":::"memory"); \
      _Pragma("unroll") for(int d_=0;d_<2;++d_) _Pragma("unroll") for(int r=0;r<16;++r)o[d_][r]*=wsf[crow(r,hi)]; } }while(0)
  f32x16 pA0,pA1,pB0,pB1;
  int sl_prev=0,sl_cur=0,sl_next=SLOTB;
  #define ROT() do{sl_prev=sl_cur;sl_cur=sl_next;sl_next=(sl_next==(NSLOT-1)*SLOTB)?0:sl_next+SLOTB;}while(0)
  DMA_K(2,2*SLOTB);
  WAIT_BAR(3);
  qkt(pA0,pA1,Kbase,qr,negm,r32,hi);asm volatile("s_nop 15\n\ts_nop 7":"+v"(pA0),"+v"(pA1));CMASK(pA0,pA1,0);
  START(pA0,pA1);
  _Pragma("unroll") for(int r=0;r<16;++r)pA1[r]=__builtin_amdgcn_exp2f(pA1[r]);
  WAIT_BAR(0);
  DMA_K(3,0);DMA_V(1,SLOTB);
  ROT();
  kload8(kf,kp0+sl_cur);
  WAIT_BAR(2);
  s16x4 vlo[8],vhi[8]; u32x4 pw0,pw1,pw2,pw3;
  #define PKW(P,B) cvtpk_s(P[B],P[B+1])
  #define PAF(k) __builtin_bit_cast(bf16x8,pw##k)
  #define VFR(i) (bf16x8){vlo[i][0],vlo[i][1],vlo[i][2],vlo[i][3],vhi[i][0],vhi[i][1],vhi[i][2],vhi[i][3]}
  #define PIN(x) asm volatile("":"+v"(x))
  #define MX3(a,b,c) __builtin_fmaxf(__builtin_fmaxf((a),(b)),(c))
  #define GAPA(MF,A0,A1,A2,A3,W0,W1,PW) do{ MF; sacc+=A0; sacc+=A1; sacc+=A2; sacc+=A3; PIN(sacc); W0; W1; PIN(PW); SBAR(); }while(0)
  #define EX(v) __builtin_amdgcn_exp2f(v)
  #define GAPB(MF,X,B) do{ MF; X[B]=EX(X[B]); X[B+1]=EX(X[B+1]); X[B+2]=EX(X[B+2]); X[B+3]=EX(X[B+3]); PIN(X); SBAR(); }while(0)
  #define VRD(i) do{ vlo[i]=vtr(vp_+(((i)>>2)*4096+((i)&3)*1024)); vhi[i]=vtr(vp_+(((i)>>2)*4096+((i)&3)*1024+512)); }while(0)
  #define KRD(G,j) do{ if(G){ kload2(kf,kp0+sl_next,j); SBAR(); } }while(0)
  #define STEP(C0,C1,P0,P1,t,GK,GV,GL) do{ SBAR(); \
    const lds_cptr vp_=vp0+sl_prev; \
    VRD(0); SBAR(); float sacc=(P0[0]+P0[1]); \
    GAPA(C0=__builtin_amdgcn_mfma_f32_32x32x16_bf16(kf[0],qr[0],negm,0,0,0), P0[2],P0[3],P0[4],P0[5],     pw0[0]=PKW(P0,0), pw0[1]=PKW(P0,2), pw0); \
    VRD(4); SBAR(); GAPA(C1=__builtin_amdgcn_mfma_f32_32x32x16_bf16(kf[1],qr[0],negm,0,0,0), P0[6],P0[7],P0[8],P0[9],     pw0[2]=PKW(P0,4), pw0[3]=PKW(P0,6), pw0); \
    VRD(1); SBAR(); GAPA(C0=__builtin_amdgcn_mfma_f32_32x32x16_bf16(kf[2],qr[1],C0,0,0,0),   P0[10],P0[11],P0[12],P0[13], pw1[0]=PKW(P0,8), pw1[1]=PKW(P0,10), pw1); \
    VRD(5); SBAR(); GAPA(C1=__builtin_amdgcn_mfma_f32_32x32x16_bf16(kf[3],qr[1],C1,0,0,0),   P0[14],P0[15],P1[0],P1[1],   pw1[2]=PKW(P0,12),pw1[3]=PKW(P0,14), pw1); \
    VRD(2); SBAR(); GAPA(C0=__builtin_amdgcn_mfma_f32_32x32x16_bf16(kf[4],qr[2],C0,0,0,0),   P1[2],P1[3],P1[4],P1[5],     pw2[0]=PKW(P1,0), pw2[1]=PKW(P1,2), pw2); \
    VRD(6); SBAR(); GAPA(C1=__builtin_amdgcn_mfma_f32_32x32x16_bf16(kf[5],qr[2],C1,0,0,0),   P1[6],P1[7],P1[8],P1[9],     pw2[2]=PKW(P1,4), pw2[3]=PKW(P1,6), pw2); \
    VRD(3); SBAR(); GAPA(C0=__builtin_amdgcn_mfma_f32_32x32x16_bf16(kf[6],qr[3],C0,0,0,0),   P1[10],P1[11],P1[12],P1[13], pw3[0]=PKW(P1,8), pw3[1]=PKW(P1,10), pw3); \
    VRD(7); SBAR(); GAPA(C1=__builtin_amdgcn_mfma_f32_32x32x16_bf16(kf[7],qr[3],C1,0,0,0),   P1[14],P1[15],0.f,0.f,       pw3[2]=PKW(P1,12),pw3[3]=PKW(P1,14), pw3); \
    l_reg+=sacc; \
    if(GK){DMA_K((t)+3,sl_cur);} if(GV){DMA_V((t)+1,sl_next);} \
    CMASK(C0,C1,t); \
    { float a=MX3(C0[0],C0[1],C1[0]),b=MX3(C0[2],C0[3],C1[1]); a=MX3(a,C1[2],C1[3]); \
      _Pragma("unroll") for(int r=4;r<16;r+=4){a=MX3(a,C0[r],C0[r+1]);b=MX3(b,C0[r+2],C0[r+3]);a=MX3(a,C1[r],C1[r+1]);b=MX3(b,C1[r+2],C1[r+3]);} \
      float rm=__builtin_fmaxf(a,b); { auto rr=__builtin_amdgcn_permlane32_swap(__float_as_uint(rm),__float_as_uint(rm),false,false); rm=__builtin_fmaxf(__uint_as_float(rr[0]),__uint_as_float(rr[1])); } \
      resc=false; \
      if(__builtin_expect(__any(rm>(float)THRL),0)){ const float dl=__builtin_fmaxf(rm,0.f); mhat+=dl; \
        _Pragma("unroll") for(int r=0;r<16;++r){C0[r]-=dl;C1[r]-=dl;} \
        _Pragma("unroll") for(int r=0;r<16;++r)negm[r]=-mhat; asm volatile("":"+v"(negm)); \
        const float f=__builtin_amdgcn_exp2f(-dl); l_reg*=f; if(hi==0)wsf[r32]=f; resc=true; } } \
    SBAR(); \
    GAPB(o[0]=__builtin_amdgcn_mfma_f32_32x32x16_bf16(PAF(0),VFR(0),o[0],0,0,0), C0,0); \
    GAPB(o[1]=__builtin_amdgcn_mfma_f32_32x32x16_bf16(PAF(0),VFR(4),o[1],0,0,0), C0,4); \
    KRD(GL,0); GAPB(o[0]=__builtin_amdgcn_mfma_f32_32x32x16_bf16(PAF(1),VFR(1),o[0],0,0,0), C0,8); \
    KRD(GL,1); GAPB(o[1]=__builtin_amdgcn_mfma_f32_32x32x16_bf16(PAF(1),VFR(5),o[1],0,0,0), C0,12); \
    KRD(GL,2); GAPB(o[0]=__builtin_amdgcn_mfma_f32_32x32x16_bf16(PAF(2),VFR(2),o[0],0,0,0), C1,0); \
    KRD(GL,3); GAPB(o[1]=__builtin_amdgcn_mfma_f32_32x32x16_bf16(PAF(2),VFR(6),o[1],0,0,0), C1,4); \
    GAPB(o[0]=__builtin_amdgcn_mfma_f32_32x32x16_bf16(PAF(3),VFR(3),o[0],0,0,0), C1,8); \
    GAPB(o[1]=__builtin_amdgcn_mfma_f32_32x32x16_bf16(PAF(3),VFR(7),o[1],0,0,0), C1,12); \
    }while(0)
  int t=1;
  #undef CMASK
  #define CMASK(P0,P1,t) do{}while(0)
  for(;t+5<NT;t+=2){
    STEP(pB0,pB1,pA0,pA1,t,true,true,true);     WAIT_BAR(2); RESC(); ROT();
    STEP(pA0,pA1,pB0,pB1,t+1,true,true,true);   WAIT_BAR(2); RESC(); ROT();
  }
  #undef CMASK
  #define CMASK(P0,P1,t) do{}while(0)
  #define ENDW(tt) do{ if((tt)+3<NT){WAIT_BAR(2);} else if((tt)+2<NT){WAIT_BAR(1);} else {WAIT_BAR(0);} }while(0)
  for(;t+1<NT;t+=2){
    STEP(pB0,pB1,pA0,pA1,t,(t+3<NT),(t+1<NT),(t+1<NT));       ENDW(t);   RESC(); ROT();
    STEP(pA0,pA1,pB0,pB1,t+1,(t+4<NT),(t+2<NT),(t+2<NT));     ENDW(t+1); RESC(); ROT();
  }
  STEP(pB0,pB1,pA0,pA1,NT-1,false,false,false); RESC();
  { float sacc=pB0[0]+pB0[1]; _Pragma("unroll") for(int r=2;r<16;++r)sacc+=pB0[r]; _Pragma("unroll") for(int r=0;r<16;++r)sacc+=pB1[r]; l_reg+=sacc;
    pw0=(u32x4){PKW(pB0,0),PKW(pB0,2),PKW(pB0,4),PKW(pB0,6)};pw1=(u32x4){PKW(pB0,8),PKW(pB0,10),PKW(pB0,12),PKW(pB0,14)};pw2=(u32x4){PKW(pB1,0),PKW(pB1,2),PKW(pB1,4),PKW(pB1,6)};pw3=(u32x4){PKW(pB1,8),PKW(pB1,10),PKW(pB1,12),PKW(pB1,14)};
    SBAR(); pv(o,vb0+sl_cur,PAF(0),PAF(1),PAF(2),PAF(3)); }
  #undef PKW
  #undef PAF
  #undef VFR
  #undef PIN
  #undef MX3
  #undef GAPA
  #undef GAPB
  #undef EX
  #undef VRD
  #undef KRD
  #undef STEP
  #undef ENDW
  {auto rr=__builtin_amdgcn_permlane32_swap(__float_as_uint(l_reg),__float_as_uint(l_reg),false,false);l_reg=__uint_as_float(rr[0])+__uint_as_float(rr[1]);}
  if(hi==0)wsf[32+r32]=l_reg;asm volatile("s_waitcnt lgkmcnt(0)":::"memory");
  float rli[16];
  #pragma unroll
  for(int r=0;r<16;++r)rli[r]=__builtin_amdgcn_rcpf(wsf[32+crow(r,hi)]);
  bf16*Ow=O+(rowbase+q0+wid*QBLK)*OP+h*D;
  { bf16*stg=(bf16*)(shm+LDS_OST)+wid*2048;
    #pragma unroll
    for(int r=0;r<16;++r){const int orow=crow(r,hi);
      #pragma unroll
      for(int d0=0;d0<2;++d0)stg[orow*64+d0*32+r32]=__float2bfloat16(o[d0][r]*rli[r]);}
    asm volatile("s_waitcnt lgkmcnt(0)":::"memory");
    #pragma unroll
    for(int i=0;i<4;++i){const int row=i*8+(lane>>3),ch=lane&7; const u32x4 v=*(const u32x4*)(stg+row*64+ch*8); ATTN_STORE16(Ow+(long)row*OP+ch*8,v);} }
  asm volatile("s_waitcnt lgkmcnt(0)\n\ts_barrier":::"memory");
  #undef DMA_K
  #undef DMA_V
  #undef CMASK
  #undef START
  #undef RESC
  #undef ROT
}
constexpr int ATTN_LDS_BYTES=LDS_BYTES;
#undef SBAR
#undef WAIT_BAR
}

#define GAS __attribute__((address_space(1)))
#define LAS __attribute__((address_space(3)))
typedef unsigned short bf16;
typedef unsigned v4u __attribute__((ext_vector_type(4)));
typedef float f32x4 __attribute__((ext_vector_type(4)));
typedef short bf16x8 __attribute__((ext_vector_type(8)));
typedef GAS unsigned gu32;
typedef GAS unsigned long long gu64;
#define RLX_AGENT __ATOMIC_RELAXED, __HIP_MEMORY_SCOPE_AGENT
#define LDS_WAIT() asm volatile("s_waitcnt lgkmcnt(0)" ::: "memory")
#define VM_WAIT() asm volatile("s_waitcnt vmcnt(0)" ::: "memory")
__device__ __forceinline__ unsigned long long rt() { return __builtin_amdgcn_s_memrealtime(); }
__device__ __forceinline__ unsigned f2bf(float f) { unsigned u = __builtin_bit_cast(unsigned, f); return (u + 0x7fffu + ((u >> 16) & 1u)) >> 16; }
__device__ __forceinline__ unsigned pk2(float lo, float hi) { return f2bf(lo) | (f2bf(hi) << 16); }

#define XB_TMO      128
#define XB_XCNT(j)  (256  + 64 * (j))
#define XB_XSUB(j)  (1280 + 64 * (j))
#define XB_XGEN(j)  (2304 + 64 * (j))
#define XB_TOP      3328
#define XB_TOPGEN   3392
#define XCD_BAR_WORDS 3456
#define XB_SPIN_CAP (1u << 18)

__device__ __forceinline__ unsigned xb_ld(unsigned* p)              { return __hip_atomic_load(p, __ATOMIC_RELAXED, __HIP_MEMORY_SCOPE_AGENT); }
__device__ __forceinline__ unsigned xb_add(unsigned* p, unsigned v) { return __hip_atomic_fetch_add(p, v, __ATOMIC_RELAXED, __HIP_MEMORY_SCOPE_AGENT); }
__device__ __forceinline__ unsigned xb_xcc_id() { return (unsigned)__builtin_amdgcn_s_getreg((3 << 11) | 20) & 0xFu; }
#define XB_SPIN(cond, bar) do { unsigned _sp = 0; while (cond) { __builtin_amdgcn_s_sleep(1); \
    if ((++_sp & 255u) == 0u) { if (xb_ld(&(bar)[XB_TMO])) break; if (_sp > XB_SPIN_CAP) { atomicAdd(&(bar)[XB_TMO], 1u); break; } } } } while (0)

struct XcdBarrier {
    unsigned* bar; unsigned x;
    volatile LAS unsigned* st;
};

__device__ __forceinline__ XcdBarrier xcd_barrier_post(unsigned* bar, volatile LAS unsigned* st) {
    XcdBarrier b; b.bar = bar; b.x = xb_xcc_id(); b.st = st;
    if (threadIdx.x == 0) (void)xb_add(&bar[XB_XCNT(b.x)], 1u);
    return b;
}
__device__ __forceinline__ void xcd_barrier_complete(unsigned* bar, unsigned x, unsigned& nloc, unsigned& nx) {
    const unsigned G = gridDim.x * gridDim.y * gridDim.z;
    unsigned sum, cnt, mine, sp = 0u;
    for (;;) {
        sum = 0u; cnt = 0u; mine = 0u;
#pragma unroll
        for (unsigned j = 0; j < 16; ++j) { const unsigned c = xb_ld(&bar[XB_XCNT(j)]); sum += c; cnt += (c > 0u) ? 1u : 0u; mine = (j == x) ? c : mine; }
        if (sum == G) break;
        __builtin_amdgcn_s_sleep(1);
        if ((++sp & 255u) == 0u) { if (xb_ld(&bar[XB_TMO])) break; if (sp > XB_SPIN_CAP) { atomicAdd(&bar[XB_TMO], 1u); break; } }
    }
    nloc = mine > 0u ? mine : 1u; nx = cnt > 0u ? cnt : 1u;
}

__device__ __forceinline__ void xcd_barrier(const XcdBarrier& b) {
    asm volatile("s_waitcnt vmcnt(0)" ::: "memory");
    __syncthreads();
    if (threadIdx.x == 0) {
        unsigned* bar = b.bar;
        __builtin_amdgcn_s_waitcnt(0);
        unsigned nloc = b.st[0], nx = b.st[1];
        if (nloc == 0u) { xcd_barrier_complete(bar, b.x, nloc, nx); b.st[0] = nloc; b.st[1] = nx; }
        const unsigned old = xb_add(&bar[XB_XSUB(b.x)], 1u);
        const unsigned gen = old / nloc;
        if (old + 1u == (gen + 1u) * nloc) {
            __builtin_amdgcn_fence(__ATOMIC_RELEASE, "agent");
            asm volatile("s_waitcnt vmcnt(0)" ::: "memory");
            const unsigned og = xb_add(&bar[XB_TOP], 1u);
            const unsigned tg = og / nx;
            if (og + 1u == (tg + 1u) * nx) xb_add(&bar[XB_TOPGEN], 1u);
            else XB_SPIN(xb_ld(&bar[XB_TOPGEN]) == tg, bar);
            __builtin_amdgcn_fence(__ATOMIC_ACQUIRE, "agent");
            xb_add(&bar[XB_XGEN(b.x)], 1u);
            asm volatile("s_waitcnt vmcnt(0)" ::: "memory");
        } else {
            XB_SPIN(xb_ld(&bar[XB_XGEN(b.x)]) == gen, bar);
            __builtin_amdgcn_fence(__ATOMIC_ACQUIRE, "agent");
            asm volatile("s_waitcnt vmcnt(0)" ::: "memory");
        }
    }
    __syncthreads();
}

__device__ __forceinline__ float bf2f(unsigned short h) { return __builtin_bit_cast(float, (unsigned)h << 16); }
__device__ __forceinline__ float bflo(unsigned w) { return __builtin_bit_cast(float, w << 16); }
__device__ __forceinline__ float bfhi(unsigned w) { return __builtin_bit_cast(float, w & 0xffff0000u); }
__device__ __forceinline__ float wave_sum(float v) {
    v += __builtin_bit_cast(float, __builtin_amdgcn_update_dpp(0, __builtin_bit_cast(int, v), 0xB1, 0xf, 0xf, false));
    v += __builtin_bit_cast(float, __builtin_amdgcn_update_dpp(0, __builtin_bit_cast(int, v), 0x4E, 0xf, 0xf, false));
    v += __builtin_bit_cast(float, __builtin_amdgcn_update_dpp(0, __builtin_bit_cast(int, v), 0x141, 0xf, 0xf, false));
    v += __builtin_bit_cast(float, __builtin_amdgcn_update_dpp(0, __builtin_bit_cast(int, v), 0x140, 0xf, 0xf, false));
    v += __builtin_bit_cast(float, __builtin_amdgcn_update_dpp(0, __builtin_bit_cast(int, v), 0x142, 0xa, 0xf, false));
    v += __builtin_bit_cast(float, __builtin_amdgcn_update_dpp(0, __builtin_bit_cast(int, v), 0x143, 0xc, 0xf, false));
    return __builtin_bit_cast(float, __builtin_amdgcn_readlane(__builtin_bit_cast(int, v), 63));
}
__device__ __forceinline__ float sigmoidf_(float x) { return __builtin_amdgcn_rcpf(1.0f + __expf(-x)); }
typedef float f32x16 __attribute__((ext_vector_type(16)));

struct Frame {
    LAS unsigned char* lds;
    volatile LAS unsigned* MISC;
    unsigned char* ws;
    int tid, lane, wave, vcu, G;
};
struct TrItem { const float* W; bf16* WT; int ldw, k0, sc0, ldt, dr0; };
__device__ __forceinline__ void p0_tr_load(const TrItem& q, int lane, f32x4 (&t)[8]) {
#pragma unroll
    for (int i = 0; i < 8; ++i) t[i] = *(const f32x4*)(q.W + (size_t)(q.k0 + 8 * (lane >> 3) + i) * q.ldw + q.sc0 + 4 * (lane & 7));
}
__device__ __forceinline__ void p0_tr_finish(const TrItem& q, const f32x4 (&t)[8], LAS float* scr, int lane) {
#pragma unroll
    for (int e = 0; e < 4; ++e) { v4u o; o.x = pk2(t[0][e], t[1][e]); o.y = pk2(t[2][e], t[3][e]); o.z = pk2(t[4][e], t[5][e]); o.w = pk2(t[6][e], t[7][e]);
        *(GAS v4u*)(q.WT + (size_t)(q.dr0 + 4 * (lane & 7) + e) * q.ldt + q.k0 + 8 * (lane >> 3)) = o; }
}
__device__ __forceinline__ void s0_prologue(Frame& F) {
    LAS float* scr = (LAS float*)(F.lds + RING_OFF + F.wave * 16384);
    const int gw = F.vcu * NWAVES + F.wave, NGW = F.G * NWAVES, lane = F.lane;
    unsigned char* ws = F.ws;
    {
        float* modpart = (float*)(ws + SM_MODPART);
        for (int it = gw; it < DEPTH * 16 * 24; it += NGW) {
            const int l = it / (16 * 24), kc = (it / 24) % 16, jb = it % 24, j0 = jb * 256 + 4 * lane, k0 = kc * 64;
            const float c0 = inptr(F.lds, IN_C)[k0 + lane], c1 = inptr(F.lds, IN_C)[1024 + k0 + lane], c2 = inptr(F.lds, IN_CCTX)[k0 + lane];
            const float s0 = c0 * sigmoidf_(c0), s1 = c1 * sigmoidf_(c1), s2 = c2 * sigmoidf_(c2);
            f32x4 a0 = {0.f, 0.f, 0.f, 0.f}, a1 = a0, a2 = a0;
            const float* wp = inptr(F.lds, IN_WMOD) + ((size_t)l * 1024 + k0) * 6144 + j0;
#pragma unroll 16
            for (int kk = 0; kk < 64; ++kk) { const f32x4 w = *(const f32x4*)(wp + (size_t)kk * 6144);
                a0 += w * __shfl(s0, kk); a1 += w * __shfl(s1, kk); a2 += w * __shfl(s2, kk); }
            float* mp = modpart + ((size_t)(l * 16 + kc) * 3) * 6144 + j0;
            *(f32x4*)mp = a0; *(f32x4*)(mp + 6144) = a1; *(f32x4*)(mp + 2 * 6144) = a2;
        }
    }
    {
        constexpr int I_WINA = 16 * 16, I_WINB = 24 * 16, I_WFI = 176 * 16, I_WFO = 32 * 44, I_WO = 32 * 4, I_L = I_WINA + I_WINB + I_WFI + I_WFO + I_WO;
        auto decode = [&](int it) { TrItem q;
            const int l = it / I_L; int r = it % I_L;
            bf16* WinT = (bf16*)(ws + WS_WIN + l * WIN_STRIDE); bf16* WoT = (bf16*)(ws + WS_WO + l * WO_STRIDE);
            bf16* WfiT = (bf16*)(ws + WS_WFI + l * WFI_STRIDE); bf16* WfoT = (bf16*)(ws + WS_WFO + l * WFO_STRIDE);
            const float* w_in = inptr(F.lds, IN_WIN) + (size_t)l * 1024 * DIN0;
            if (r < I_WINA) { const int kb = r / 16, nb = r % 16; q = TrItem{w_in, WinT, DIN0, 64 * kb, 32 * nb, 1024, (nb >> 3) * 256 + (nb & 1) * 128 + ((nb >> 1) & 3) * 32}; return q; } r -= I_WINA;
            if (r < I_WINB) { const int kb = r / 24, nb = r % 24; q = TrItem{w_in, WinT, DIN0, 64 * kb, 768 + 32 * nb, 1024, 1024 + 32 * nb}; return q; } r -= I_WINB;
            if (r < I_WFI) { const int kb = r / 176, nb = r % 176, d0 = 32 * nb, pn = d0 >> 8, hb = (d0 >> 7) & 1, i0 = d0 & 127;
                q = TrItem{inptr(F.lds, IN_WFI) + (size_t)l * 1024 * 2 * DFF, WfiT, 2 * DFF, 64 * kb, hb * DFF + 128 * pn + i0, 1024, d0}; return q; } r -= I_WFI;
            if (r < I_WFO) { const int kb = r / 32, nb = r % 32; q = TrItem{inptr(F.lds, IN_WFO) + (size_t)l * DFF * 1024, WfoT, 1024, 64 * kb, 32 * nb, DFF, 32 * nb}; return q; } r -= I_WFO;
            { const int kb = r / 32, nb = r % 32; q = TrItem{inptr(F.lds, IN_WO) + (size_t)l * 1024 * 1024, WoT, 1024, 64 * kb, 32 * nb, 1024, 32 * nb}; return q; } };
        const int gA = (3 * NGW) / 8, gB = (5 * NGW) / 8, NIT = DEPTH * I_L, cut = (NIT * 10) / 13;
        const int t_lo = gw < gA ? gw : (gw < gB ? cut + (gw - gA) : NIT), t_hi = gw < gA ? cut : NIT, t_st = gw < gA ? gA : gB - gA;
        for (int it = t_lo; it < t_hi; it += 4 * t_st) {
            TrItem q[4]; bool ok[4]; f32x4 t[4][8];
#pragma unroll
            for (int u = 0; u < 4; ++u) { ok[u] = it + u * t_st < t_hi; q[u] = decode(ok[u] ? it + u * t_st : it); }
#pragma unroll
            for (int u = 0; u < 4; ++u) if (ok[u]) p0_tr_load(q[u], lane, t[u]);
#pragma unroll
            for (int u = 0; u < 4; ++u) if (ok[u]) p0_tr_finish(q[u], t[u], scr, lane);
        }
    }
    {
        LAS float* tab = scr;
        { float sn, cs; sincospif((float)lane * (1.0f / 32.0f), &sn, &cs); tab[lane] = cs; tab[64 + lane] = sn; }
        LDS_WAIT(); asm volatile("" ::: "memory");
        if (gw >= (3 * NGW) / 8 && gw < (5 * NGW) / 8) for (int it = gw - (3 * NGW) / 8; it < DEPTH * 256; it += (5 * NGW) / 8 - (3 * NGW) / 8) {
            const int l = it / 256, kb = (it / 16) % 16, h = (it / 4) % 4, cq = it % 4, k = kb * 64 + lane;
            const float* src = inptr(F.lds, IN_WIN) + ((size_t)l * 1024 + k) * DIN0 + 512 + h * 64;
            float u[64];
#pragma unroll
            for (int c = 0; c < 16; ++c) { const f32x4 t = *(const f32x4*)(src + 4 * c); u[4 * c] = t[0]; u[4 * c + 1] = t[1]; u[4 * c + 2] = t[2]; u[4 * c + 3] = t[3]; }
            bf16* WinT = (bf16*)(ws + WS_WIN + l * WIN_STRIDE);
            for (int cp = 16 * cq; cp < 16 * cq + 16; ++cp) { float ar = 0.f, ai = 0.f;
#pragma unroll
                for (int c = 0; c < 64; ++c) { const int j = (c * cp) & 63; ar += u[c] * tab[j]; ai -= u[c] * tab[64 + j]; }
                WinT[(size_t)(512 + h * 64 + cp) * 1024 + k] = (bf16)f2bf(ar); WinT[(size_t)(768 + h * 64 + cp) * 1024 + k] = (bf16)f2bf(ai); }
        }
        LDS_WAIT(); asm volatile("" ::: "memory");
    }
    if (gw >= (5 * NGW) / 8) for (int it = gw - (5 * NGW) / 8; it < DEPTH * 96 * 4; it += NGW - (5 * NGW) / 8) {
        const int l = it / (96 * 4), ib = (it / 4) % 96, nb = it % 4, i0 = ib * 8, n0 = nb * 256 + 4 * lane;
        const int br = i0 >> 8;
        const float* wo = inptr(F.lds, IN_WO) + (size_t)l * 1024 * 1024;
        f32x4 acc[8];
#pragma unroll
        for (int q = 0; q < 8; ++q) acc[q] = (f32x4){0.f, 0.f, 0.f, 0.f};
        if (br < 2) { const float* wx = (br == 0 ? inptr(F.lds, IN_WF) : inptr(F.lds, IN_WPW)) + (size_t)l * 65536 + (size_t)(i0 & 255) * 256;
#pragma unroll
            for (int q = 0; q < 8; ++q) *(LAS f32x4*)(scr + q * 256 + 4 * lane) = *(const f32x4*)(wx + q * 256 + 4 * lane);
            LDS_WAIT(); asm volatile("" ::: "memory");
            const float* wrow = wo + (size_t)(256 + br * 256) * 1024 + n0;
#pragma unroll 2
            for (int j = 0; j < 256; j += 4) { f32x4 w[4];
#pragma unroll
                for (int e = 0; e < 4; ++e) w[e] = *(const f32x4*)(wrow + (size_t)(j + e) * 1024);
#pragma unroll
                for (int q = 0; q < 8; ++q) { const f32x4 x = *(const LAS f32x4*)(scr + q * 256 + j); acc[q] += w[0] * x[0]; acc[q] += w[1] * x[1]; acc[q] += w[2] * x[2]; acc[q] += w[3] * x[3]; } }
        } else { const int g = (i0 - 512) >> 6, c0 = (i0 - 512) & 63;
            const float* wx = inptr(F.lds, IN_WPL) + (size_t)l * 4 * 4096 + (size_t)g * 4096 + (size_t)c0 * 64; const float* ps = inptr(F.lds, IN_PLS) + l * 256 + g * 64;
            { const float sv = ps[lane];
#pragma unroll
              for (int q = 0; q < 8; ++q) scr[q * 64 + lane] = wx[q * 64 + lane] * sv; }
            LDS_WAIT(); asm volatile("" ::: "memory");
            const float* wrow = wo + (size_t)(768 + g * 64) * 1024 + n0;
#pragma unroll 2
            for (int j = 0; j < 64; j += 4) { f32x4 w[4];
#pragma unroll
                for (int e = 0; e < 4; ++e) w[e] = *(const f32x4*)(wrow + (size_t)(j + e) * 1024);
#pragma unroll
                for (int q = 0; q < 8; ++q) { const f32x4 x = *(const LAS f32x4*)(scr + q * 64 + j); acc[q] += w[0] * x[0]; acc[q] += w[1] * x[1]; acc[q] += w[2] * x[2]; acc[q] += w[3] * x[3]; } }
        }
        LDS_WAIT(); asm volatile("" ::: "memory");
        bf16* WoT = (bf16*)(ws + WS_WO + l * WO_STRIDE);
#pragma unroll
        for (int e = 0; e < 4; ++e) { v4u o; o.x = pk2(acc[0][e], acc[1][e]); o.y = pk2(acc[2][e], acc[3][e]); o.z = pk2(acc[4][e], acc[5][e]); o.w = pk2(acc[6][e], acc[7][e]);
            *(GAS v4u*)(WoT + (size_t)(n0 + e) * 1024 + 256 + i0) = o; }
    }
    {
        const int gt = (F.vcu * NWAVES + F.wave) * 64 + lane, NGT = NGW * 64;
        float* rope = (float*)(ws + SM_ROPE); float* tw = (float*)(ws + SM_TW);
        bf16* M1 = (bf16*)(ws + SM_M1); bf16* M2 = (bf16*)(ws + SM_M2); bf16* M3 = (bf16*)(ws + SM_M3);
        for (int i = gt; i < 128 * 16; i += NGT) { const int p = i >> 4, f = i & 15; const float inv = powf(10000.0f, -(float)f * (1.0f / 16.0f)); const float a = (float)p * inv;
            rope[2 * i] = cosf(a); rope[2 * i + 1] = sinf(a); }
        for (int i = gt; i < 8192; i += NGT) { float sn, cs; sincospif((float)i * (1.0f / 4096.0f), &sn, &cs); tw[2 * i] = cs; tw[2 * i + 1] = sn; }
        for (int i = gt; i < 2 * 128 * 128; i += NGT) { const int sel = i >> 14, k1 = (i >> 7) & 127, t1 = i & 127;
            float sn, cs; sincospif((float)((k1 * t1) & 127) * (1.0f / 64.0f), &sn, &cs); M1[i] = (bf16)f2bf(sel ? sn : cs); }
        for (int i = gt; i < 64 * 128; i += NGT) { const int k2 = i >> 7, k = i & 127, t2 = k >> 1, ri = k & 1;
            float sn, cs; sincospif((float)((k2 * t2) & 63) * (1.0f / 32.0f), &sn, &cs); M2[i] = (bf16)f2bf(ri ? sn : cs); }
        for (int i = gt; i < 256 * 512; i += NGT) { const int kq = i >> 9, k = i & 511, ri = k >> 8, t = k & 255;
            float sn, cs; sincospif((float)((kq * t) & 255) * (1.0f / 128.0f), &sn, &cs); M3[i] = (bf16)f2bf(ri ? sn : cs); }
    }
}
__device__ __forceinline__ void s0b_modsum(Frame& F) {
    const int gt = (F.vcu * NWAVES + F.wave) * 64 + F.lane, NGT = F.G * NWAVES * 64;
    const float* modpart = (const float*)(F.ws + SM_MODPART); float* mod = (float*)(F.ws + WS_CTL + CTL_MOD); const float* bm = inptr(F.lds, IN_BMOD);
    for (int i = gt; i < DEPTH * 3 * 6144; i += NGT) { const int l = i / (3 * 6144), v = (i / 6144) % 3, j = i % 6144; float s = bm[l * 6144 + j];
#pragma unroll
        for (int kc = 0; kc < 16; ++kc) s += modpart[((size_t)(l * 16 + kc) * 3 + v) * 6144 + j];
        mod[i] = s; }
}
__device__ __forceinline__ void s1_prologue(Frame& F) {
    const int gw = F.vcu * NWAVES + F.wave, NGW = F.G * NWAVES, lane = F.lane;
    unsigned char* ws = F.ws;
    const float* mod = (const float*)(ws + WS_CTL + CTL_MOD);
    {
        bf16* ACT = (bf16*)(ws + WS_ACT); float* rss = (float*)(ws + WS_RPART);
        auto xptr = [&](int r) { const int b = r / SPB, rr = r % SPB; return rr < CTXL ? inptr(F.lds, IN_CTX) + ((size_t)b * CTXL + rr) * DM : inptr(F.lds, IN_X) + ((size_t)b * SEQ + rr - CTXL) * DM; };
        f32x4 xv[4], xn[4];
#pragma unroll
        for (int j = 0; j < 4; ++j) xv[j] = (f32x4){0.f, 0.f, 0.f, 0.f};
        if (gw < R) { const float* xrow = xptr(gw);
#pragma unroll
            for (int j = 0; j < 4; ++j) xv[j] = *(const f32x4*)(xrow + 4 * lane + 256 * j); }
        const float* g1p = inptr(F.lds, IN_G1);
        for (int r = gw; r < R; r += NGW) {
            const int b = r / SPB, rr = r % SPB, v = rr < CTXL ? 2 : b;
#pragma unroll
            for (int j = 0; j < 4; ++j) xn[j] = xv[j];
            if (r + NGW < R) { const float* xrow = xptr(r + NGW);
#pragma unroll
                for (int j = 0; j < 4; ++j) xn[j] = *(const f32x4*)(xrow + 4 * lane + 256 * j); }
            float s = 0.f; unsigned long long o[4];
#pragma unroll
            for (int j = 0; j < 4; ++j) { const int c = 4 * lane + 256 * j; const f32x4 x = xv[j];
                const f32x4 g = *(const f32x4*)(g1p + c) * (*(const f32x4*)(mod + v * 6144 + 1024 + c) + 1.0f);
                s += (x[0] * x[0] + x[1] * x[1]) + (x[2] * x[2] + x[3] * x[3]); const f32x4 a = x * g;
                o[j] = (unsigned long long)pk2(a[0], a[1]) | ((unsigned long long)pk2(a[2], a[3]) << 32); }
            s = wave_sum(s);
#pragma unroll
            for (int j = 0; j < 4; ++j) *(unsigned long long*)(ACT + (size_t)r * DM + 4 * lane + 256 * j) = o[j];
            if (lane < 16) rss[(size_t)r * 16 + lane] = lane == 0 ? s : 0.f;
#pragma unroll
            for (int j = 0; j < 4; ++j) xv[j] = xn[j];
        }
    }
#pragma unroll 1
    for (int grp = 0; grp < 2 * DEPTH; ++grp) {
        const int l = grp >> 1; const bool isin = (grp & 1) == 0; const int ncol = isin ? NIN : 2 * DFF;
        const float* sh = mod + (size_t)l * 3 * 6144 + (isin ? 0 : 3072);
        f32x4 sv[3][4];
#pragma unroll
        for (int v = 0; v < 3; ++v)
#pragma unroll
            for (int j = 0; j < 2; ++j) { sv[v][2 * j] = *(const f32x4*)(sh + v * 6144 + 8 * lane + 512 * j); sv[v][2 * j + 1] = *(const f32x4*)(sh + v * 6144 + 8 * lane + 512 * j + 4); }
        const bf16* wbase = isin ? (const bf16*)(ws + WS_WIN + l * WIN_STRIDE) : (const bf16*)(ws + WS_WFI + l * WFI_STRIDE);
        float* dst = isin ? (float*)(ws + SM_BIN) + (size_t)l * 3 * NIN : (float*)(ws + SM_BFF) + (size_t)l * 3 * 2 * DFF;
        for (int n0 = gw; n0 < ncol; n0 += 4 * NGW) {
            v4u w[4][2];
#pragma unroll
            for (int u = 0; u < 4; ++u) { const int n = n0 + u * NGW;
#pragma unroll
                for (int j = 0; j < 2; ++j) { w[u][j] = (v4u){0u, 0u, 0u, 0u}; if (n < ncol) w[u][j] = *(const GAS v4u*)(wbase + (size_t)n * 1024 + 8 * lane + 512 * j); } }
#pragma unroll
            for (int u = 0; u < 4; ++u) { const int n = n0 + u * NGW;
                if (n < ncol) { float a[3] = {0.f, 0.f, 0.f};
#pragma unroll
                    for (int j = 0; j < 2; ++j) { const v4u ww = w[u][j];
                        const f32x4 lo = {bflo(ww.x), bfhi(ww.x), bflo(ww.y), bfhi(ww.y)}, hi = {bflo(ww.z), bfhi(ww.z), bflo(ww.w), bfhi(ww.w)};
#pragma unroll
                        for (int v = 0; v < 3; ++v) { const f32x4 p = lo * sv[v][2 * j] + hi * sv[v][2 * j + 1]; a[v] += (p[0] + p[1]) + (p[2] + p[3]); } }
                    const float r0 = wave_sum(a[0]), r1 = wave_sum(a[1]), r2 = wave_sum(a[2]);
                    if (lane == 0) { dst[n] = r0; dst[ncol + n] = r1; dst[2 * ncol + n] = r2; } } }
        }
    }
}
__device__ __forceinline__ void unpack8(const v4u w, float (&x)[8]) { x[0] = bflo(w.x); x[1] = bfhi(w.x); x[2] = bflo(w.y); x[3] = bfhi(w.y); x[4] = bflo(w.z); x[5] = bfhi(w.z); x[6] = bflo(w.w); x[7] = bfhi(w.w); }
__device__ __forceinline__ void p2_qkv(Frame& F, int l) {
    const int gw = F.vcu * NWAVES + F.wave, NGW = F.G * NWAVES, lane = F.lane;
    unsigned char* ws = F.ws;
    const bf16* P = (const bf16*)(ws + WS_P); bf16* Q = (bf16*)(ws + WS_Q); bf16* K = (bf16*)(ws + WS_K); bf16* V = (bf16*)(ws + WS_V);
    const float* rope = (const float*)(ws + SM_ROPE);
    const int head = lane >> 3, sub = lane & 7;
    float g[8];
#pragma unroll
    for (int j = 0; j < 8; ++j) g[j] = head < 4 ? inptr(F.lds, IN_QG)[l * 64 + sub * 8 + j] * QSCALE : (head < 6 ? inptr(F.lds, IN_KG)[l * 64 + sub * 8 + j] : 1.0f);
    auto fetch = [&](int rr_, v4u& w, f32x4& c0, f32x4& c1) {
        w = *(const GAS v4u*)(P + (size_t)rr_ * NIN + lane * 8);
        const int rr = rr_ % SPB; const int t = rr >= CTXL ? rr - CTXL : 0; const int pos = sub < 4 ? (t >> 6) : (t & 63);
        const float* cs = rope + ((size_t)pos * 16 + (sub & 3) * 4) * 2; c0 = *(const f32x4*)cs; c1 = *(const f32x4*)(cs + 4); };
    auto process = [&](int r, const v4u raw, const f32x4 cs0, const f32x4 cs1) {
        const int rr = r % SPB;
        float x[8]; unpack8(raw, x);
        if (head < 6) {
            float ss = 0.f;
#pragma unroll
            for (int j = 0; j < 8; ++j) ss += x[j] * x[j];
            ss += __shfl_xor(ss, 1); ss += __shfl_xor(ss, 2); ss += __shfl_xor(ss, 4);
            const float rs = rsqrtf(ss * (1.0f / 64.0f) + EPS);
#pragma unroll
            for (int j = 0; j < 8; ++j) x[j] = x[j] * rs * g[j];
            if (rr >= CTXL) { const float cc[4] = {cs0[0], cs0[2], cs1[0], cs1[2]}, sn[4] = {cs0[1], cs0[3], cs1[1], cs1[3]};
#pragma unroll
                for (int p = 0; p < 4; ++p) { const float x0 = x[2 * p], x1 = x[2 * p + 1]; x[2 * p] = x0 * cc[p] - x1 * sn[p]; x[2 * p + 1] = x0 * sn[p] + x1 * cc[p]; } }
        }
        v4u o; o.x = pk2(x[0], x[1]); o.y = pk2(x[2], x[3]); o.z = pk2(x[4], x[5]); o.w = pk2(x[6], x[7]);
        bf16* dst = head < 4 ? Q + (size_t)r * 256 + lane * 8 : (head < 6 ? K + (size_t)r * 128 + (lane - 32) * 8 : V + (size_t)r * 128 + (lane - 48) * 8);
        *(GAS v4u*)dst = o; };
    v4u raw[4], rawn[4]; f32x4 c0[4], c1[4], c0n[4], c1n[4];
#pragma unroll
    for (int q = 0; q < 4; ++q) { raw[q] = (v4u){0u, 0u, 0u, 0u}; c0[q] = (f32x4){1.f, 0.f, 1.f, 0.f}; c1[q] = c0[q]; const int r = gw + q * NGW; if (r < R) fetch(r, raw[q], c0[q], c1[q]); }
    for (int rb = gw; rb < R; rb += 4 * NGW) {
#pragma unroll
        for (int q = 0; q < 4; ++q) { rawn[q] = raw[q]; c0n[q] = c0[q]; c1n[q] = c1[q]; const int r = rb + (4 + q) * NGW; if (r < R) fetch(r, rawn[q], c0n[q], c1n[q]); }
#pragma unroll
        for (int q = 0; q < 4; ++q) { const int r = rb + q * NGW; if (r < R) process(r, raw[q], c0[q], c1[q]); }
#pragma unroll
        for (int q = 0; q < 4; ++q) { raw[q] = rawn[q]; c0[q] = c0n[q]; c1[q] = c1n[q]; }
    }
}
template <int TPW  > __device__ __forceinline__ void p2_convpool_unit(Frame& F, int l, const int r0) {
    constexpr int NT = 8 * TPW, CR = NT + 30, PR = NT + 16, CI = (CR * 32 + 511) / 512, PI = (PR * 32) / 512; static_assert((PR * 32) % 512 == 0, "pool fill");
    unsigned char* ws = F.ws; const int tid = F.tid, lane = F.lane, w = F.wave;
    const bf16* P = (const bf16*)(ws + WS_P); bf16* MIX = (bf16*)(ws + WS_MIX);
    LAS float* buf = (LAS float*)(F.lds + RING_OFF);
    LAS float* pbuf = buf + CR * 256;
    const int b = r0 / SPB, rr0 = r0 % SPB;
    const int seq_lo = rr0 < CTXL ? b * SPB : b * SPB + CTXL, seq_hi = rr0 < CTXL ? b * SPB + CTXL : (b + 1) * SPB;
    v4u a8[CI], g8[CI], p8[PI];
#pragma unroll
    for (int it = 0; it < CI; ++it) { const int idx = tid + it * 512, ri = idx >> 5, cg = idx & 31, r = r0 - 15 + ri;
        a8[it] = (v4u){0u, 0u, 0u, 0u}; g8[it] = a8[it];
        if (idx < CR * 32 && r >= seq_lo && r < seq_hi) { a8[it] = *(const GAS v4u*)(P + (size_t)r * NIN + 1024 + cg * 8); g8[it] = *(const GAS v4u*)(P + (size_t)r * NIN + 1280 + cg * 8); } }
#pragma unroll
    for (int it = 0; it < PI; ++it) { const int idx = tid + it * 512, ri = idx >> 5, cg = idx & 31, r = r0 - 8 + ri;
        p8[it] = (v4u){0u, 0u, 0u, 0u};
        if (r >= seq_lo && r < seq_hi) p8[it] = *(const GAS v4u*)(P + (size_t)r * NIN + 1536 + cg * 8); }
#pragma unroll
    for (int it = 0; it < CI; ++it) { const int idx = tid + it * 512, ri = idx >> 5, cg = idx & 31;
        if (idx < CR * 32) { float a[8], g[8]; unpack8(a8[it], a); unpack8(g8[it], g);
            *(LAS f32x4*)(buf + ri * 256 + cg * 8) = (f32x4){a[0] * sigmoidf_(g[0]), a[1] * sigmoidf_(g[1]), a[2] * sigmoidf_(g[2]), a[3] * sigmoidf_(g[3])};
            *(LAS f32x4*)(buf + ri * 256 + cg * 8 + 4) = (f32x4){a[4] * sigmoidf_(g[4]), a[5] * sigmoidf_(g[5]), a[6] * sigmoidf_(g[6]), a[7] * sigmoidf_(g[7])}; } }
#pragma unroll
    for (int it = 0; it < PI; ++it) { const int idx = tid + it * 512, ri = idx >> 5, cg = idx & 31; *(LAS v4u*)((LAS unsigned char*)pbuf + (ri * 256 + cg * 8) * 2) = p8[it]; }
    const float* dww = inptr(F.lds, IN_DWW) + (size_t)l * 31 * 256 + 4 * lane;
    f32x4 wt[31];
#pragma unroll
    for (int j = 0; j < 31; ++j) wt[j] = *(const f32x4*)(dww + j * 256);
    const f32x4 bias = *(const f32x4*)(inptr(F.lds, IN_DWB) + l * 256 + 4 * lane);
    const f32x4 lng = *(const f32x4*)(inptr(F.lds, IN_LNG) + l * 256 + 4 * lane), lnb = *(const f32x4*)(inptr(F.lds, IN_LNB) + l * 256 + 4 * lane);
    __syncthreads();
    {
        f32x4 acc[TPW];
#pragma unroll
        for (int o = 0; o < TPW; ++o) acc[o] = bias;
#pragma unroll
        for (int i = 0; i < TPW + 30; ++i) { const f32x4 v = *(const LAS f32x4*)(buf + (w * TPW + i) * 256 + 4 * lane);
#pragma unroll
            for (int o = 0; o < TPW; ++o) { const int j = i - o; if (j >= 0 && j < 31) acc[o] += v * wt[j]; } }
#pragma unroll
        for (int o = 0; o < TPW; ++o) { const f32x4 a = acc[o];
            const float mean = wave_sum((a[0] + a[1]) + (a[2] + a[3])) * (1.0f / 256.0f); const f32x4 d = a - mean;
            const float var = wave_sum((d[0] * d[0] + d[1] * d[1]) + (d[2] * d[2] + d[3] * d[3])) * (1.0f / 256.0f);
            f32x4 y = d * rsqrtf(var + EPS) * lng + lnb;
#pragma unroll
            for (int q = 0; q < 4; ++q) y[q] = y[q] * sigmoidf_(y[q]);
            *(unsigned long long*)(MIX + (size_t)(r0 + w * TPW + o) * 1024 + 512 + 4 * lane) = (unsigned long long)pk2(y[0], y[1]) | ((unsigned long long)pk2(y[2], y[3]) << 32); }
    }
    {
        const LAS unsigned char* pb = (const LAS unsigned char*)pbuf;
        const int win = 2 << (lane >> 4), half = win >> 1;
#pragma unroll
        for (int o = 0; o < TPW; ++o) { const int t = r0 + w * TPW + o;
            int lo = t - half, hi = t - half + win; lo = lo < seq_lo ? seq_lo : lo; hi = hi > seq_hi ? seq_hi : hi;
            f32x4 s = {0.f, 0.f, 0.f, 0.f};
#pragma unroll
            for (int j = 0; j < 16; ++j) { if (j < win) { const u32x2_t q = *(const LAS u32x2_t*)(pb + ((t - half + j - r0 + 8) * 256 + 4 * lane) * 2); s += (f32x4){bflo(q.x), bfhi(q.x), bflo(q.y), bfhi(q.y)}; } }
            const u32x2_t q = *(const LAS u32x2_t*)(pb + ((t - r0 + 8) * 256 + 4 * lane) * 2); const f32x4 self = {bflo(q.x), bfhi(q.x), bflo(q.y), bfhi(q.y)};
            const f32x4 y = s * (1.0f / (float)(hi - lo)) - self;
            *(unsigned long long*)(MIX + (size_t)t * 1024 + 768 + 4 * lane) = (unsigned long long)pk2(y[0], y[1]) | ((unsigned long long)pk2(y[2], y[3]) << 32); }
    }
    __syncthreads();
}
#define MFMA32(a, b, c) __builtin_amdgcn_mfma_f32_32x32x16_bf16(a, b, c, 0, 0, 0)
__device__ __forceinline__ void tr8x8(const v4u (&in)[8], v4u (&out)[8]) {
#pragma unroll
    for (int j = 0; j < 8; ++j) {
        unsigned d[4];
#pragma unroll
        for (int m = 0; m < 4; ++m) { const unsigned a = in[2 * m][j >> 1], b = in[2 * m + 1][j >> 1]; d[m] = (j & 1) ? ((a >> 16) | (b & 0xffff0000u)) : ((a & 0xffffu) | (b << 16)); }
        out[j] = (v4u){d[0], d[1], d[2], d[3]}; }
}
constexpr int F1_ZT = 0, F1_C = 67584, F1_S = F1_C + 34816, F1_END = F1_S + 34816;
static_assert(F1_END <= LDSCTL_OFF, "f1 LDS");
__device__ __forceinline__ void f1_unit(Frame& F, int unit) {
    unsigned char* ws = F.ws; const int tid = F.tid, lane = F.lane, w = F.wave, r = lane & 31, h = lane >> 5;
    const int b = unit >> 7, t2 = (unit >> 1) & 63, ch = unit & 1;
    const bf16* P = (const bf16*)(ws + WS_P); bf16* GP = (bf16*)(ws + WS_GP); const bf16* CS = (const bf16*)(ws + SM_M1); const float* tw = (const float*)(ws + SM_TW);
    LAS bf16* ZT = (LAS bf16*)(F.lds + F1_ZT); LAS bf16* Cl = (LAS bf16*)(F.lds + F1_C);
    const int nt = w & 3, mh = w >> 2;
    {
        const int kb = tid >> 4, pc = tid & 15, ri = kb >> 4;
        v4u in[8], out[8], tb[8];
#pragma unroll
        for (int i = 0; i < 8; ++i) { const int t1 = (kb * 8 + i) & 127; const size_t row = (size_t)b * SPB + CTXL + t1 * 64 + t2;
            in[i] = *(const GAS v4u*)(P + row * NIN + 512 + ri * 256 + ch * 128 + pc * 8); }
#pragma unroll
        for (int i = 0; i < 8; ++i) tb[i] = *(const GAS v4u*)(CS + (size_t)(tid + i * 512) * 8);
        tr8x8(in, out);
#pragma unroll
        for (int j = 0; j < 8; ++j) *(LAS v4u*)(ZT + (pc * 8 + j) * 264 + kb * 8) = out[j];
#pragma unroll
        for (int i = 0; i < 8; ++i) { const int c = tid + i * 512; *(LAS v4u*)(Cl + (c >> 4) * 136 + (c & 15) * 8) = tb[i]; }
    }
    float twc[2][16], tws[2][16];
#pragma unroll
    for (int pi = 0; pi < 2; ++pi)
#pragma unroll
        for (int q = 0; q < 16; ++q) { const int k1 = (2 * mh + pi) * 32 + (q & 3) + 8 * (q >> 2) + 4 * h; const float* p = tw + 2 * (t2 * k1); twc[pi][q] = p[0]; tws[pi][q] = p[1]; }
    __syncthreads();
    f32x16 ar[2], ai[2];
#pragma unroll
    for (int a = 0; a < 2; ++a) { ar[a] = f32x16{}; ai[a] = f32x16{}; }
#pragma unroll 2
    for (int kt = 0; kt < 8; ++kt) {
        const bf16x8 zr = *(const LAS bf16x8*)(ZT + (nt * 32 + r) * 264 + kt * 16 + 8 * h), zi = *(const LAS bf16x8*)(ZT + (nt * 32 + r) * 264 + 128 + kt * 16 + 8 * h);
#pragma unroll
        for (int pi = 0; pi < 2; ++pi) { const int mrow = ((2 * mh + pi) * 32 + r) * 136 + kt * 16 + 8 * h;
            const bf16x8 ac = *(const LAS bf16x8*)(Cl + mrow), as = *(const LAS bf16x8*)(Cl + 128 * 136 + mrow);
            const bf16x8 ns = as ^ (short)0x8000;
            ar[pi] = MFMA32(ac, zr, ar[pi]); ar[pi] = MFMA32(as, zi, ar[pi]);
            ai[pi] = MFMA32(ac, zi, ai[pi]); ai[pi] = MFMA32(ns, zr, ai[pi]); }
    }
    __syncthreads();
    LAS bf16* OUT = (LAS bf16*)(F.lds + F1_ZT);
#pragma unroll
    for (int pi = 0; pi < 2; ++pi)
#pragma unroll
        for (int q = 0; q < 16; ++q) { const int k1 = (2 * mh + pi) * 32 + (q & 3) + 8 * (q >> 2) + 4 * h; const float c = twc[pi][q], s = tws[pi][q], gr = ar[pi][q], gi = ai[pi][q];
            OUT[(k1 * 2) * 128 + nt * 32 + r] = (bf16)f2bf(c * gr + s * gi); OUT[(k1 * 2 + 1) * 128 + nt * 32 + r] = (bf16)f2bf(c * gi - s * gr); }
    __syncthreads();
#pragma unroll
    for (int i = 0; i < 8; ++i) { const int c = tid + i * 512, row = c >> 4, pc = c & 15, k1 = row >> 1, ri = row & 1;
        *(GAS v4u*)(GP + ((((size_t)b * 128 + k1) * 64 + t2) * 2 + ri) * 256 + ch * 128 + pc * 8) = *(const LAS v4u*)(OUT + row * 128 + pc * 8); }
    __syncthreads();
}
constexpr int F2_GT = 0, F2_M = 69632, F2_END = F2_M + 17408;
__device__ __forceinline__ void f2_unit(Frame& F, int unit) {
    unsigned char* ws = F.ws; const int tid = F.tid, lane = F.lane, w = F.wave, r = lane & 31, h = lane >> 5;
    const int b = unit >> 7, k1 = unit & 127;
    const bf16* GP = (const bf16*)(ws + WS_GP) + ((size_t)b * 128 + k1) * 64 * 2 * 256; bf16* MIX = (bf16*)(ws + WS_MIX); const bf16* M2 = (const bf16*)(ws + SM_M2);
    LAS bf16* GT = (LAS bf16*)(F.lds + F2_GT); LAS bf16* Ml = (LAS bf16*)(F.lds + F2_M);
    {
        const int kb = tid >> 5, pc = tid & 31;
        v4u in[8], out[8], tb[2];
#pragma unroll
        for (int i = 0; i < 8; ++i) in[i] = *(const GAS v4u*)(GP + (size_t)(kb * 8 + i) * 256 + pc * 8);
#pragma unroll
        for (int i = 0; i < 2; ++i) tb[i] = *(const GAS v4u*)(M2 + (size_t)(tid + i * 512) * 8);
        tr8x8(in, out);
#pragma unroll
        for (int j = 0; j < 8; ++j) *(LAS v4u*)(GT + (pc * 8 + j) * 136 + kb * 8) = out[j];
#pragma unroll
        for (int i = 0; i < 2; ++i) { const int c = tid + i * 512; *(LAS v4u*)(Ml + (c >> 4) * 136 + (c & 15) * 8) = tb[i]; }
    }
    __syncthreads();
    f32x16 acc[2]; acc[0] = f32x16{}; acc[1] = f32x16{};
#pragma unroll
    for (int kt = 0; kt < 8; ++kt) { const bf16x8 bf = *(const LAS bf16x8*)(GT + (w * 32 + r) * 136 + kt * 16 + 8 * h);
#pragma unroll
        for (int mt = 0; mt < 2; ++mt) { const bf16x8 af = *(const LAS bf16x8*)(Ml + (mt * 32 + r) * 136 + kt * 16 + 8 * h); acc[mt] = MFMA32(af, bf, acc[mt]); } }
    __syncthreads();
    LAS bf16* OUT = (LAS bf16*)(F.lds + F2_GT);
    const float SC = 1.0f / 724.0773439350246f;
#pragma unroll
    for (int mt = 0; mt < 2; ++mt)
#pragma unroll
        for (int q = 0; q < 16; ++q) { const int k2 = mt * 32 + (q & 3) + 8 * (q >> 2) + 4 * h; OUT[k2 * 256 + w * 32 + r] = (bf16)f2bf(acc[mt][q] * SC); }
    __syncthreads();
#pragma unroll
    for (int i = 0; i < 4; ++i) { const int c = tid + i * 512, k2 = c >> 5, pc = c & 31; const size_t row = (size_t)b * SPB + CTXL + k1 + 128 * k2;
        *(GAS v4u*)(MIX + row * 1024 + 256 + pc * 8) = *(const LAS v4u*)(OUT + k2 * 256 + pc * 8); }
    __syncthreads();
}
__device__ __forceinline__ void fctx_unit(Frame& F, int unit) {
    unsigned char* ws = F.ws; const int tid = F.tid, lane = F.lane, w = F.wave, r = lane & 31, h = lane >> 5;
    const int b = unit >> 3, cb = unit & 7;
    const bf16* P = (const bf16*)(ws + WS_P); bf16* MIX = (bf16*)(ws + WS_MIX); const bf16* M3 = (const bf16*)(ws + SM_M3);
    LAS bf16* ZT = (LAS bf16*)(F.lds + RING_OFF);
    for (int idx = tid; idx < 2048; idx += NWAVES * 64) { const int k = idx >> 2, pc = idx & 3, ri = k >> 8, t = k & 255;
        const size_t row = (size_t)b * SPB + t; const v4u raw = *(const GAS v4u*)(P + row * NIN + 512 + ri * 256 + cb * 32 + pc * 8);
        LAS bf16* d = ZT + (pc * 8) * 520 + k;
        d[0] = (bf16)(raw.x & 0xffff); d[520] = (bf16)(raw.x >> 16); d[2 * 520] = (bf16)(raw.y & 0xffff); d[3 * 520] = (bf16)(raw.y >> 16);
        d[4 * 520] = (bf16)(raw.z & 0xffff); d[5 * 520] = (bf16)(raw.z >> 16); d[6 * 520] = (bf16)(raw.w & 0xffff); d[7 * 520] = (bf16)(raw.w >> 16); }
    __syncthreads();
    f32x16 acc = f32x16{};
#pragma unroll 4
    for (int kt = 0; kt < 32; ++kt) { const bf16x8 bf = *(const LAS bf16x8*)(ZT + r * 520 + kt * 16 + 8 * h);
        const bf16x8 af = *(const bf16x8*)(M3 + (size_t)(w * 32 + r) * 512 + kt * 16 + 8 * h); acc = MFMA32(af, bf, acc); }
#pragma unroll
    for (int q = 0; q < 16; ++q) { const int kq = w * 32 + (q & 3) + 8 * (q >> 2) + 4 * h; const size_t row = (size_t)b * SPB + kq;
        MIX[row * 1024 + 256 + cb * 32 + r] = (bf16)f2bf(acc[q] * (1.0f / 128.0f)); }
    __syncthreads();
}

__device__ __forceinline__ void ctx_fixup(Frame& F, int l, int kind) {
    const int gw = F.vcu * NWAVES + F.wave, NGW = F.G * NWAVES, lane = F.lane;
    unsigned char* ws = F.ws;
    const float* mod = (const float*)(ws + WS_CTL + CTL_MOD) + (size_t)l * 3 * 6144 + 2 * 6144;
    const float* gate = mod + (kind == 0 ? 2048 : 5120);
    const float* gn = kind == 0 ? inptr(F.lds, IN_G2) + l * DM : inptr(F.lds, IN_G1) + (l + 1) * DM;
    const float* sc = kind == 0 ? mod + 4096 : mod + 3 * 6144 + 1024;
    const float* part = (const float*)(ws + WS_PART); float* ctxres = (float*)(ws + WS_CTXRES); bf16* ACT = (bf16*)(ws + WS_ACT);
    float* rowss = (float*)(ws + WS_RPART) + (size_t)(2 * l + 1 + kind) * R * 16;
    const float* ctxin = (kind == 0 && l == 0) ? inptr(F.lds, IN_CTX) : nullptr;
    for (int cr = gw; cr < 512; cr += NGW) {
        const int b = cr >> 8, r = b * SPB + (cr & 255); float ss = 0.f; unsigned long long o[4];
#pragma unroll
        for (int j = 0; j < 4; ++j) { const int c = 4 * lane + 256 * j; const size_t off = (size_t)cr * 1024 + c;
            const f32x4 p0 = *(const f32x4*)(part + off), p1 = *(const f32x4*)(part + 512 * 1024 + off), p2 = *(const f32x4*)(part + 2 * 512 * 1024 + off), p3 = *(const f32x4*)(part + 3 * 512 * 1024 + off);
            const f32x4 xs = ctxin ? *(const f32x4*)(ctxin + off) : *(const f32x4*)(ctxres + off);
            const f32x4 xo = xs + *(const f32x4*)(gate + c) * ((p0 + p1) + (p2 + p3));
            *(f32x4*)(ctxres + off) = xo;
            ss += (xo[0] * xo[0] + xo[1] * xo[1]) + (xo[2] * xo[2] + xo[3] * xo[3]);
            const f32x4 a = xo * (*(const f32x4*)(gn + c) * (*(const f32x4*)(sc + c) + 1.0f));
            o[j] = (unsigned long long)pk2(a[0], a[1]) | ((unsigned long long)pk2(a[2], a[3]) << 32); }
        ss = wave_sum(ss);
#pragma unroll
        for (int j = 0; j < 4; ++j) *(unsigned long long*)(ACT + (size_t)r * DM + 4 * lane + 256 * j) = o[j];
        if (lane < 16) rowss[(size_t)r * 16 + lane] = lane == 0 ? ss : 0.f;
    }
}
#ifndef MK_N_LAUNCHES
#define MK_N_LAUNCHES 1
#endif
constexpr int N_PHASES = 3 + 8 * DEPTH;
struct Args { const float* in[22]; float* out; unsigned char* ws; int ph_lo, ph_hi; };
__global__ void __launch_bounds__(NWAVES * 64, 2) fwd_kernel(Args args) {
    extern __shared__ __attribute__((aligned(16))) unsigned char lds[];
    Frame F;
    F.lds = (LAS unsigned char*)lds;
    F.MISC = (volatile LAS unsigned*)(F.lds + MISC_OFF);
    F.tid = threadIdx.x; F.lane = F.tid & 63; F.wave = __builtin_amdgcn_readfirstlane(F.tid >> 6);
    F.G = gridDim.x; { const int bx = blockIdx.x; F.vcu = (F.G % 8 == 0) ? (bx % 8) * (F.G / 8) + bx / 8 : bx; }
    F.ws = args.ws;
    unsigned char* ws = args.ws;
    for (int u = F.tid; u < (LDS_BYTES - LDSCTL_OFF) / 4; u += NWAVES * 64) ((LAS unsigned*)(F.lds + LDSCTL_OFF))[u] = 0u;
    __syncthreads();
    if (F.tid == 0) { LAS unsigned long long* tab = (LAS unsigned long long*)(F.lds + PTAB_OFF);
#pragma unroll
        for (int i = 0; i < N_IN; ++i) tab[i] = (unsigned long long)args.in[i];
        tab[IN_OUT] = (unsigned long long)args.out; }
    __syncthreads();
    XcdBarrier bar; bar.bar = (unsigned*)(ws + WS_CTL) + CW_BAR; bar.x = 0; bar.st = nullptr;
    if (MK_N_LAUNCHES == 1) bar = xcd_barrier_post((unsigned*)(ws + WS_CTL) + CW_BAR, F.MISC + 8);
    const int lo = args.ph_lo, hi = args.ph_hi;
#define IN(k) (lo <= (k) && (k) < hi)
#define SEAM(k) do { if ((k) + 1 < hi) xcd_barrier(bar); } while (0)
#define ENTER() do { int t_ = threadIdx.x; asm volatile("" : "+v"(t_)); F.tid = t_; F.lane = t_ & 63; F.wave = __builtin_amdgcn_readfirstlane(t_ >> 6); \
        unsigned long long w_ = (unsigned long long)args.ws; asm volatile("" : "+s"(w_)); ws = (unsigned char*)w_; F.ws = ws; } while (0)

    if (IN(0)) { ENTER(); s0_prologue(F); SEAM(0); }
    if (IN(1)) { ENTER(); s0b_modsum(F); SEAM(1); }
    if (IN(2)) { ENTER(); s1_prologue(F); SEAM(2); }
#pragma unroll 1
    for (int l = 0; l < DEPTH; ++l) {
        const int p0 = 3 + 8 * l; const bool last = (l == DEPTH - 1);
        if (IN(p0)) {
            ENTER();
            pg8::Gemm g{(const bf16*)(ws + WS_ACT), (const bf16*)(ws + WS_WIN + l * WIN_STRIDE), R, NIN, DM}; pg8::StaticOrder S; S.init(R, NIN, DM, F.G, (int)blockIdx.x, 0);
            pg8::EpiInProj E{F.lds, ws, l};
            pg8::gemm_phase<pg8::EpiInProj, pg8::StaticOrder, true, true>(F.lds + RING_OFF, g, S, E);
            SEAM(p0);
        }
        if (IN(p0 + 1)) {
            ENTER();
            for (int u = F.vcu; u < 256; u += F.G) f1_unit(F, u);
            ENTER();
            for (int u = F.vcu; u < 256; u += F.G) p2_convpool_unit<8>(F, l, (u >> 7) * SPB + CTXL + (u & 127) * 64);
            if (!last) { ENTER(); for (int u = (F.vcu + 32) % F.G; u < 16; u += F.G) p2_convpool_unit<4>(F, l, (u >> 3) * SPB + (u & 7) * 32); }
            if (!last) { ENTER(); for (int u = F.G - 1 - F.vcu; u < 16; u += F.G) fctx_unit(F, u); }
            SEAM(p0 + 1);
        }
        if (IN(p0 + 2)) {
            ENTER();
            for (int u = F.vcu; u < 256; u += F.G) f2_unit(F, u);
            ENTER();
            const int nun = last ? 256 : 264;
            for (int u = F.vcu; u < nun; u += F.G) {
                int bh, q0, NT; if (u < 256) { bh = u >> 5; q0 = 256 * (1 + (u & 31)); NT = SPB / 64; } else { bh = u - 256; q0 = 0; NT = CTXL / 64; }
                attn_body::attn_unit<8>((long)(bh >> 2) * SPB, bh & 3, q0, NT, (const attn_body::bf16*)(ws + WS_Q), (const attn_body::bf16*)(ws + WS_K), (const attn_body::bf16*)(ws + WS_V),
                                        (attn_body::bf16*)(ws + WS_MIX), (char*)lds + RING_OFF);
            }
            SEAM(p0 + 2);
        }
        if (IN(p0 + 3)) {
            ENTER();
            pg8::Gemm g{(const bf16*)(ws + WS_MIX), (const bf16*)(ws + WS_WO + l * WO_STRIDE), R, DM, DM}; pg8::StaticOrder S; S.init(64 * 256, DM, DM, F.G, (int)blockIdx.x, 1);
            if (F.G == 256) { pg8::EpiRes2 E{F.lds, ws, l, 0}; pg8::gemm_phase<pg8::EpiRes2, pg8::StaticOrder, false, true>(F.lds + RING_OFF, g, S, E); }
            else { pg8::EpiRes E{F.lds, ws, l, 0}; pg8::gemm_phase<pg8::EpiRes, pg8::StaticOrder, true, true>(F.lds + RING_OFF, g, S, E); }
            if (!last) { ENTER(); pg8::Gemm g2{(const bf16*)(ws + WS_MIX), (const bf16*)(ws + WS_WO + l * WO_STRIDE), R, DM, DM}; pg8::StaticOrder S2; S2.init(64 * 256, DM, DM, F.G, (int)blockIdx.x, 2); pg8::EpiPart E2{ws};
                pg8::gemm_phase<pg8::EpiPart, pg8::StaticOrder, true, true>(F.lds + RING_OFF, g2, S2, E2); }
            SEAM(p0 + 3);
        }
        if (IN(p0 + 4) && !last) { ENTER(); ctx_fixup(F, l, 0); SEAM(p0 + 4); }
        if (IN(p0 + 5)) {
            ENTER();
            pg8::Gemm g{(const bf16*)(ws + WS_ACT), (const bf16*)(ws + WS_WFI + l * WFI_STRIDE), R, 2 * DFF, DM}; pg8::StaticOrder S; S.init(last ? 64 * 256 : R, 2 * DFF, DM, F.G, (int)blockIdx.x, last ? 1 : 0);
            pg8::EpiFfnIn E{ws, l};
            pg8::gemm_phase<pg8::EpiFfnIn, pg8::StaticOrder, true, true>(F.lds + RING_OFF, g, S, E);
            SEAM(p0 + 5);
        }
        if (IN(p0 + 6)) {
            ENTER();
            pg8::Gemm g{(const bf16*)(ws + WS_H), (const bf16*)(ws + WS_WFO + l * WFO_STRIDE), R, DM, DFF}; pg8::StaticOrder S; S.init(64 * 256, DM, DFF, F.G, (int)blockIdx.x, 1);
            if (F.G == 256) { pg8::EpiRes2 E{F.lds, ws, l, 1}; pg8::gemm_phase<pg8::EpiRes2, pg8::StaticOrder, false, true>(F.lds + RING_OFF, g, S, E); }
            else { pg8::EpiRes E{F.lds, ws, l, 1}; pg8::gemm_phase<pg8::EpiRes, pg8::StaticOrder, true, true>(F.lds + RING_OFF, g, S, E); }
            if (!last) { ENTER(); pg8::Gemm g2{(const bf16*)(ws + WS_H), (const bf16*)(ws + WS_WFO + l * WFO_STRIDE), R, DM, DFF}; pg8::StaticOrder S2; S2.init(64 * 256, DM, DFF, F.G, (int)blockIdx.x, 2); pg8::EpiPart E2{ws};
                pg8::gemm_phase<pg8::EpiPart, pg8::StaticOrder, true, true>(F.lds + RING_OFF, g2, S2, E2); }
            if (!last) SEAM(p0 + 6);
        }
        if (IN(p0 + 7) && !last) { ENTER(); ctx_fixup(F, l, 1); SEAM(p0 + 7); }
    }
#undef IN
#undef SEAM
}

extern "C" void kernel_launch(void* const* d_in, const int* in_sizes, int n_in, void* d_out, int out_size, void* d_ws, size_t ws_size, hipStream_t stream) {
    static int grid = 0;
    if (grid == 0) {
        if (n_in != 22 || out_size != BATCH * SEQ * DM || ws_size < WS_END) { fprintf(stderr, "kernel_launch: unexpected shapes (n_in %d out %d ws %zu)\n", n_in, out_size, ws_size); grid = -1; return; }
        int dev = 0, cus = 0, per_cu = 0;
        if (hipGetDevice(&dev) != hipSuccess || hipDeviceGetAttribute(&cus, hipDeviceAttributeMultiprocessorCount, dev) != hipSuccess) { grid = -1; return; }
        if (hipFuncSetAttribute((const void*)fwd_kernel, hipFuncAttributeMaxDynamicSharedMemorySize, LDS_BYTES) != hipSuccess) { fprintf(stderr, "kernel_launch: hipFuncSetAttribute failed\n"); grid = -1; return; }
        if (hipOccupancyMaxActiveBlocksPerMultiprocessor(&per_cu, (const void*)fwd_kernel, NWAVES * 64, LDS_BYTES) != hipSuccess || per_cu < 1) { fprintf(stderr, "kernel_launch: occupancy query says %d\n", per_cu); (void)hipGetLastError(); per_cu = 1; }
        grid = cus;
    }
    if (grid < 0) return;
    (void)hipMemsetAsync((char*)d_ws + WS_CTL, 0, CTL_ZERO_BYTES, stream);
    Args a{};
    for (int i = 0; i < 22; ++i) a.in[i] = (const float*)d_in[i];
    a.out = (float*)d_out; a.ws = (unsigned char*)d_ws;
#if MK_N_LAUNCHES == 1
    a.ph_lo = 0; a.ph_hi = N_PHASES;
    void* kargs[] = {&a};
    hipError_t e = hipLaunchCooperativeKernel((const void*)fwd_kernel, dim3(grid), dim3(NWAVES * 64), kargs, LDS_BYTES, stream);
    if (e != hipSuccess) { fprintf(stderr, "kernel_launch: cooperative launch failed: %s\n", hipGetErrorString(e)); }
#else
    for (int p = 0; p < N_PHASES; ++p) { a.ph_lo = p; a.ph_hi = p + 1; hipLaunchKernelGGL(fwd_kernel, dim3(grid), dim3(NWAVES * 64), LDS_BYTES, stream, a); }
#endif
}
```
